# Optimizing an MI355X kernel written in HIP

```python
import jax, jax.numpy as jnp
from jax import lax
import numpy as np

D_MODEL = 1024
BATCH = 8
SEQ = 4096
DEPTH = 1

MLA_HEADS = 8
NOPE_DIM = 64
ROPE_DIM = 32
QK_DIM = NOPE_DIM + ROPE_DIM
V_DIM = 64
Q_LORA = 512
KV_LORA = 256
ROPE_THETA = 10000.0
Q_BLOCK = 128
MLA_WIDTH = MLA_HEADS * V_DIM
HG_HEADS = 4
HG_KDIM = 128
HG_VDIM = 128
HG_WIDTH = HG_HEADS * HG_KDIM
HG_VWIDTH = HG_HEADS * HG_VDIM
CHUNK = 64
D_FF = 2816
CONV_W = 3
N_MOD = 6
EPS = 1e-6

IN_SPLITS = (Q_LORA, KV_LORA + ROPE_DIM, HG_WIDTH, HG_WIDTH, HG_VWIDTH, HG_VWIDTH, D_MODEL, D_MODEL)
IN_WIDTH = int(sum(IN_SPLITS))

kernel_name = "hybrid_mla_hgrn2_adaln_block"


def rms_norm(x, g):
    xf = x.astype(jnp.float32)
    y = xf * lax.rsqrt(jnp.mean(xf * xf, axis=-1, keepdims=True) + EPS)
    return (y * g.astype(jnp.float32)).astype(x.dtype)


def rope_tables(positions):
    inv_freq = ROPE_THETA ** (-jnp.arange(0, ROPE_DIM, 2, dtype=jnp.float32) / ROPE_DIM)
    ang = positions.astype(jnp.float32)[..., None] * inv_freq
    return jnp.cos(ang)[:, :, None, :], jnp.sin(ang)[:, :, None, :]


def rope_tail(t, cos, sin):
    t_pass, t_rot = t[..., :NOPE_DIM], t[..., NOPE_DIM:]
    tf = t_rot.astype(jnp.float32)
    t1, t2 = tf[..., : ROPE_DIM // 2], tf[..., ROPE_DIM // 2:]
    rot = jnp.concatenate([t1 * cos - t2 * sin, t2 * cos + t1 * sin], axis=-1)
    return jnp.concatenate([t_pass, rot.astype(t.dtype)], axis=-1)


def causal_attention_blocked(q, k, v):
    B, S, H, _ = q.shape
    nb = S // Q_BLOCK
    scale = 1.0 / float(np.sqrt(QK_DIM))
    qb = q.reshape(B, nb, Q_BLOCK, H, QK_DIM).transpose(1, 0, 2, 3, 4)
    k_pos = jnp.arange(S)

    def block(args):
        qi, i = args
        s = jnp.einsum('bqhd,bkhd->bhqk', qi, k).astype(jnp.float32) * scale
        q_pos = i * Q_BLOCK + jnp.arange(Q_BLOCK)
        mask = k_pos[None, :] <= q_pos[:, None]
        s = jnp.where(mask[None, None], s, -jnp.inf)
        p = jax.nn.softmax(s, axis=-1).astype(v.dtype)
        return jnp.einsum('bhqk,bkhd->bqhd', p, v)

    out = lax.map(block, (qb, jnp.arange(nb)))
    return out.transpose(1, 0, 2, 3, 4).reshape(B, S, H * V_DIM)


def mla_branch(c_q, c_kv_all, cos, sin, q_a_norm_g, w_uq, kv_a_norm_g, w_ukv, q_norm_g, k_norm_g):
    B, S, _ = c_q.shape
    c_q = rms_norm(c_q, q_a_norm_g)
    q = (c_q @ w_uq).reshape(B, S, MLA_HEADS, QK_DIM)
    c_kv, k_rope = c_kv_all[..., :KV_LORA], c_kv_all[..., KV_LORA:]
    c_kv = rms_norm(c_kv, kv_a_norm_g)
    kv = (c_kv @ w_ukv).reshape(B, S, MLA_HEADS, NOPE_DIM + V_DIM)
    k_nope, v = kv[..., :NOPE_DIM], kv[..., NOPE_DIM:]
    k_rope = jnp.broadcast_to(k_rope[:, :, None, :], (B, S, MLA_HEADS, ROPE_DIM))
    k = jnp.concatenate([k_nope, k_rope], axis=-1)
    q = rope_tail(rms_norm(q, q_norm_g), cos, sin)
    k = rope_tail(rms_norm(k, k_norm_g), cos, sin)
    return causal_attention_blocked(q, k, v)


def hgrn2_lower_bound(lb_table, layer):
    cum = jnp.cumsum(jax.nn.softmax(lb_table.astype(jnp.float32), axis=0), axis=0)
    return cum[layer + 1] - cum[0]


def hgrn2_branch(q_pre, f_pre, i_in, g_pre, lb, out_norm_g):
    B, S, _ = q_pre.shape
    nc = S // CHUNK
    f32 = jnp.float32
    q = jax.nn.silu(q_pre.astype(f32)).reshape(B, S, HG_HEADS, HG_KDIM)
    f = lb + (1.0 - lb) * jax.nn.sigmoid(f_pre.astype(f32))
    log_f = jnp.log(f).reshape(B, S, HG_HEADS, HG_KDIM)
    k = (1.0 - f).reshape(B, S, HG_HEADS, HG_KDIM)
    v = i_in.astype(f32).reshape(B, S, HG_HEADS, HG_VDIM)

    def to_chunks(t):
        return t.reshape(B, nc, CHUNK, HG_HEADS, t.shape[-1]).transpose(1, 0, 3, 2, 4)

    tri = jnp.tril(jnp.ones((CHUNK, CHUNK), dtype=bool))[None, None, :, :, None]

    def step(state, inp):
        qc, kc, vc, lfc = inp
        b = jnp.cumsum(lfc, axis=2)
        inter = jnp.einsum('bhck,bhkv->bhcv', qc * jnp.exp(b), state)
        diff = b[:, :, :, None, :] - b[:, :, None, :, :]
        decay = jnp.exp(jnp.where(tri, diff, -jnp.inf))
        attn = jnp.einsum('bhtk,bhsk,bhtsk->bhts', qc, kc, decay)
        intra = jnp.einsum('bhts,bhsv->bhtv', attn, vc)
        b_last = b[:, :, -1:, :]
        new_state = (jnp.exp(b_last[:, :, 0, :])[..., None] * state
                     + jnp.einsum('bhsk,bhsv->bhkv', kc * jnp.exp(b_last - b), vc))
        return new_state, inter + intra

    state0 = jnp.zeros((B, HG_HEADS, HG_KDIM, HG_VDIM), f32)
    _, o = lax.scan(step, state0, (to_chunks(q), to_chunks(k), to_chunks(v), to_chunks(log_f)))
    o = o.transpose(1, 0, 3, 2, 4).reshape(B, S, HG_HEADS, HG_VDIM)
    o = rms_norm(o, out_norm_g) * jax.nn.silu(g_pre.astype(f32)).reshape(B, S, HG_HEADS, HG_VDIM)
    return o.reshape(B, S, HG_VWIDTH).astype(q_pre.dtype)


def causal_depthwise_conv(u, w, b):
    S = u.shape[1]
    up = jnp.pad(u, ((0, 0), (CONV_W - 1, 0), (0, 0)))
    y = b
    for j in range(CONV_W):
        y = y + w[j] * up[:, j:j + S, :]
    return y


def setup_inputs(seed: int = 0) -> dict:
    key = jax.random.key(seed)
    ks = jax.random.split(key, 32)
    f32 = jnp.float32
    L = DEPTH

    def nrm(k, shape, scale):
        return jax.random.normal(k, shape, f32) * scale

    def gain(k, shape):
        return 1.0 + 0.02 * jax.random.normal(k, shape, f32)

    x = jax.random.normal(ks[0], (BATCH, SEQ, D_MODEL), f32)
    c = jax.random.normal(ks[1], (BATCH, D_MODEL), f32)
    offsets = jax.random.randint(ks[2], (BATCH, 1), 0, 1024, dtype=jnp.int32)
    positions = offsets + jnp.arange(SEQ, dtype=jnp.int32)[None, :]
    return {
        "x": x,
        "c": c,
        "positions": positions,
        "w_ada": nrm(ks[3], (L, D_MODEL, N_MOD * D_MODEL), 0.5 * D_MODEL ** -0.5),
        "b_ada": nrm(ks[4], (L, N_MOD * D_MODEL), 0.02),
        "norm1_g": gain(ks[5], (L, D_MODEL)),
        "w_in": nrm(ks[6], (L, D_MODEL, IN_WIDTH), D_MODEL ** -0.5),
        "q_a_norm_g": gain(ks[7], (L, Q_LORA)),
        "w_uq": nrm(ks[8], (L, Q_LORA, MLA_HEADS * QK_DIM), Q_LORA ** -0.5),
        "kv_a_norm_g": gain(ks[9], (L, KV_LORA)),
        "w_ukv": nrm(ks[10], (L, KV_LORA, MLA_HEADS * (NOPE_DIM + V_DIM)), KV_LORA ** -0.5),
        "q_norm_g": gain(ks[11], (L, QK_DIM)),
        "k_norm_g": gain(ks[12], (L, QK_DIM)),
        "hg_lower_bound": nrm(ks[13], (L + 1, HG_WIDTH), 0.5),
        "hg_out_norm_g": gain(ks[14], (L, HG_VDIM)),
        "w_branch_a": nrm(ks[15], (L, MLA_WIDTH, D_MODEL), MLA_WIDTH ** -0.5),
        "w_branch_b": nrm(ks[16], (L, HG_VWIDTH, D_MODEL), HG_VWIDTH ** -0.5),
        "w_out": nrm(ks[17], (L, D_MODEL, D_MODEL), D_MODEL ** -0.5),
        "norm2_g": gain(ks[18], (L, D_MODEL)),
        "w_up": nrm(ks[19], (L, D_MODEL, 2 * D_FF), D_MODEL ** -0.5),
        "conv_w": nrm(ks[20], (L, CONV_W, 2 * D_FF), CONV_W ** -0.5),
        "conv_b": nrm(ks[21], (L, 2 * D_FF), 0.02),
        "w_down": nrm(ks[22], (L, D_FF, D_MODEL), D_FF ** -0.5),
    }


def reference(x, c, positions, w_ada, b_ada, norm1_g, w_in, q_a_norm_g, w_uq, kv_a_norm_g,
              w_ukv, q_norm_g, k_norm_g, hg_lower_bound, hg_out_norm_g, w_branch_a,
              w_branch_b, w_out, norm2_g, w_up, conv_w, conv_b, w_down):
    cos, sin = rope_tables(positions)
    split_idx = np.cumsum(IN_SPLITS)[:-1].tolist()
    for l in range(DEPTH):
        mod = (c @ w_ada[l] + b_ada[l])[:, None, :]
        shift1, scale1, gate1, shift2, scale2, gate2 = jnp.split(mod, N_MOD, axis=-1)

        h = rms_norm(x, norm1_g[l]) * (1.0 + scale1) + shift1
        proj = h @ w_in[l]
        c_q, c_kv_all, hq, hf, hi, hg, ga, gb = jnp.split(proj, split_idx, axis=-1)

        y_a = mla_branch(c_q, c_kv_all, cos, sin, q_a_norm_g[l], w_uq[l], kv_a_norm_g[l],
                         w_ukv[l], q_norm_g[l], k_norm_g[l]) @ w_branch_a[l]
        lb = hgrn2_lower_bound(hg_lower_bound, l)
        y_b = hgrn2_branch(hq, hf, hi, hg, lb, hg_out_norm_g[l]) @ w_branch_b[l]

        merged = jax.nn.sigmoid(ga) * y_a + jax.nn.sigmoid(gb) * y_b
        x = x + gate1 * (merged @ w_out[l])

        h2 = rms_norm(x, norm2_g[l]) * (1.0 + scale2) + shift2
        up = causal_depthwise_conv(h2 @ w_up[l], conv_w[l], conv_b[l])
        u_gate, u_val = up[..., :D_FF], up[..., D_FF:]
        x = x + gate2 * ((jax.nn.silu(u_gate) * u_val) @ w_down[l])
    return x
```

```cpp
#include <hip/hip_runtime.h>
#include <hip/hip_cooperative_groups.h>
#include <cstdio>
#include <cstdint>
#include <cmath>
namespace cg = cooperative_groups;
namespace pg8 {
#define PG8_LAS __attribute__((address_space(3)))
typedef unsigned short bf16_t;
typedef short bf16x8 __attribute__((ext_vector_type(8)));
typedef float f32x4 __attribute__((ext_vector_type(4)));
typedef unsigned u32x4 __attribute__((ext_vector_type(4)));
constexpr int BM = 256, BK = 64, HALF = 128, HTB = HALF * BK * 2  , STAGE_BYTES = 8 * HTB, NXCD = 8, WGM = 8;

__host__ __device__ __forceinline__ int lds_byte(int r, int c) { const int st = (r >> 4) * 2 + (c >> 5), rr = r & 15, cc = c & 31, ob = rr * 64 + cc * 2; return st * 1024 + (ob ^ (((ob >> 9) & 1) << 5)); }
__host__ __device__ __forceinline__ void stage_rc(int b, int& R, int& C) { const int st = b / 1024, sb = b % 1024, swz = sb ^ (((sb >> 9) & 1) << 5); R = (st >> 1) * 16 + swz / 64; C = (st & 1) * 32 + (swz % 64) / 2; }
__host__ __device__ __forceinline__ int perm32(int rho) { const int n = rho >> 4, i = rho & 15; return 8 * (i >> 2) + 4 * n + (i & 3); }

struct Unit { int pm, pn, kh; };
struct Gemm { const bf16_t* A; const bf16_t* Bt; int M, N, K, ldk; };

struct StaticOrder {
    int nM, nN, nwg, G, c;
    __host__ __device__ void init(int M, int N, int G_, int c_) { nM = M / BM; nN = N / BM; nwg = nM * nN; G = G_; c = c_; }
    __host__ __device__ bool next(int i, Unit& u) const {
        const long L = (long)i * G + c; if (L >= nwg) return false;
        int wgid = (int)L; { const int q = nwg / NXCD, r = nwg % NXCD, xcd = wgid % NXCD, off = wgid / NXCD; wgid = (xcd < r ? xcd * (q + 1) : r * (q + 1) + (xcd - r) * q) + off; }
        const int nig = WGM * nN, gid = wgid / nig, fm = gid * WGM, gsz = (nM - fm) < WGM ? (nM - fm) : WGM;
        u.pm = fm + ((wgid % nig) % gsz); u.pn = (wgid % nig) / gsz; u.kh = 0; return true;
    }
    __device__ __forceinline__ void a_ready(const Unit&) const {}
    __device__ __forceinline__ void done(const Unit&) const {}
};

struct PairOrder {
    StaticOrder base;
    __host__ __device__ void init(int M, int N, int G_, int c_) { base.init(M, N, G_, c_); }
    __host__ __device__ bool next(int i, Unit& u) const { if (!base.next(i >> 1, u)) return false; u.kh = i & 1; return true; }
    __device__ __forceinline__ void a_ready(const Unit&) const {}
    __device__ __forceinline__ void done(const Unit&) const {}
};

__device__ __forceinline__ unsigned cvt_pk_bf16(float lo, float hi) { unsigned r; asm volatile("v_cvt_pk_bf16_f32 %0, %1, %2" : "=v"(r) : "v"(lo), "v"(hi)); return r; }
typedef float f32x2 __attribute__((ext_vector_type(2)));
__device__ __forceinline__ f32x2 gelu_pk(f32x2 v) {
    const f32x2 av = __builtin_elementwise_abs(v), d = av * 0.2316418882f + 1.0f;
    f32x2 t; t.x = __builtin_amdgcn_rcpf(d.x); t.y = __builtin_amdgcn_rcpf(d.y);
    f32x2 q = t * 0.5307027145f + (-0.7265760135f); q = q * t + 0.7107068705f; q = q * t + (-0.142248368f); q = q * t + 0.127414796f; q = q * t;
    const f32x2 s = (v * v) * (-0.72134752044f);
    f32x2 e; e.x = __builtin_amdgcn_exp2f(s.x); e.y = __builtin_amdgcn_exp2f(s.y);
    const f32x2 m = v * (q * e), r = v - m;
    f32x2 o; o.x = v.x < 0.f ? m.x : r.x; o.y = v.y < 0.f ? m.y : r.y; return o;
}

template <int ACT  > struct EpiBf16 {
    static constexpr bool PERM = true, AFTER_DRAIN = false, ROWPERM = false; static_assert(ACT == 0 || ACT == 1, "EpiBf16: ACT is 0 (none) or 1 (gelu_pk)");
    bf16_t* O; int ldc; const float* bias; int split_cols; size_t split_stride; float scale0;
    __device__ __forceinline__ void operator()(const f32x4 (&acc)[2][2][4][2], const Unit& u, int wr, int wc, int fr, int fq) const {
        const int row0 = u.pm * BM + wr * 64 + fr; int colt = u.pn * BM; bf16_t* base = O;
        float sc = 1.f; if (split_cols) { const int t = colt / split_cols; base += (size_t)t * split_stride; colt -= t * split_cols; if (t == 0) sc = scale0; }
        const int col0 = colt + wc * 32 + 8 * fq, bcol0 = u.pn * BM + wc * 32 + 8 * fq;
        f32x4 bv[2][2];
#pragma unroll
        for (int bj = 0; bj < 2; ++bj)
#pragma unroll
            for (int n = 0; n < 2; ++n) bv[bj][n] = bias ? *(const f32x4*)(bias + bcol0 + bj * HALF + 4 * n) : (f32x4){0.f, 0.f, 0.f, 0.f};
#pragma unroll
        for (int ai = 0; ai < 2; ++ai)
#pragma unroll
            for (int m = 0; m < 4; ++m) { bf16_t* rowp = base + (size_t)(row0 + ai * HALF + m * 16) * ldc + col0;
#pragma unroll
                for (int bj = 0; bj < 2; ++bj) { f32x4 v0 = acc[ai][bj][m][0] + bv[bj][0], v1 = acc[ai][bj][m][1] + bv[bj][1];
                    if (ACT == 1) { f32x2 a = gelu_pk((f32x2){v0[0], v0[1]}), b = gelu_pk((f32x2){v0[2], v0[3]}), c = gelu_pk((f32x2){v1[0], v1[1]}), d = gelu_pk((f32x2){v1[2], v1[3]});
                        v0 = (f32x4){a.x, a.y, b.x, b.y}; v1 = (f32x4){c.x, c.y, d.x, d.y}; }
                    v0 = v0 * sc; v1 = v1 * sc; u32x4 w; w.x = cvt_pk_bf16(v0[0], v0[1]); w.y = cvt_pk_bf16(v0[2], v0[3]); w.z = cvt_pk_bf16(v1[0], v1[1]); w.w = cvt_pk_bf16(v1[2], v1[3]);
                    *(u32x4*)(rowp + bj * HALF) = w; } }
    }
};


template <bool BASE_BF16, bool OUT_BF16> struct EpiResGate {
    static constexpr bool PERM = false, AFTER_DRAIN = false, ROWPERM = false;
    const void* base; void* out; const float* gate;
    __device__ __forceinline__ void operator()(const f32x4 (&acc)[2][2][4][2], const Unit& u, int wr, int wc, int fr, int fq) const {
        const int row0 = u.pm * BM + wr * 64 + fr, col0 = u.pn * BM + wc * 32 + 4 * fq;
        const float* gp = gate + ((u.pm * BM) >> 12) * 6144 + col0;
        f32x4 gv[2][2];
#pragma unroll
        for (int bj = 0; bj < 2; ++bj)
#pragma unroll
            for (int n = 0; n < 2; ++n) gv[bj][n] = *(const f32x4*)(gp + bj * HALF + 16 * n);
#pragma unroll
        for (int ai = 0; ai < 2; ++ai) {
            f32x4 bv[4][2][2]; unsigned long long bw[4][2][2];
#pragma unroll
            for (int m = 0; m < 4; ++m) { const size_t off = (size_t)(row0 + ai * HALF + m * 16) * 1024 + col0;
#pragma unroll
                for (int bj = 0; bj < 2; ++bj)
#pragma unroll
                    for (int n = 0; n < 2; ++n) {
                        if (BASE_BF16) bw[m][bj][n] = *(const unsigned long long*)((const bf16_t*)base + off + bj * HALF + 16 * n);
                        else bv[m][bj][n] = *(const f32x4*)((const float*)base + off + bj * HALF + 16 * n); } }
            asm volatile("" ::: "memory");
#pragma unroll
            for (int m = 0; m < 4; ++m) { const size_t off = (size_t)(row0 + ai * HALF + m * 16) * 1024 + col0;
#pragma unroll
                for (int bj = 0; bj < 2; ++bj)
#pragma unroll
                    for (int n = 0; n < 2; ++n) {
                        f32x4 b4;
                        if (BASE_BF16) { const unsigned long long w = bw[m][bj][n];
                            b4 = (f32x4){__uint_as_float((unsigned)(w & 0xffffull) << 16), __uint_as_float((unsigned)((w >> 16) & 0xffffull) << 16),
                                         __uint_as_float((unsigned)((w >> 32) & 0xffffull) << 16), __uint_as_float((unsigned)((w >> 48) & 0xffffull) << 16)}; }
                        else b4 = bv[m][bj][n];
                        const f32x4 o = b4 + gv[bj][n] * acc[ai][bj][m][n];
                        if (OUT_BF16) *(unsigned long long*)((bf16_t*)out + off + bj * HALF + 16 * n) = (unsigned long long)cvt_pk_bf16(o[0], o[1]) | ((unsigned long long)cvt_pk_bf16(o[2], o[3]) << 32);
                        else *(f32x4*)((float*)out + off + bj * HALF + 16 * n) = o; } }
        }
    }
};
template <int MODE> struct EpiBranch {
    static constexpr bool PERM = false, AFTER_DRAIN = false, ROWPERM = false;
    const bf16_t* gsl; float* tmp; bf16_t* merged; size_t slab_elems;
    __device__ __forceinline__ void operator()(const f32x4 (&acc)[2][2][4][2], const Unit& u, int wr, int wc, int fr, int fq) const {
        const int row0 = u.pm * BM + wr * 64 + fr, cin = wc * 32 + 4 * fq, col0 = u.pn * BM + cin;
        const bf16_t* gb = gsl + (size_t)(u.pn >> 1) * slab_elems + (u.pn & 1) * 256 + cin;
#pragma unroll
        for (int ai = 0; ai < 2; ++ai)
#pragma unroll
            for (int m = 0; m < 4; ++m) { const int row = row0 + ai * HALF + m * 16; const size_t off = (size_t)row * 1024 + col0; const bf16_t* gr = gb + (size_t)row * 512;
#pragma unroll
                for (int bj = 0; bj < 2; ++bj)
#pragma unroll
                    for (int n = 0; n < 2; ++n) {
                        const unsigned long long gw = *(const unsigned long long*)(gr + bj * HALF + 16 * n);
                        f32x4 g; g[0] = __uint_as_float((unsigned)(gw & 0xffffull) << 16); g[1] = __uint_as_float((unsigned)((gw >> 16) & 0xffffull) << 16);
                        g[2] = __uint_as_float((unsigned)((gw >> 32) & 0xffffull) << 16); g[3] = __uint_as_float((unsigned)((gw >> 48) & 0xffffull) << 16);
                        f32x4 v;
#pragma unroll
                        for (int e = 0; e < 4; ++e) v[e] = acc[ai][bj][m][n][e] * __builtin_amdgcn_rcpf(1.0f + __expf(-g[e]));
                        unsigned long long* mp = (unsigned long long*)(merged + off + bj * HALF + 16 * n);
                        if (MODE == 0) { *mp = (unsigned long long)cvt_pk_bf16(v[0], v[1]) | ((unsigned long long)cvt_pk_bf16(v[2], v[3]) << 32); }
                        else { const unsigned long long tw = *mp;
                            const f32x4 o = {v[0] + __uint_as_float((unsigned)(tw & 0xffffull) << 16), v[1] + __uint_as_float((unsigned)((tw >> 16) & 0xffffull) << 16),
                                             v[2] + __uint_as_float((unsigned)((tw >> 32) & 0xffffull) << 16), v[3] + __uint_as_float((unsigned)((tw >> 48) & 0xffffull) << 16)};
                            *mp = (unsigned long long)cvt_pk_bf16(o[0], o[1]) | ((unsigned long long)cvt_pk_bf16(o[2], o[3]) << 32); } } }
    }
};

struct EpiBranchPair {
    static constexpr bool PERM = false, AFTER_DRAIN = false, ROWPERM = false;
    const bf16_t* ga; const bf16_t* gb; bf16_t* merged; size_t slab_elems;
    __device__ __forceinline__ void operator()(f32x4 (&acc)[2][2][4][2], const Unit& u, int wr, int wc, int fr, int fq) const {
        const int row0 = u.pm * BM + wr * 64 + fr, cin = wc * 32 + 4 * fq, col0 = u.pn * BM + cin;
        const size_t gofs = (size_t)(u.pn >> 1) * slab_elems + (u.pn & 1) * 256 + cin;
#pragma unroll
        for (int ai = 0; ai < 2; ++ai) {
            unsigned long long wbv[4][2][2], wav[4][2][2];
#pragma unroll
            for (int m = 0; m < 4; ++m) { const size_t gro = gofs + (size_t)(row0 + ai * HALF + m * 16) * 512;
#pragma unroll
                for (int bj = 0; bj < 2; ++bj)
#pragma unroll
                    for (int n = 0; n < 2; ++n) { wbv[m][bj][n] = *(const unsigned long long*)(gb + gro + bj * HALF + 16 * n);
                        if (u.kh == 0) wav[m][bj][n] = *(const unsigned long long*)(ga + gro + bj * HALF + 16 * n); else wav[m][bj][n] = 0ull; } }
            asm volatile("" ::: "memory");
#pragma unroll
            for (int m = 0; m < 4; ++m) { const size_t off = (size_t)(row0 + ai * HALF + m * 16) * 1024 + col0;
#pragma unroll
                for (int bj = 0; bj < 2; ++bj)
#pragma unroll
                    for (int n = 0; n < 2; ++n) {
                        const unsigned long long wb = wbv[m][bj][n];
                        f32x4 eb;
                        eb[0] = __expf(-fmaxf(__uint_as_float((unsigned)(wb & 0xffffull) << 16), -60.f)); eb[1] = __expf(-fmaxf(__uint_as_float((unsigned)((wb >> 16) & 0xffffull) << 16), -60.f));
                        eb[2] = __expf(-fmaxf(__uint_as_float((unsigned)((wb >> 32) & 0xffffull) << 16), -60.f)); eb[3] = __expf(-fmaxf(__uint_as_float((unsigned)((wb >> 48) & 0xffffull) << 16), -60.f));
                        if (u.kh == 0) {
                            const unsigned long long wa = wav[m][bj][n];
                            f32x4 ea;
                            ea[0] = __expf(-__uint_as_float((unsigned)(wa & 0xffffull) << 16)); ea[1] = __expf(-__uint_as_float((unsigned)((wa >> 16) & 0xffffull) << 16));
                            ea[2] = __expf(-__uint_as_float((unsigned)((wa >> 32) & 0xffffull) << 16)); ea[3] = __expf(-__uint_as_float((unsigned)((wa >> 48) & 0xffffull) << 16));
#pragma unroll
                            for (int e_ = 0; e_ < 4; ++e_) acc[ai][bj][m][n][e_] *= (1.0f + eb[e_]) * __builtin_amdgcn_rcpf(1.0f + ea[e_]);
                        } else {
                            f32x4 o;
#pragma unroll
                            for (int e_ = 0; e_ < 4; ++e_) o[e_] = acc[ai][bj][m][n][e_] * __builtin_amdgcn_rcpf(1.0f + eb[e_]);
                            *(unsigned long long*)(merged + off + bj * HALF + 16 * n) = (unsigned long long)cvt_pk_bf16(o[0], o[1]) | ((unsigned long long)cvt_pk_bf16(o[2], o[3]) << 32);
                        } } }
        }
    }
};

__device__ __forceinline__ float dpp_shr1(float v) { return __builtin_bit_cast(float, __builtin_amdgcn_update_dpp(0, __builtin_bit_cast(int, v), 0x111, 0xf, 0xf, true)); }
struct EpiConvAct {
    static constexpr bool PERM = true, AFTER_DRAIN = false, ROWPERM = true;
    bf16_t* act; bf16_t* edge; const float* cw; const float* cb;
    __device__ __forceinline__ void operator()(const f32x4 (&acc)[2][2][4][2], const Unit& u, int wr, int wc, int fr, int fq) const {
        const int chl = wc * 32 + 8 * fq, ch0 = u.pn * 128 + chl, ucol = u.pn * 256 + chl;
#pragma unroll
        for (int n = 0; n < 2; ++n) {
            const f32x4 wg0 = *(const f32x4*)(cw + ch0 + 4 * n), wg1 = *(const f32x4*)(cw + 5632 + ch0 + 4 * n), wg2 = *(const f32x4*)(cw + 2 * 5632 + ch0 + 4 * n), bg = *(const f32x4*)(cb + ch0 + 4 * n);
            const f32x4 wv0 = *(const f32x4*)(cw + 2816 + ch0 + 4 * n), wv1 = *(const f32x4*)(cw + 5632 + 2816 + ch0 + 4 * n), wv2 = *(const f32x4*)(cw + 2 * 5632 + 2816 + ch0 + 4 * n), bv = *(const f32x4*)(cb + 2816 + ch0 + 4 * n);
#pragma unroll
            for (int ai = 0; ai < 2; ++ai) {
                const int stripe = u.pm * 4 + ai * 2 + wr;
                f32x4 pg1, pg2, pv1, pv2;
#pragma unroll
                for (int e = 0; e < 4; ++e) { pg1[e] = dpp_shr1(acc[ai][0][3][n][e]); pg2[e] = dpp_shr1(acc[ai][0][2][n][e]); pv1[e] = dpp_shr1(acc[ai][1][3][n][e]); pv2[e] = dpp_shr1(acc[ai][1][2][n][e]); }
                f32x4 yg[4], yv[4];
                yg[0] = bg + wg0 * pg2 + wg1 * pg1 + wg2 * acc[ai][0][0][n];
                yg[1] = bg + wg0 * pg1 + wg1 * acc[ai][0][0][n] + wg2 * acc[ai][0][1][n];
                yg[2] = bg + wg0 * acc[ai][0][0][n] + wg1 * acc[ai][0][1][n] + wg2 * acc[ai][0][2][n];
                yg[3] = bg + wg0 * acc[ai][0][1][n] + wg1 * acc[ai][0][2][n] + wg2 * acc[ai][0][3][n];
                yv[0] = bv + wv0 * pv2 + wv1 * pv1 + wv2 * acc[ai][1][0][n];
                yv[1] = bv + wv0 * pv1 + wv1 * acc[ai][1][0][n] + wv2 * acc[ai][1][1][n];
                yv[2] = bv + wv0 * acc[ai][1][0][n] + wv1 * acc[ai][1][1][n] + wv2 * acc[ai][1][2][n];
                yv[3] = bv + wv0 * acc[ai][1][1][n] + wv1 * acc[ai][1][2][n] + wv2 * acc[ai][1][3][n];
                bf16_t* arow = act + (size_t)(stripe * 64 + 4 * fr) * 2816 + ch0 + 4 * n;
#pragma unroll
                for (int m = 0; m < 4; ++m) { f32x4 o;
#pragma unroll
                    for (int e = 0; e < 4; ++e) o[e] = yg[m][e] * __builtin_amdgcn_rcpf(1.0f + __expf(-yg[m][e])) * yv[m][e];
                    *(unsigned long long*)(arow + (size_t)m * 2816) = (unsigned long long)cvt_pk_bf16(o[0], o[1]) | ((unsigned long long)cvt_pk_bf16(o[2], o[3]) << 32); }
                if (fr == 0 || fr == 15) {
                    const int m0 = (fr == 0) ? 0 : 2;
#pragma unroll
                    for (int mm = 0; mm < 2; ++mm)
#pragma unroll
                        for (int bj = 0; bj < 2; ++bj) { const f32x4 x = (fr == 0) ? acc[ai][bj][mm][n] : acc[ai][bj][2 + mm][n];
                            *(unsigned long long*)(edge + ((size_t)stripe * 4 + m0 + mm) * 5632 + ucol + bj * HALF + 4 * n) = (unsigned long long)cvt_pk_bf16(x[0], x[1]) | ((unsigned long long)cvt_pk_bf16(x[2], x[3]) << 32); }
                }
            }
        }
    }
};

struct EpiRowScale {
    static constexpr bool PERM = true, AFTER_DRAIN = false, ROWPERM = false;
    bf16_t* O; int ldc; const float* rs;
    __device__ __forceinline__ void operator()(const f32x4 (&acc)[2][2][4][2], const Unit& u, int wr, int wc, int fr, int fq) const {
        const int row0 = u.pm * BM + wr * 64 + fr, col0 = u.pn * BM + wc * 32 + 8 * fq;
#pragma unroll
        for (int ai = 0; ai < 2; ++ai)
#pragma unroll
            for (int m = 0; m < 4; ++m) { const int row = row0 + ai * HALF + m * 16; const float sc = rs[row]; bf16_t* rowp = O + (size_t)row * ldc + col0;
#pragma unroll
                for (int bj = 0; bj < 2; ++bj) { const f32x4 v0 = acc[ai][bj][m][0] * sc, v1 = acc[ai][bj][m][1] * sc;
                    u32x4 w; w.x = cvt_pk_bf16(v0[0], v0[1]); w.y = cvt_pk_bf16(v0[2], v0[3]); w.z = cvt_pk_bf16(v1[0], v1[1]); w.w = cvt_pk_bf16(v1[2], v1[3]);
                    *(u32x4*)(rowp + bj * HALF) = w; } }
    }
};
struct EpiColScale {
    static constexpr bool PERM = true, AFTER_DRAIN = false, ROWPERM = false;
    bf16_t* O; int ldc; const float* cs;
    __device__ __forceinline__ void operator()(const f32x4 (&acc)[2][2][4][2], const Unit& u, int wr, int wc, int fr, int fq) const {
        const int row0 = u.pm * BM + wr * 64 + fr, col0 = u.pn * BM + wc * 32 + 8 * fq;
        f32x4 sv[2][2];
#pragma unroll
        for (int bj = 0; bj < 2; ++bj)
#pragma unroll
            for (int n = 0; n < 2; ++n) sv[bj][n] = *(const f32x4*)(cs + col0 + bj * HALF + 4 * n);
#pragma unroll
        for (int ai = 0; ai < 2; ++ai)
#pragma unroll
            for (int m = 0; m < 4; ++m) { bf16_t* rowp = O + (size_t)(row0 + ai * HALF + m * 16) * ldc + col0;
#pragma unroll
                for (int bj = 0; bj < 2; ++bj) { const f32x4 v0 = acc[ai][bj][m][0] * sv[bj][0], v1 = acc[ai][bj][m][1] * sv[bj][1];
                    u32x4 w; w.x = cvt_pk_bf16(v0[0], v0[1]); w.y = cvt_pk_bf16(v0[2], v0[3]); w.z = cvt_pk_bf16(v1[0], v1[1]); w.w = cvt_pk_bf16(v1[2], v1[3]);
                    *(u32x4*)(rowp + bj * HALF) = w; } }
    }
};
template <class Epi, class Sched, bool ALIGN_EPI = false, bool SP2 = false>
__device__ __forceinline__ void gemm_phase(PG8_LAS unsigned char* lds, const Gemm g, const Sched& S, const Epi& E) {
    const int tid = threadIdx.x, wid = __builtin_amdgcn_readfirstlane(tid >> 6), lane = tid & 63, wr = wid >> 2, wc = wid & 3, fr = lane & 15, fq = lane >> 4;
    const int K = g.K, nt = K / BK, ldk = g.ldk ? g.ldk : g.K;
    unsigned voffA[2], voffB[2];
#pragma unroll
    for (int i = 0; i < 2; ++i) { int R, C; stage_rc(tid * 16 + i * 8192, R, C); const int Rb = Epi::PERM ? ((R & ~31) + perm32(R & 31)) : R;
        const int Ra = Epi::ROWPERM ? ((R & 64) | ((R & 15) << 2) | ((R >> 4) & 3)) : R;
        voffA[i] = (unsigned)(Ra * ldk + C) * 2u; voffB[i] = (unsigned)(Rb * ldk + C) * 2u; }
    const size_t kstep = (size_t)(BK * 2);
    const size_t hstep = (size_t)HALF * ldk * 2;
    const size_t tstep = 2 * hstep;
    const unsigned ldsw = (unsigned)wid * 1024u;
    const int aoff = lds_byte(wr * 64 + fr, fq * 8), boff = lds_byte(wc * 32 + fr, fq * 8);
#define PG8_SA(b, h) (((b) * 2 + (h)) * HTB)
#define PG8_SB(b, h) ((4 + (b) * 2 + (h)) * HTB)
#define PG8_STAGE(bufoff, gbase, voff) do { _Pragma("unroll") for (int _i = 0; _i < 2; ++_i) \
        __builtin_amdgcn_global_load_lds((const unsigned*)((const char*)(gbase) + (voff)[_i]), (PG8_LAS unsigned*)(lds + (bufoff) + ldsw + _i * 8192), 16, 0, 0); } while (0)
#define PG8_LDA(dst, b, h) do { _Pragma("unroll") for (int m = 0; m < 4; ++m) _Pragma("unroll") for (int k = 0; k < 2; ++k) dst[m][k] = *(const PG8_LAS bf16x8*)(lds + PG8_SA(b, h) + aoff + m * 2048 + k * 1024); } while (0)
#define PG8_LDB(dst, b, h) do { _Pragma("unroll") for (int n = 0; n < 2; ++n) _Pragma("unroll") for (int k = 0; k < 2; ++k) dst[n][k] = *(const PG8_LAS bf16x8*)(lds + PG8_SB(b, h) + boff + n * 2048 + k * 1024); } while (0)
#define PG8_MMA(ai, bj, At, Bt) do { __builtin_amdgcn_s_setprio(1); _Pragma("unroll") for (int m = 0; m < 4; ++m) _Pragma("unroll") for (int n = 0; n < 2; ++n) _Pragma("unroll") for (int k = 0; k < 2; ++k) \
        acc[ai][bj][m][n] = __builtin_amdgcn_mfma_f32_16x16x32_bf16(Bt[n][k], At[m][k], acc[ai][bj][m][n], 0, 0, 0); __builtin_amdgcn_s_setprio(0); } while (0)
#define PG8_WAIT_V(n) asm volatile("s_waitcnt vmcnt(" #n ")" ::: "memory")
#define PG8_WAIT_L(n) asm volatile("s_waitcnt lgkmcnt(" #n ")" ::: "memory")
#define PG8_BAR __builtin_amdgcn_s_barrier()
#define PG8_SCHED __builtin_amdgcn_sched_barrier(0)
    Unit cur, nxt; int ui = 0;
    if (!S.next(0, cur)) return;
    f32x4 acc[2][2][4][2];
#pragma unroll
    for (int a = 0; a < 2; ++a)
#pragma unroll
        for (int b = 0; b < 2; ++b)
#pragma unroll
            for (int m = 0; m < 4; ++m)
#pragma unroll
                for (int n = 0; n < 2; ++n) acc[a][b][m][n] = (f32x4){0.f, 0.f, 0.f, 0.f};
    bf16x8 At[4][2], B0[2][2], B1[2][2];
    const size_t khstep = (size_t)K * 2;
    const char* cA = (const char*)g.A + (size_t)cur.pm * tstep + cur.kh * khstep; const char* cB = (const char*)g.Bt + (size_t)cur.pn * tstep + cur.kh * khstep;
    S.a_ready(cur);
    if constexpr (SP2) {
        PG8_STAGE(PG8_SB(0, 0), cB, voffB); PG8_STAGE(PG8_SB(0, 1), cB + hstep, voffB); PG8_STAGE(PG8_SA(0, 0), cA, voffA); PG8_STAGE(PG8_SA(0, 1), cA + hstep, voffA);
        if (wr == 1) PG8_BAR;
        PG8_WAIT_V(2); PG8_BAR;
        PG8_STAGE(PG8_SB(1, 0), cB + kstep, voffB); PG8_STAGE(PG8_SA(1, 0), cA + kstep, voffA); PG8_STAGE(PG8_SB(1, 1), cB + hstep + kstep, voffB);
        PG8_WAIT_V(6); PG8_BAR;
    } else {
        PG8_STAGE(PG8_SB(0, 0), cB, voffB); PG8_STAGE(PG8_SA(0, 0), cA, voffA); PG8_STAGE(PG8_SB(0, 1), cB + hstep, voffB); PG8_STAGE(PG8_SA(0, 1), cA + hstep, voffA);
        if (wr == 1) PG8_BAR;
        PG8_WAIT_V(4); PG8_BAR;
        PG8_STAGE(PG8_SB(1, 0), cB + kstep, voffB); PG8_STAGE(PG8_SA(1, 0), cA + kstep, voffA); PG8_STAGE(PG8_SB(1, 1), cB + hstep + kstep, voffB);
        PG8_WAIT_V(6); PG8_BAR;
    }
    for (;;) {
        const bool has_next = S.next(ui + 1, nxt);
        const char* nA = has_next ? (const char*)g.A + (size_t)nxt.pm * tstep + nxt.kh * khstep : cA; const char* nB = has_next ? (const char*)g.Bt + (size_t)nxt.pn * tstep + nxt.kh * khstep : cB;
        for (int t = 0; t < nt; t += 2) {
            const bool last = (t == nt - 2);
            const char* a1 = cA + (size_t)(t + 1) * kstep;
            const char* a2 = last ? nA : cA + (size_t)(t + 2) * kstep; const char* b2 = last ? nB : cB + (size_t)(t + 2) * kstep;
            const char* a3 = a2 + kstep; const char* b3 = b2 + kstep;
            if (last && has_next) S.a_ready(nxt);
            if constexpr (SP2) {
            PG8_LDB(B0, 0, 0); PG8_LDB(B1, 0, 1); PG8_SCHED; PG8_LDA(At, 0, 0); PG8_STAGE(PG8_SA(1, 1), a1 + hstep, voffA);
            PG8_WAIT_V(8); PG8_WAIT_L(0); PG8_BAR; PG8_MMA(0, 0, At, B0); PG8_MMA(0, 1, At, B1); PG8_BAR; PG8_SCHED;
            PG8_LDA(At, 0, 1); PG8_STAGE(PG8_SB(0, 0), b2, voffB); PG8_STAGE(PG8_SB(0, 1), b2 + hstep, voffB); PG8_STAGE(PG8_SA(0, 0), a2, voffA);
            PG8_WAIT_V(8); PG8_WAIT_L(0); PG8_BAR; PG8_MMA(1, 0, At, B0); PG8_MMA(1, 1, At, B1); PG8_BAR; PG8_SCHED;
            PG8_LDB(B0, 1, 0); PG8_LDB(B1, 1, 1); PG8_SCHED; PG8_LDA(At, 1, 0); PG8_STAGE(PG8_SA(0, 1), a2 + hstep, voffA);
            PG8_WAIT_V(8); PG8_WAIT_L(0); PG8_BAR; PG8_MMA(0, 0, At, B0); PG8_MMA(0, 1, At, B1); PG8_BAR; PG8_SCHED;
            PG8_LDA(At, 1, 1); PG8_STAGE(PG8_SB(1, 0), b3, voffB); PG8_STAGE(PG8_SB(1, 1), b3 + hstep, voffB); PG8_STAGE(PG8_SA(1, 0), a3, voffA);
            PG8_WAIT_V(8); PG8_WAIT_L(0); PG8_BAR; PG8_MMA(1, 0, At, B0); PG8_MMA(1, 1, At, B1); PG8_BAR; PG8_SCHED;
            } else {
            PG8_LDB(B0, 0, 0); PG8_SCHED; PG8_LDA(At, 0, 0); PG8_STAGE(PG8_SA(1, 1), a1 + hstep, voffA);
            PG8_WAIT_L(8); PG8_BAR; PG8_WAIT_L(0); PG8_MMA(0, 0, At, B0); PG8_BAR; PG8_SCHED;
            PG8_LDB(B1, 0, 1); PG8_STAGE(PG8_SB(0, 0), b2, voffB);
            PG8_BAR; PG8_WAIT_L(0); PG8_MMA(0, 1, At, B1); PG8_BAR;
            PG8_LDA(At, 0, 1); PG8_STAGE(PG8_SA(0, 0), a2, voffA);
            PG8_BAR; PG8_WAIT_L(0); PG8_MMA(1, 0, At, B0); PG8_BAR; PG8_SCHED;
            PG8_STAGE(PG8_SB(0, 1), b2 + hstep, voffB);
            PG8_WAIT_V(6); PG8_BAR; PG8_MMA(1, 1, At, B1); PG8_BAR;
            PG8_LDB(B0, 1, 0); PG8_SCHED; PG8_LDA(At, 1, 0); PG8_STAGE(PG8_SA(0, 1), a2 + hstep, voffA);
            PG8_WAIT_L(8); PG8_BAR; PG8_WAIT_L(0); PG8_MMA(0, 0, At, B0); PG8_BAR; PG8_SCHED;
            PG8_LDB(B1, 1, 1); PG8_STAGE(PG8_SB(1, 0), b3, voffB);
            PG8_BAR; PG8_WAIT_L(0); PG8_MMA(0, 1, At, B1); PG8_BAR;
            PG8_LDA(At, 1, 1); PG8_STAGE(PG8_SA(1, 0), a3, voffA);
            PG8_BAR; PG8_WAIT_L(0); PG8_MMA(1, 0, At, B0); PG8_BAR; PG8_SCHED;
            PG8_STAGE(PG8_SB(1, 1), b3 + hstep, voffB);
            PG8_WAIT_V(6); PG8_BAR; PG8_MMA(1, 1, At, B1); PG8_BAR;
            }
        }
        if constexpr (ALIGN_EPI) { if (wr == 0) PG8_BAR; }
        if constexpr (!Epi::AFTER_DRAIN) { E(acc, cur, wr, wc, fr, fq); S.done(cur); }
        if (!has_next) break;
        if (nxt.kh == 0)
#pragma unroll
        for (int a = 0; a < 2; ++a)
#pragma unroll
            for (int b = 0; b < 2; ++b)
#pragma unroll
                for (int m = 0; m < 4; ++m)
#pragma unroll
                    for (int n = 0; n < 2; ++n) acc[a][b][m][n] = (f32x4){0.f, 0.f, 0.f, 0.f};
        cur = nxt; cA = nA; cB = nB; ++ui;
        if constexpr (ALIGN_EPI) { if (wr == 1) PG8_BAR; }
    }
    PG8_WAIT_V(0);
    if constexpr (!ALIGN_EPI) { if (wr == 0) PG8_BAR; }
    PG8_BAR;
    if constexpr (Epi::AFTER_DRAIN) { E.fused(acc, cur, wr, wc, fr, fq, lds, wid, lane); S.done(cur); }
#undef PG8_SA
#undef PG8_SB
#undef PG8_STAGE
#undef PG8_LDA
#undef PG8_LDB
#undef PG8_MMA
#undef PG8_WAIT_V
#undef PG8_WAIT_L
#undef PG8_BAR
#undef PG8_SCHED
}
}

#define LAS __attribute__((address_space(3)))
typedef unsigned short bf16_t;
typedef short bf16x8 __attribute__((ext_vector_type(8)));
typedef float f32x4 __attribute__((ext_vector_type(4)));
typedef float f32x16 __attribute__((ext_vector_type(16)));
typedef unsigned u32x4 __attribute__((ext_vector_type(4)));
typedef unsigned u32x2 __attribute__((ext_vector_type(2)));

constexpr int T = 32768, DM = 1024, SEQ = 4096;
constexpr int NMOD = 6144, NPROJ = 5120, DFF = 2816, NUP = 5632;
constexpr int NTHR = 512;
constexpr size_t MiB = 1u << 20;
constexpr size_t SLAB = 32 * MiB;
constexpr size_t SLAB_EL = (size_t)T * 512;
constexpr size_t WS_BAR = 512 * 1024;
constexpr size_t WS_MOD = 0, WS_LB = 256 * 1024, WS_G = 1 * MiB, WS_RSQ = 2 * MiB, WS_RSKV = 3 * MiB;
constexpr size_t WS_WIN = 4 * MiB, WS_WUQ = 14 * MiB, WS_WUKV = 15 * MiB, WS_WA = 16 * MiB, WS_WB = 17 * MiB, WS_WOUT = 18 * MiB, WS_WUP = 20 * MiB, WS_WDOWN = 31 * MiB;
__host__ __device__ constexpr size_t SL(int i) { return (size_t)i * SLAB; }
constexpr size_t WS_UH = SL(2);
constexpr size_t WS_ACT = SL(2) + 192 * MiB;
constexpr size_t WS_NEED = 512 * MiB;
constexpr int LDS_BYTES = 147456;
constexpr int NPHASE = 17;

__device__ __forceinline__ float bf2f(unsigned short v) { return __uint_as_float((unsigned)v << 16); }
__device__ __forceinline__ float bflo(unsigned w) { return __uint_as_float(w << 16); }
__device__ __forceinline__ float bfhi(unsigned w) { return __uint_as_float(w & 0xffff0000u); }
typedef float f32x2_t __attribute__((ext_vector_type(2))); typedef __bf16 bf16x2_t __attribute__((ext_vector_type(2)));
__device__ __forceinline__ unsigned pk2(float lo, float hi) { f32x2_t v = {lo, hi}; bf16x2_t b = __builtin_convertvector(v, bf16x2_t); return __builtin_bit_cast(unsigned, b); }
__device__ __forceinline__ unsigned short f2bf(float f) { return (unsigned short)(pk2(f, 0.f) & 0xffffu); }
__device__ __forceinline__ float wave_sum(float v) {
#pragma unroll
    for (int o = 1; o < 64; o <<= 1) v += __shfl_xor(v, o);
    return v;
}
__device__ __forceinline__ float sigmoidf_(float x) { return __builtin_amdgcn_rcpf(1.0f + __expf(-x)); }
#define MFMA16(a, b, c) __builtin_amdgcn_mfma_f32_16x16x32_bf16((a), (b), (c), 0, 0, 0)
#define MFMA32(a, b, c) __builtin_amdgcn_mfma_f32_32x32x16_bf16((a), (b), (c), 0, 0, 0)

struct Args { const float* in[23]; float* out; unsigned char* ws; float invf[16]; int ph_lo, ph_hi; };

__device__ __forceinline__ int srccol(int mapid, int nd) {
    if (mapid == 0) return nd;
    if (mapid == 1) { if (nd < 800) return nd; if (nd < 1024) return -1; return nd - 224; }
    if (mapid == 3) return (nd >> 6) * 128 + (nd & 63);
    if (mapid == 4) return (nd >> 6) * 128 + 64 + (nd & 63);
    const int pn = nd >> 8, j = nd & 255; return (j < 128) ? (128 * pn + j) : (DFF + 128 * pn + (j - 128));
}
__device__ __forceinline__ void wt_item(const float* W, int K, int Nsrc, bf16_t* WT, int mapid, int item, int nblk, LAS unsigned short* tile, int ldk = 0, int kofs = 0, const float* kgain = nullptr) {
    if (ldk == 0) ldk = K;
    const int kb = item / nblk, nb = item % nblk, k0 = kb * 64, n0 = nb * 64;
    const int tid = threadIdx.x, n = tid & 63, kq = tid >> 6;
    const int sc = srccol(mapid, n0 + n);
#pragma unroll
    for (int i = 0; i < 8; ++i) { const int k = i * 8 + kq; float v = (sc >= 0) ? W[(size_t)(k0 + k) * Nsrc + sc] : 0.f; if (kgain) v *= kgain[k0 + k]; tile[n * 66 + k] = f2bf(v); }
    __syncthreads();
    { const int nn = tid >> 3, kc = tid & 7; const LAS unsigned* tp = (const LAS unsigned*)(tile + nn * 66 + kc * 8);
      u32x4 w; w[0] = tp[0]; w[1] = tp[1]; w[2] = tp[2]; w[3] = tp[3];
      *(u32x4*)(WT + (size_t)(n0 + nn) * ldk + kofs + k0 + kc * 8) = w; }
    __syncthreads();
}
__device__ __forceinline__ void p0_phase(const Args& a, LAS unsigned char* lds, int bid, int G) {
    unsigned char* ws = a.ws;
    const int tid = threadIdx.x, lane = tid & 63, wid = tid >> 6;
    for (int cgp = bid; cgp < 96; cgp += G) {
        LAS float* red = (LAS float*)lds;
        const float* c = a.in[1]; const float* w = a.in[3]; const int n = cgp * 64 + lane;
        float acc[8];
#pragma unroll
        for (int b = 0; b < 8; ++b) acc[b] = 0.f;
        for (int k = wid * 128; k < wid * 128 + 128; ++k) { const float wv = w[(size_t)k * NMOD + n];
#pragma unroll
            for (int b = 0; b < 8; ++b) acc[b] += c[b * DM + k] * wv; }
#pragma unroll
        for (int b = 0; b < 8; ++b) red[(wid * 8 + b) * 64 + lane] = acc[b];
        __syncthreads();
        { const int b = wid; float s = 0.f;
#pragma unroll
          for (int w8 = 0; w8 < 8; ++w8) s += red[(w8 * 8 + b) * 64 + lane];
          ((float*)(ws + WS_MOD))[b * NMOD + n] = s + a.in[4][n]; }
        __syncthreads();
    }
    if (bid == (96 % G)) { const float* t = a.in[13]; ((float*)(ws + WS_LB))[tid] = 1.0f / (1.0f + expf(t[tid] - t[512 + tid])); }
    LAS unsigned short* tile = (LAS unsigned short*)lds;
    constexpr int I0 = 16 * 80, I1 = 8 * 12, I2 = 4 * 8, I2b = 4 * 8, I3 = 8 * 16, I4 = 8 * 16, I5 = 16 * 16, I6 = 16 * 88, I7 = 44 * 16;
    constexpr int NIT = I0 + I1 + I2 + I2b + I3 + I4 + I5 + I6 + I7;
    for (int it = bid; it < NIT; it += G) {
        int r = it;
        if (r < I0) { wt_item(a.in[6], 1024, 4896, (bf16_t*)(ws + WS_WIN), 1, r, 80, tile); continue; } r -= I0;
        if (r < I1) { wt_item(a.in[8], 512, 768, (bf16_t*)(ws + WS_WUQ), 0, r, 12, tile, 0, 0, a.in[7]); continue; } r -= I1;
        if (r < I2) { wt_item(a.in[10], 256, 1024, (bf16_t*)(ws + WS_WUKV), 3, r, 8, tile, 512, 0, a.in[9]); continue; } r -= I2;
        if (r < I2b) { wt_item(a.in[10], 256, 1024, (bf16_t*)(ws + WS_WUKV + 512 * 1024), 4, r, 8, tile, 512, 0, a.in[9]); continue; } r -= I2b;
        if (r < I3) { wt_item(a.in[15], 512, 1024, (bf16_t*)(ws + WS_WA), 0, r, 16, tile, 1024, 0); continue; } r -= I3;
        if (r < I4) { wt_item(a.in[16], 512, 1024, (bf16_t*)(ws + WS_WA), 0, r, 16, tile, 1024, 512); continue; } r -= I4;
        if (r < I5) { wt_item(a.in[17], 1024, 1024, (bf16_t*)(ws + WS_WOUT), 0, r, 16, tile); continue; } r -= I5;
        if (r < I6) { wt_item(a.in[19], 1024, NUP, (bf16_t*)(ws + WS_WUP), 2, r, 88, tile); continue; } r -= I6;
        wt_item(a.in[22], DFF, 1024, (bf16_t*)(ws + WS_WDOWN), 0, r, 16, tile);
    }
}

template <bool IN_BF16> __device__ __forceinline__ void adaln_phase(const void* xin_, const float* g, const float* mod, int shift_off, int scale_off, bf16_t* out, int bid, int G) {
    const int lane = threadIdx.x & 63, wid = threadIdx.x >> 6;
    const int gw = bid * 8 + wid, NGW = G * 8;
    for (int m0 = 2 * gw; m0 < T; m0 += 2 * NGW) {
        f32x4 v[2][4]; float s[2] = {0.f, 0.f};
#pragma unroll
        for (int r = 0; r < 2; ++r) {
            if (IN_BF16) { const u32x2* xr = (const u32x2*)((const bf16_t*)xin_ + (size_t)(m0 + r) * DM) + lane;
#pragma unroll
                for (int j = 0; j < 4; ++j) { const u32x2 w = xr[64 * j]; v[r][j] = (f32x4){bflo(w[0]), bfhi(w[0]), bflo(w[1]), bfhi(w[1])}; } }
            else { const f32x4* xr = (const f32x4*)((const float*)xin_ + (size_t)(m0 + r) * DM) + lane;
#pragma unroll
                for (int j = 0; j < 4; ++j) v[r][j] = xr[64 * j]; } }
        const float* mb = mod + (m0 >> 12) * NMOD;
        f32x4 ga[4], sh[4];
#pragma unroll
        for (int j = 0; j < 4; ++j) { const int col = 4 * lane + 256 * j; const f32x4 gg = *(const f32x4*)(g + col), sc = *(const f32x4*)(mb + scale_off + col); sh[j] = *(const f32x4*)(mb + shift_off + col);
#pragma unroll
            for (int e = 0; e < 4; ++e) ga[j][e] = gg[e] * (1.0f + sc[e]); }
#pragma unroll
        for (int r = 0; r < 2; ++r)
#pragma unroll
            for (int j = 0; j < 4; ++j) s[r] += (v[r][j][0] * v[r][j][0] + v[r][j][1] * v[r][j][1]) + (v[r][j][2] * v[r][j][2] + v[r][j][3] * v[r][j][3]);
#pragma unroll
        for (int o = 1; o < 64; o <<= 1) { s[0] += __shfl_xor(s[0], o); s[1] += __shfl_xor(s[1], o); }
#pragma unroll
        for (int r = 0; r < 2; ++r) { const float rstd = rsqrtf(s[r] * (1.f / DM) + 1e-6f);
            u32x2* o8 = (u32x2*)(out + (size_t)(m0 + r) * DM) + lane;
#pragma unroll
            for (int j = 0; j < 4; ++j) { f32x4 h;
#pragma unroll
                for (int e = 0; e < 4; ++e) h[e] = v[r][j][e] * rstd * ga[j][e] + sh[j][e];
                u32x2 w; w[0] = pk2(h[0], h[1]); w[1] = pk2(h[2], h[3]); o8[64 * j] = w; } }
    }
}

__device__ __forceinline__ void lora_norm_phase(const Args& a, int bid, int G) {
    unsigned char* ws = a.ws;
    const bf16_t* cq = (const bf16_t*)(ws + SL(4)); const bf16_t* ckv = (const bf16_t*)(ws + SL(5));
    float* rsq = (float*)(ws + WS_RSQ); float* rskv = (float*)(ws + WS_RSKV);
    const int lane = threadIdx.x & 63, wid = threadIdx.x >> 6;
    const int gw = bid * 8 + wid, NGW = G * 8;
#pragma unroll 4
    for (int m = gw; m < T; m += NGW) {
        const u32x4 w = *(const u32x4*)(cq + (size_t)m * 512 + 8 * lane);
        u32x4 w2 = {0u, 0u, 0u, 0u};
        if (lane < 32) w2 = *(const u32x4*)(ckv + (size_t)m * 512 + 8 * lane);
        float s = 0.f, s2 = 0.f;
#pragma unroll
        for (int e = 0; e < 4; ++e) { const float v0 = bflo(w[e]), v1 = bfhi(w[e]), u0 = bflo(w2[e]), u1 = bfhi(w2[e]); s += v0 * v0 + v1 * v1; s2 += u0 * u0 + u1 * u1; }
#pragma unroll
        for (int o = 1; o < 64; o <<= 1) { s += __shfl_xor(s, o); s2 += __shfl_xor(s2, o); }
        if (lane == 0) { rsq[m] = rsqrtf(s * (1.f / 512.f) + 1e-6f); rskv[m] = rsqrtf(s2 * (1.f / 256.f) + 1e-6f); }
    }
}

__device__ __forceinline__ void h1_phase(const bf16_t* hq, const bf16_t* hf, const bf16_t* hi, bf16_t* qe_out, bf16_t* intra_out, const float* lb, bf16_t* Ub, float* G, LAS unsigned char* lds, int bid, int Gn) {
    LAS bf16_t* QA = (LAS bf16_t*)lds;
    LAS bf16_t* KD = QA + 4 * 64 * 136;
    LAS bf16_t* KET = KD + 64 * 136;
    LAS bf16_t* VT = KET + 128 * 72;
    LAS bf16_t* AT = VT + 128 * 72;
    LAS float* TOT = (LAS float*)(AT + 64 * 72);
    LAS bf16_t* ST = QA;
    const int tid = threadIdx.x, lane = tid & 63, wid = __builtin_amdgcn_readfirstlane(tid >> 6);
    const int k = tid & 127, I = __builtin_amdgcn_readfirstlane(tid >> 7);
    u32x4 pf[2][3];
#define H1_LOAD(uu) do { const int b_ = (uu) >> 8, h_ = ((uu) >> 6) & 3, c_ = (uu) & 63; _Pragma("unroll") for (int i = 0; i < 2; ++i) { const int id = tid + NTHR * i, row = id >> 4, cc = id & 15; \
        const size_t go = (size_t)(b_ * SEQ + c_ * 64 + row) * 512 + h_ * 128 + cc * 8; pf[i][0] = *(const u32x4*)(hq + go); pf[i][1] = *(const u32x4*)(hf + go); pf[i][2] = *(const u32x4*)(hi + go); } } while (0)
    if (bid < 2048) H1_LOAD(bid);
    for (int u = bid; u < 2048; u += Gn) {
    const int b = u >> 8, h = (u >> 6) & 3, c = u & 63, t0 = b * SEQ + c * 64, cb = h * 128;
#pragma unroll
    for (int i = 0; i < 2; ++i) { const int id = tid + NTHR * i, row = id >> 4, cc = id & 15;
        *(LAS u32x4*)(ST + row * 128 + cc * 8) = pf[i][0]; *(LAS u32x4*)(ST + 8192 + row * 128 + cc * 8) = pf[i][1]; *(LAS u32x4*)(ST + 16384 + row * 128 + cc * 8) = pf[i][2]; }
    __syncthreads();
    if (u + Gn < 2048) H1_LOAD(u + Gn);
    float q[16], kk[16], pc[16]; unsigned short vv[16];
    const float lbk = lb[cb + k]; float run = 1.0f;
#pragma unroll
    for (int i = 0; i < 16; ++i) {
        const float xq = bf2f(ST[(16 * I + i) * 128 + k]), xf = bf2f(ST[8192 + (16 * I + i) * 128 + k]); vv[i] = ST[16384 + (16 * I + i) * 128 + k];
        const float f = lbk + (1.0f - lbk) * sigmoidf_(xf);
        run *= f; pc[i] = run; kk[i] = 1.0f - f; q[i] = xq * sigmoidf_(xq);
    }
    TOT[I * 128 + k] = run;
    for (int j = tid; j < 64 * 72 / 2; j += NTHR) ((LAS unsigned*)AT)[j] = 0u;
    __syncthreads();
    const float tp0 = TOT[k], tp1 = TOT[128 + k], tp2 = TOT[256 + k], tp3 = TOT[384 + k];
    const float ej2 = (I > 2 ? tp2 : 1.f), ej1 = (I > 1 ? tp1 : 1.f) * ej2, ej0 = (I > 0 ? tp0 : 1.f) * ej1;
    const float suf = (I <= 0 ? tp0 : 1.f) * (I <= 1 ? tp1 : 1.f) * (I <= 2 ? tp2 : 1.f) * tp3;
    unsigned kw[8], vw[8];
#pragma unroll
    for (int i = 0; i < 16; ++i) {
        const int s = 16 * I + i;
        const float rp = __builtin_amdgcn_rcpf(pc[i]), qp = q[i] * pc[i];
        KD[s * 136 + k] = f2bf(kk[i] * rp);
        QA[(0 * 64 + s) * 136 + k] = f2bf(qp * ej0);
        if (I >= 1) QA[(1 * 64 + s) * 136 + k] = f2bf(qp * ej1);
        if (I >= 2) QA[(2 * 64 + s) * 136 + k] = f2bf(qp * ej2);
        if (I >= 3) QA[(3 * 64 + s) * 136 + k] = f2bf(qp);
        const float ke = kk[i] * (suf * rp);
        if (i & 1) { kw[i >> 1] |= (unsigned)f2bf(ke) << 16; vw[i >> 1] |= (unsigned)vv[i] << 16; } else { kw[i >> 1] = f2bf(ke); vw[i >> 1] = vv[i]; }
    }
    { LAS u32x4* kp = (LAS u32x4*)(KET + k * 72 + 16 * I); kp[0] = (u32x4){kw[0], kw[1], kw[2], kw[3]}; kp[1] = (u32x4){kw[4], kw[5], kw[6], kw[7]};
      LAS u32x4* vp = (LAS u32x4*)(VT + k * 72 + 16 * I); vp[0] = (u32x4){vw[0], vw[1], vw[2], vw[3]}; vp[1] = (u32x4){vw[4], vw[5], vw[6], vw[7]}; }
    if (I == 0) G[(size_t)u * 128 + k] = (tp0 * tp1) * (tp2 * tp3);
    __syncthreads();
    const int l15 = lane & 15, l4 = lane >> 4;
#pragma unroll
    for (int i = 0; i < 2; ++i) { const int id = tid + NTHR * i, row = id >> 4, cc = id & 15;
        *(u32x4*)(qe_out + (size_t)(t0 + row) * 512 + cb + cc * 8) = *(const LAS u32x4*)(QA + row * 136 + cc * 8); }
    for (int blk = wid; blk < 10; blk += 8) {
        const int Ip = (blk >= 6) ? 3 : (blk >= 3) ? 2 : (blk >= 1) ? 1 : 0, J = blk - Ip * (Ip + 1) / 2;
        f32x4 acc = {0.f, 0.f, 0.f, 0.f};
#pragma unroll
        for (int ks = 0; ks < 4; ++ks) {
            const bf16x8 x = *(const LAS bf16x8*)(QA + (J * 64 + 16 * Ip + l15) * 136 + 32 * ks + 8 * l4);
            const bf16x8 y = *(const LAS bf16x8*)(KD + (16 * J + l15) * 136 + 32 * ks + 8 * l4);
            acc = MFMA16(x, y, acc);
        }
#pragma unroll
        for (int ii = 0; ii < 4; ++ii) { const int tl = 4 * l4 + ii; const float val = (Ip == J && l15 > tl) ? 0.f : acc[ii]; AT[(16 * Ip + tl) * 72 + 16 * J + l15] = f2bf(val); }
    }
    __syncthreads();
    { const int tb = wid & 3, vb0 = (wid >> 2) * 4;
      const bf16x8 x0 = *(const LAS bf16x8*)(AT + (16 * tb + l15) * 72 + 8 * l4), x1 = *(const LAS bf16x8*)(AT + (16 * tb + l15) * 72 + 32 + 8 * l4);
#pragma unroll
      for (int j = 0; j < 4; ++j) { const int vb = vb0 + j;
          const bf16x8 y0 = *(const LAS bf16x8*)(VT + (16 * vb + l15) * 72 + 8 * l4), y1 = *(const LAS bf16x8*)(VT + (16 * vb + l15) * 72 + 32 + 8 * l4);
          f32x4 acc = {0.f, 0.f, 0.f, 0.f}; acc = MFMA16(y0, x0, acc); acc = MFMA16(y1, x1, acc);
          u32x2 w; w[0] = pk2(acc[0], acc[1]); w[1] = pk2(acc[2], acc[3]);
          *(u32x2*)(intra_out + (size_t)(t0 + 16 * tb + l15) * 512 + cb + 16 * vb + 4 * l4) = w; } }
    { const int kb = wid;
      const bf16x8 x0 = *(const LAS bf16x8*)(KET + (16 * kb + l15) * 72 + 8 * l4), x1 = *(const LAS bf16x8*)(KET + (16 * kb + l15) * 72 + 32 + 8 * l4);
#pragma unroll
      for (int vb = 0; vb < 8; ++vb) {
          const bf16x8 y0 = *(const LAS bf16x8*)(VT + (16 * vb + l15) * 72 + 8 * l4), y1 = *(const LAS bf16x8*)(VT + (16 * vb + l15) * 72 + 32 + 8 * l4);
          f32x4 acc = {0.f, 0.f, 0.f, 0.f}; acc = MFMA16(x0, y0, acc); acc = MFMA16(x1, y1, acc);
          u32x2 w; w[0] = pk2(acc[0], acc[1]); w[1] = pk2(acc[2], acc[3]);
          *(u32x2*)(Ub + (size_t)u * 16384 + (16 * vb + l15) * 128 + 16 * kb + 4 * l4) = w; } }
    __syncthreads();
    }
#undef H1_LOAD
}

__device__ __forceinline__ void h2_phase(bf16_t* Ub, const float* __restrict__ G, int bid, int Gn) {
    const int gt = bid * NTHR + threadIdx.x, NT_ = Gn * NTHR;
    for (int e4 = gt; e4 < 131072; e4 += NT_) {
        const int bh = e4 >> 12, e = (e4 & 4095) * 4, k = e & 127;
        bf16_t* p = Ub + (size_t)bh * 64 * 16384 + e; const float* gp = G + (size_t)bh * 64 * 128 + k;
        float s0 = 0.f, s1 = 0.f, s2 = 0.f, s3 = 0.f;
#pragma unroll 1
        for (int c0 = 0; c0 < 64; c0 += 16) {
            u32x2 uv[16]; f32x4 g[16];
#pragma unroll
            for (int j = 0; j < 16; ++j) { uv[j] = *(const u32x2*)(p + (size_t)(c0 + j) * 16384); g[j] = *(const f32x4*)(gp + (c0 + j) * 128); }
#pragma unroll
            for (int j = 0; j < 16; ++j) {
                u32x2 w; w[0] = pk2(s0, s1); w[1] = pk2(s2, s3); *(u32x2*)(p + (size_t)(c0 + j) * 16384) = w;
                s0 = g[j][0] * s0 + bflo(uv[j][0]); s1 = g[j][1] * s1 + bfhi(uv[j][0]); s2 = g[j][2] * s2 + bflo(uv[j][1]); s3 = g[j][3] * s3 + bfhi(uv[j][1]);
            }
        }
    }
}

__device__ __forceinline__ void h3_unit(int j, const bf16_t* qe, const bf16_t* intra, const bf16_t* Ub, const bf16_t* hg, const float* gn, bf16_t* out) {
    const int tid = threadIdx.x, lane = tid & 63, wid = __builtin_amdgcn_readfirstlane(tid >> 6), l15 = lane & 15, l4 = lane >> 4;
    const int b = j >> 6, c = j & 63, t0 = b * SEQ + c * 64;
#pragma unroll 1
    for (int cc = 0; cc < 2; ++cc) {
        const int combo = 2 * wid + cc, head = combo >> 2, tb = combo & 3, u = (b * 4 + head) * 64 + c;
        const size_t rbase = (size_t)(t0 + 16 * tb + l15) * 512 + head * 128;
        bf16x8 x[4];
#pragma unroll
        for (int ks = 0; ks < 4; ++ks) x[ks] = *(const bf16x8*)(qe + rbase + 8 * l4 + 32 * ks);
        u32x2 iv[8], gv[8];
#pragma unroll
        for (int vb = 0; vb < 8; ++vb) { iv[vb] = *(const u32x2*)(intra + rbase + 16 * vb + 4 * l4); gv[vb] = *(const u32x2*)(hg + rbase + 16 * vb + 4 * l4); }
        const bf16_t* ub = Ub + (size_t)u * 16384 + l15 * 128 + 8 * l4;
        f32x4 acc[8];
#pragma unroll
        for (int vb = 0; vb < 8; ++vb) { acc[vb] = (f32x4){0.f, 0.f, 0.f, 0.f};
#pragma unroll
            for (int ks = 0; ks < 4; ++ks) { const bf16x8 y = *(const bf16x8*)(ub + vb * 2048 + 32 * ks); acc[vb] = MFMA16(y, x[ks], acc[vb]); } }
        float ss = 0.f;
#pragma unroll
        for (int vb = 0; vb < 8; ++vb) { acc[vb][0] += bflo(iv[vb][0]); acc[vb][1] += bfhi(iv[vb][0]); acc[vb][2] += bflo(iv[vb][1]); acc[vb][3] += bfhi(iv[vb][1]);
            ss += (acc[vb][0] * acc[vb][0] + acc[vb][1] * acc[vb][1]) + (acc[vb][2] * acc[vb][2] + acc[vb][3] * acc[vb][3]); }
        ss += __shfl_xor(ss, 16); ss += __shfl_xor(ss, 32);
        const float rstd = rsqrtf(ss * (1.f / 128.f) + 1e-6f);
#pragma unroll
        for (int vb = 0; vb < 8; ++vb) { const f32x4 gnv = *(const f32x4*)(gn + 16 * vb + 4 * l4);
            const float g0 = bflo(gv[vb][0]), g1 = bfhi(gv[vb][0]), g2 = bflo(gv[vb][1]), g3 = bfhi(gv[vb][1]);
            u32x2 w; w[0] = pk2(acc[vb][0] * rstd * gnv[0] * (g0 * sigmoidf_(g0)), acc[vb][1] * rstd * gnv[1] * (g1 * sigmoidf_(g1)));
            w[1] = pk2(acc[vb][2] * rstd * gnv[2] * (g2 * sigmoidf_(g2)), acc[vb][3] * rstd * gnv[3] * (g3 * sigmoidf_(g3)));
            *(u32x2*)(out + (size_t)(t0 + 16 * tb + l15) * 1024 + 512 + head * 128 + 16 * vb + 4 * l4) = w; }
    }
}

__device__ __forceinline__ void qk_prep_phase(const Args& a, int bid, int G) {
    unsigned char* ws = a.ws;
    const bf16_t* qraw = (const bf16_t*)a.out; const bf16_t* knope = (const bf16_t*)(ws + SL(2)); const bf16_t* krope = (const bf16_t*)(ws + SL(5)) + 256;
    bf16_t* Q = (bf16_t*)(ws + SL(3)); bf16_t* K = (bf16_t*)((unsigned char*)a.out + 64 * MiB);
    const int* positions = (const int*)a.in[2]; const float* gq = a.in[11]; const float* gk = a.in[12];
    const int lane = threadIdx.x & 63, wid = threadIdx.x >> 6, h = lane >> 3, c = lane & 7, c3 = c & 3;
    const float QS = 0.10206207261596577f * 1.4426950408889634f;
    float gqn[8], gkn[8], gqr[4], gkr[4], invf[4];
#pragma unroll
    for (int j = 0; j < 8; ++j) { gqn[j] = gq[8 * c + j] * QS; gkn[j] = gk[8 * c + j]; }
#pragma unroll
    for (int j = 0; j < 4; ++j) { gqr[j] = gq[64 + 4 * c + j] * QS; gkr[j] = gk[64 + 4 * c + j];
        invf[j] = (c3 == 0) ? a.invf[j] : (c3 == 1) ? a.invf[4 + j] : (c3 == 2) ? a.invf[8 + j] : a.invf[12 + j]; }
    const int gw = bid * 8 + wid, NGW = G * 8;
#pragma unroll 2
    for (int m = gw; m < T; m += NGW) {
        const int b = m >> 12, s = m & 4095;
        const u32x4 qn = *(const u32x4*)(qraw + (size_t)m * 768 + h * 96 + 8 * c); const u32x2 qr = *(const u32x2*)(qraw + (size_t)m * 768 + h * 96 + 64 + 4 * c);
        const u32x4 kn = *(const u32x4*)(knope + (size_t)m * 512 + h * 64 + 8 * c); const u32x2 kr = *(const u32x2*)(krope + (size_t)m * 512 + 4 * c);
        const float posf = (float)positions[m];
        float cs[4], sn[4];
#pragma unroll
        for (int j = 0; j < 4; ++j) { const float ang = posf * invf[j]; double rv = (double)ang * 0.15915494309189535; rv -= __builtin_rint(rv);
            const float fr = (float)rv; sn[j] = __builtin_amdgcn_sinf(fr); cs[j] = __builtin_amdgcn_cosf(fr); }
        size_t ob = ((size_t)(b * 8 + h) * SEQ + s) * 96;
        { float v[8], w[4]; float ss = 0.f;
#pragma unroll
          for (int e = 0; e < 4; ++e) { v[2 * e] = bflo(qn[e]); v[2 * e + 1] = bfhi(qn[e]); ss += v[2 * e] * v[2 * e] + v[2 * e + 1] * v[2 * e + 1]; }
          w[0] = bflo(qr[0]); w[1] = bfhi(qr[0]); w[2] = bflo(qr[1]); w[3] = bfhi(qr[1]); ss += (w[0] * w[0] + w[1] * w[1]) + (w[2] * w[2] + w[3] * w[3]);
          ss += __shfl_xor(ss, 1); ss += __shfl_xor(ss, 2); ss += __shfl_xor(ss, 4);
          const float rstd = rsqrtf(ss * (1.f / 96.f) + 1e-6f);
          u32x4 o; o[0] = pk2(v[0] * rstd * gqn[0], v[1] * rstd * gqn[1]); o[1] = pk2(v[2] * rstd * gqn[2], v[3] * rstd * gqn[3]);
          o[2] = pk2(v[4] * rstd * gqn[4], v[5] * rstd * gqn[5]); o[3] = pk2(v[6] * rstd * gqn[6], v[7] * rstd * gqn[7]);
          float rot[4];
#pragma unroll
          for (int j = 0; j < 4; ++j) { const float n1 = w[j] * rstd * gqr[j], pr = __shfl_xor(n1, 4); rot[j] = (c & 4) ? (n1 * cs[j] + pr * sn[j]) : (n1 * cs[j] - pr * sn[j]); }
          u32x2 o2; o2[0] = pk2(rot[0], rot[1]); o2[1] = pk2(rot[2], rot[3]);
          *(u32x4*)(Q + ob + 8 * c) = o; *(u32x2*)(Q + ob + 64 + 4 * c) = o2; }
        { float v[8], w[4]; float ss = 0.f;
#pragma unroll
          for (int e = 0; e < 4; ++e) { v[2 * e] = bflo(kn[e]); v[2 * e + 1] = bfhi(kn[e]); ss += v[2 * e] * v[2 * e] + v[2 * e + 1] * v[2 * e + 1]; }
          w[0] = bflo(kr[0]); w[1] = bfhi(kr[0]); w[2] = bflo(kr[1]); w[3] = bfhi(kr[1]); ss += (w[0] * w[0] + w[1] * w[1]) + (w[2] * w[2] + w[3] * w[3]);
          ss += __shfl_xor(ss, 1); ss += __shfl_xor(ss, 2); ss += __shfl_xor(ss, 4);
          const float rstd = rsqrtf(ss * (1.f / 96.f) + 1e-6f);
          u32x4 o; o[0] = pk2(v[0] * rstd * gkn[0], v[1] * rstd * gkn[1]); o[1] = pk2(v[2] * rstd * gkn[2], v[3] * rstd * gkn[3]);
          o[2] = pk2(v[4] * rstd * gkn[4], v[5] * rstd * gkn[5]); o[3] = pk2(v[6] * rstd * gkn[6], v[7] * rstd * gkn[7]);
          float rot[4];
#pragma unroll
          for (int j = 0; j < 4; ++j) { const float n1 = w[j] * rstd * gkr[j], pr = __shfl_xor(n1, 4); rot[j] = (c & 4) ? (n1 * cs[j] + pr * sn[j]) : (n1 * cs[j] - pr * sn[j]); }
          u32x2 o2; o2[0] = pk2(rot[0], rot[1]); o2[1] = pk2(rot[2], rot[3]);
          *(u32x4*)(K + ob + 8 * c) = o; *(u32x2*)(K + ob + 64 + 4 * c) = o2; }
    }
}

__device__ __forceinline__ int crow(int r, int hi) { return (r & 3) + 8 * (r >> 2) + 4 * hi; }
template <bool FIX> __device__ __forceinline__ void attn_unit(const bf16_t* Q, const bf16_t* K, const bf16_t* Vt, bf16_t* O, int bh, int qb, float mfix, LAS unsigned char* lds) {
    const int tid = threadIdx.x, lane = tid & 63, wid = __builtin_amdgcn_readfirstlane(tid >> 6), r = lane & 31, hh = lane >> 5;
    LAS bf16_t* Kb = (LAS bf16_t*)lds;
    LAS bf16_t* Vb = (LAS bf16_t*)(lds + 2 * 64 * 104 * 2);
    const bf16_t* Qh = Q + (size_t)bh * SEQ * 96; const bf16_t* Kh = K + (size_t)bh * SEQ * 96; const bf16_t* Vh = Vt + (size_t)(bh & 7) * 64 * T + (size_t)(bh >> 3) * SEQ;
    const int q0 = qb * 256, qw = q0 + wid * 32, NTL = 4 * (qb + 1);
    bf16x8 qf[6];
#pragma unroll
    for (int d0 = 0; d0 < 6; ++d0) qf[d0] = *(const bf16x8*)(Qh + (size_t)(qw + r) * 96 + 16 * d0 + 8 * hh);
    f32x16 o0, o1;
#pragma unroll
    for (int i = 0; i < 16; ++i) { o0[i] = 0.f; o1[i] = 0.f; }
    float mrun = -1e30f, lrun = 0.f;
    f32x16 cinit;
#pragma unroll
    for (int i = 0; i < 16; ++i) cinit[i] = FIX ? -mfix : 0.f;
    asm volatile("" : "+v"(cinit));
    const int c2 = 512 + tid, kr1 = tid / 12, kc1 = tid % 12, kr2 = c2 / 12, kc2 = c2 % 12, vr = tid >> 3, vc = tid & 7;
    u32x4 kA, kB = {0u, 0u, 0u, 0u}, vA;
#define ATT_LOADG(t) do { kA = *(const u32x4*)(Kh + (size_t)(t) * 6144 + tid * 8); if (tid < 256) kB = *(const u32x4*)(Kh + (size_t)(t) * 6144 + c2 * 8); \
        vA = *(const u32x4*)(Vh + (size_t)vr * T + 64 * (t) + vc * 8); } while (0)
#define ATT_STORE(buf) do { *(LAS u32x4*)(Kb + (buf) * 6656 + kr1 * 104 + kc1 * 8) = kA; if (tid < 256) *(LAS u32x4*)(Kb + (buf) * 6656 + kr2 * 104 + kc2 * 8) = kB; \
        *(LAS u32x2*)(Vb + (buf) * 4352 + vr * 68 + vc * 8) = (u32x2){vA[0], vA[1]}; *(LAS u32x2*)(Vb + (buf) * 4352 + vr * 68 + vc * 8 + 4) = (u32x2){vA[2], vA[3]}; } while (0)
    ATT_LOADG(0); ATT_STORE(0); __syncthreads();
    for (int t = 0; t < NTL; ++t) {
        const int buf = t & 1;
        if (t + 1 < NTL) ATT_LOADG(t + 1);
        if (64 * t <= qw + 31) {
            f32x16 s0, s1;
            const LAS bf16_t* kp = Kb + buf * 6656 + r * 104 + 8 * hh;
#pragma unroll
            for (int d0 = 0; d0 < 6; ++d0) {
                const bf16x8 a0 = *(const LAS bf16x8*)(kp + 16 * d0), a1 = *(const LAS bf16x8*)(kp + 32 * 104 + 16 * d0);
                if (d0 == 0) { s0 = MFMA32(a0, qf[0], cinit); s1 = MFMA32(a1, qf[0], cinit); }
                else { s0 = MFMA32(a0, qf[d0], s0); s1 = MFMA32(a1, qf[d0], s1); }
            }
            if (64 * t + 63 > qw) {
                const int qrow = qw + r;
#pragma unroll
                for (int i = 0; i < 16; ++i) { const int kv = 64 * t + crow(i, hh); if (kv > qrow) s0[i] = -1e30f; if (kv + 32 > qrow) s1[i] = -1e30f; }
            }
            if constexpr (FIX) {
                f32x2_t l2 = {0.f, 0.f};
#pragma unroll
                for (int i = 0; i < 16; i += 2) { s0[i] = __builtin_amdgcn_exp2f(s0[i]); s0[i + 1] = __builtin_amdgcn_exp2f(s0[i + 1]); s1[i] = __builtin_amdgcn_exp2f(s1[i]); s1[i + 1] = __builtin_amdgcn_exp2f(s1[i + 1]);
                    l2 += (f32x2_t){s0[i], s0[i + 1]}; l2 += (f32x2_t){s1[i], s1[i + 1]}; }
                lrun += l2[0] + l2[1];
            } else {
            float mx = s0[0];
#pragma unroll
            for (int i = 1; i < 16; ++i) mx = fmaxf(mx, s0[i]);
#pragma unroll
            for (int i = 0; i < 16; ++i) mx = fmaxf(mx, s1[i]);
            mx = fmaxf(mx, __shfl_xor(mx, 32));
            const float mnew = fmaxf(mrun, mx), alpha = __builtin_amdgcn_exp2f(mrun - mnew);
            mrun = mnew;
            float ls = 0.f;
#pragma unroll
            for (int i = 0; i < 16; ++i) { s0[i] = __builtin_amdgcn_exp2f(s0[i] - mnew); s1[i] = __builtin_amdgcn_exp2f(s1[i] - mnew); ls += s0[i] + s1[i]; }
            lrun = lrun * alpha + ls;
            if (__any(alpha != 1.0f)) {
#pragma unroll
                for (int i = 0; i < 16; ++i) { const float ai = __shfl(alpha, crow(i, hh)); o0[i] *= ai; o1[i] *= ai; } }
            }
            u32x4 pw[4];
#pragma unroll
            for (int e = 0; e < 4; ++e) { pw[0][e] = pk2(s0[2 * e], s0[2 * e + 1]); pw[1][e] = pk2(s0[8 + 2 * e], s0[8 + 2 * e + 1]); pw[2][e] = pk2(s1[2 * e], s1[2 * e + 1]); pw[3][e] = pk2(s1[8 + 2 * e], s1[8 + 2 * e + 1]); }
            const LAS bf16_t* vp = Vb + buf * 4352 + r * 68 + 4 * hh;
#pragma unroll
            for (int ks = 0; ks < 4; ++ks) {
                const u32x2 va0 = *(const LAS u32x2*)(vp + 16 * ks), va1 = *(const LAS u32x2*)(vp + 16 * ks + 8), vb0 = *(const LAS u32x2*)(vp + 32 * 68 + 16 * ks), vb1 = *(const LAS u32x2*)(vp + 32 * 68 + 16 * ks + 8);
                const bf16x8 v0 = __builtin_bit_cast(bf16x8, (u32x4){va0[0], va0[1], va1[0], va1[1]}), v1 = __builtin_bit_cast(bf16x8, (u32x4){vb0[0], vb0[1], vb1[0], vb1[1]});
                const bf16x8 pf = __builtin_bit_cast(bf16x8, pw[ks]);
                o0 = MFMA32(pf, v0, o0); o1 = MFMA32(pf, v1, o1);
            }
        }
        if (t + 1 < NTL) ATT_STORE(buf ^ 1);
        __syncthreads();
    }
#undef ATT_LOADG
#undef ATT_STORE
    const float ltot = lrun + __shfl_xor(lrun, 32), inv = 1.0f / ltot;
    const int b = bh >> 3, head = bh & 7;
#pragma unroll
    for (int i = 0; i < 16; ++i) { const int qr = crow(i, hh); const float f = __shfl(inv, qr);
        bf16_t* op = O + (size_t)(b * SEQ + qw + qr) * 1024 + head * 64 + r;
        op[0] = f2bf(o0[i] * f); op[32] = f2bf(o1[i] * f); }
}

__device__ __forceinline__ void attn_unit64(const bf16_t* Q, const bf16_t* K, const bf16_t* Vt, bf16_t* O, int bh, int qb8, float mfix, LAS unsigned char* lds) {
    const int tid = threadIdx.x, lane = tid & 63, wid = __builtin_amdgcn_readfirstlane(tid >> 6), r = lane & 31, hh = lane >> 5;
    LAS bf16_t* Kb = (LAS bf16_t*)lds;
    LAS bf16_t* Vb = (LAS bf16_t*)(lds + 2 * 64 * 104 * 2);
    const bf16_t* Qh = Q + (size_t)bh * SEQ * 96; const bf16_t* Kh = K + (size_t)bh * SEQ * 96; const bf16_t* Vh = Vt + (size_t)(bh & 7) * 64 * T + (size_t)(bh >> 3) * SEQ;
    const int q0 = qb8 * 512, qw = q0 + wid * 64, NTL = 8 * (qb8 + 1), tmaxw = 8 * qb8 + wid;
    LAS bf16x8* Qs = (LAS bf16x8*)(lds + 2 * 64 * 104 * 2 + 2 * 64 * 68 * 2) + tid;
#pragma unroll
    for (int d0 = 0; d0 < 6; ++d0) { Qs[512 * d0] = *(const bf16x8*)(Qh + (size_t)(qw + r) * 96 + 16 * d0 + 8 * hh); Qs[512 * (6 + d0)] = *(const bf16x8*)(Qh + (size_t)(qw + 32 + r) * 96 + 16 * d0 + 8 * hh); }
    f32x16 oA0, oA1, oB0, oB1;
#pragma unroll
    for (int i = 0; i < 16; ++i) { oA0[i] = 0.f; oA1[i] = 0.f; oB0[i] = 0.f; oB1[i] = 0.f; }
    float lA = 0.f, lB = 0.f;
    const int c2 = 512 + tid, kr1 = tid / 12, kc1 = tid % 12, kr2 = c2 / 12, kc2 = c2 % 12, vr = tid >> 3, vc = tid & 7;
    u32x4 kA, kB = {0u, 0u, 0u, 0u}, vA;
#define ATT_LOADG(t) do { kA = *(const u32x4*)(Kh + (size_t)(t) * 6144 + tid * 8); if (tid < 256) kB = *(const u32x4*)(Kh + (size_t)(t) * 6144 + c2 * 8); \
        vA = *(const u32x4*)(Vh + (size_t)vr * T + 64 * (t) + vc * 8); } while (0)
#define ATT_STORE(buf) do { *(LAS u32x4*)(Kb + (buf) * 6656 + kr1 * 104 + kc1 * 8) = kA; if (tid < 256) *(LAS u32x4*)(Kb + (buf) * 6656 + kr2 * 104 + kc2 * 8) = kB; \
        *(LAS u32x2*)(Vb + (buf) * 4352 + vr * 68 + vc * 8) = (u32x2){vA[0], vA[1]}; *(LAS u32x2*)(Vb + (buf) * 4352 + vr * 68 + vc * 8 + 4) = (u32x2){vA[2], vA[3]}; } while (0)
    ATT_LOADG(0); ATT_STORE(0); __syncthreads();
    for (int t = 0; t < NTL; ++t) {
        const int buf = t & 1;
        if (t + 1 < NTL) ATT_LOADG(t + 1);
        if (t <= tmaxw) {
            const LAS bf16_t* kp = Kb + buf * 6656 + r * 104 + 8 * hh;
            const LAS bf16_t* vp = Vb + buf * 4352 + r * 68 + 4 * hh;
#pragma unroll
            for (int half = 0; half < 2; ++half) {
                f32x16 sA, sB;
#pragma unroll
                for (int i = 0; i < 16; ++i) { sA[i] = -mfix; sB[i] = -mfix; }
#pragma unroll
                for (int d0 = 0; d0 < 6; ++d0) { const bf16x8 a = *(const LAS bf16x8*)(kp + half * 32 * 104 + 16 * d0); const bf16x8 qa_ = Qs[512 * d0], qb_ = Qs[512 * (6 + d0)]; sA = MFMA32(a, qa_, sA); sB = MFMA32(a, qb_, sB); }
                if (t == tmaxw) {
                    const int rowA = qw + r, rowB = qw + 32 + r;
#pragma unroll
                    for (int i = 0; i < 16; ++i) { const int kv = 64 * t + 32 * half + crow(i, hh); if (kv > rowA) sA[i] = -1e30f; if (kv > rowB) sB[i] = -1e30f; }
                }
                float la = 0.f, lb_ = 0.f;
#pragma unroll
                for (int i = 0; i < 16; ++i) { sA[i] = __builtin_amdgcn_exp2f(sA[i]); sB[i] = __builtin_amdgcn_exp2f(sB[i]); la += sA[i]; lb_ += sB[i]; }
                lA += la; lB += lb_;
                u32x4 pwA[2], pwB[2];
#pragma unroll
                for (int e = 0; e < 4; ++e) { pwA[0][e] = pk2(sA[2 * e], sA[2 * e + 1]); pwA[1][e] = pk2(sA[8 + 2 * e], sA[8 + 2 * e + 1]); pwB[0][e] = pk2(sB[2 * e], sB[2 * e + 1]); pwB[1][e] = pk2(sB[8 + 2 * e], sB[8 + 2 * e + 1]); }
#pragma unroll
                for (int k2 = 0; k2 < 2; ++k2) { const int ks = 2 * half + k2;
                    const u32x2 va0 = *(const LAS u32x2*)(vp + 16 * ks), va1 = *(const LAS u32x2*)(vp + 16 * ks + 8), vb0 = *(const LAS u32x2*)(vp + 32 * 68 + 16 * ks), vb1 = *(const LAS u32x2*)(vp + 32 * 68 + 16 * ks + 8);
                    const bf16x8 v0 = __builtin_bit_cast(bf16x8, (u32x4){va0[0], va0[1], va1[0], va1[1]}), v1 = __builtin_bit_cast(bf16x8, (u32x4){vb0[0], vb0[1], vb1[0], vb1[1]});
                    const bf16x8 pfA = __builtin_bit_cast(bf16x8, pwA[k2]), pfB = __builtin_bit_cast(bf16x8, pwB[k2]);
                    oA0 = MFMA32(pfA, v0, oA0); oA1 = MFMA32(pfA, v1, oA1); oB0 = MFMA32(pfB, v0, oB0); oB1 = MFMA32(pfB, v1, oB1); }
                __builtin_amdgcn_sched_barrier(0);
            }
        }
        if (t + 1 < NTL) ATT_STORE(buf ^ 1);
        __syncthreads();
    }
#undef ATT_LOADG
#undef ATT_STORE
    const float ltA = lA + __shfl_xor(lA, 32), ltB = lB + __shfl_xor(lB, 32), invA = 1.0f / ltA, invB = 1.0f / ltB;
    const int b = bh >> 3, head = bh & 7;
#pragma unroll
    for (int i = 0; i < 16; ++i) { const int qr = crow(i, hh); const float fA = __shfl(invA, qr), fB = __shfl(invB, qr);
        bf16_t* opA = O + (size_t)(b * SEQ + qw + qr) * 1024 + head * 64 + r; bf16_t* opB = opA + (size_t)32 * 1024;
        opA[0] = f2bf(oA0[i] * fA); opA[32] = f2bf(oA1[i] * fA); opB[0] = f2bf(oB0[i] * fB); opB[32] = f2bf(oB1[i] * fB); }
}

__device__ __forceinline__ void conv_phase(const Args& a, int tile0, int ntile, int bid, int G) {
    const bf16_t* UH = (const bf16_t*)(a.ws + WS_UH); bf16_t* act = (bf16_t*)(a.ws + WS_ACT);
    const float* cw = a.in[20]; const float* cbias = a.in[21];
    const int gt = bid * NTHR + threadIdx.x, NT_ = G * NTHR;
    const int nit = ntile * 4096 * 16;
    for (int it = gt; it < nit; it += NT_) {
        const int jj = it & 15, tblk = (it >> 4) & 4095, pn = it >> 16;
        const int ch0 = 128 * (tile0 + pn) + 8 * jj, t0 = tblk * 8;
        const bf16_t* up = UH + (size_t)pn * T * 256 + 8 * jj;
        u32x4 gr[10], vr[10];
        const bool first = (t0 & 4095) == 0;
#pragma unroll
        for (int i = 0; i < 10; ++i) { const int t = t0 - 2 + i;
            if (i >= 2 || !first) { gr[i] = *(const u32x4*)(up + (size_t)t * 256); vr[i] = *(const u32x4*)(up + (size_t)t * 256 + 128); }
            else { gr[i] = (u32x4){0u, 0u, 0u, 0u}; vr[i] = (u32x4){0u, 0u, 0u, 0u}; } }
        f32x4 wg[3][2], wv[3][2], bg[2], bv[2];
#pragma unroll
        for (int j = 0; j < 3; ++j)
#pragma unroll
            for (int e = 0; e < 2; ++e) { wg[j][e] = *(const f32x4*)(cw + j * NUP + ch0 + 4 * e); wv[j][e] = *(const f32x4*)(cw + j * NUP + DFF + ch0 + 4 * e); }
#pragma unroll
        for (int e = 0; e < 2; ++e) { bg[e] = *(const f32x4*)(cbias + ch0 + 4 * e); bv[e] = *(const f32x4*)(cbias + DFF + ch0 + 4 * e); }
#pragma unroll
        for (int i = 0; i < 8; ++i) {
            u32x4 w;
#pragma unroll
            for (int e = 0; e < 4; ++e) {
                const int q4 = e >> 1, c0 = 2 * (e & 1);
                const float yg0 = bg[q4][c0] + wg[0][q4][c0] * bflo(gr[i][e]) + wg[1][q4][c0] * bflo(gr[i + 1][e]) + wg[2][q4][c0] * bflo(gr[i + 2][e]);
                const float yg1 = bg[q4][c0 + 1] + wg[0][q4][c0 + 1] * bfhi(gr[i][e]) + wg[1][q4][c0 + 1] * bfhi(gr[i + 1][e]) + wg[2][q4][c0 + 1] * bfhi(gr[i + 2][e]);
                const float yv0 = bv[q4][c0] + wv[0][q4][c0] * bflo(vr[i][e]) + wv[1][q4][c0] * bflo(vr[i + 1][e]) + wv[2][q4][c0] * bflo(vr[i + 2][e]);
                const float yv1 = bv[q4][c0 + 1] + wv[0][q4][c0 + 1] * bfhi(vr[i][e]) + wv[1][q4][c0 + 1] * bfhi(vr[i + 1][e]) + wv[2][q4][c0 + 1] * bfhi(vr[i + 2][e]);
                w[e] = pk2(yg0 * sigmoidf_(yg0) * yv0, yg1 * sigmoidf_(yg1) * yv1);
            }
            *(u32x4*)(act + (size_t)(t0 + i) * DFF + ch0) = w;
        }
    }
}

__device__ __forceinline__ void conv_fix_phase(const Args& a, int bid, int G) {
    const bf16_t* edge = (const bf16_t*)(a.ws + WS_UH); bf16_t* act = (bf16_t*)(a.ws + WS_ACT);
    const float* cw = a.in[20]; const float* cbias = a.in[21];
    const int gt = bid * NTHR + threadIdx.x, NT_ = G * NTHR;
    for (int it = gt; it < 512 * 352; it += NT_) {
        const int cg8 = it % 352, st = it / 352, ch0 = cg8 * 8, pn = ch0 >> 7, j = ch0 & 127, gcol = 256 * pn + j;
        u32x4 gr[4], vr[4];
        const bool first = (st & 63) == 0;
#pragma unroll
        for (int i = 0; i < 4; ++i) {
            if (i >= 2) { const bf16_t* p = edge + ((size_t)st * 4 + (i - 2)) * 5632 + gcol; gr[i] = *(const u32x4*)p; vr[i] = *(const u32x4*)(p + 128); }
            else if (!first) { const bf16_t* p = edge + ((size_t)(st - 1) * 4 + 2 + i) * 5632 + gcol; gr[i] = *(const u32x4*)p; vr[i] = *(const u32x4*)(p + 128); }
            else { gr[i] = (u32x4){0u, 0u, 0u, 0u}; vr[i] = (u32x4){0u, 0u, 0u, 0u}; } }
        f32x4 wg[3][2], wv[3][2], bg[2], bv[2];
#pragma unroll
        for (int jx = 0; jx < 3; ++jx)
#pragma unroll
            for (int e = 0; e < 2; ++e) { wg[jx][e] = *(const f32x4*)(cw + jx * NUP + ch0 + 4 * e); wv[jx][e] = *(const f32x4*)(cw + jx * NUP + DFF + ch0 + 4 * e); }
#pragma unroll
        for (int e = 0; e < 2; ++e) { bg[e] = *(const f32x4*)(cbias + ch0 + 4 * e); bv[e] = *(const f32x4*)(cbias + DFF + ch0 + 4 * e); }
#pragma unroll
        for (int i = 0; i < 2; ++i) {
            u32x4 w;
#pragma unroll
            for (int e = 0; e < 4; ++e) {
                const int q4 = e >> 1, c0 = 2 * (e & 1);
                const float yg0 = bg[q4][c0] + wg[0][q4][c0] * bflo(gr[i][e]) + wg[1][q4][c0] * bflo(gr[i + 1][e]) + wg[2][q4][c0] * bflo(gr[i + 2][e]);
                const float yg1 = bg[q4][c0 + 1] + wg[0][q4][c0 + 1] * bfhi(gr[i][e]) + wg[1][q4][c0 + 1] * bfhi(gr[i + 1][e]) + wg[2][q4][c0 + 1] * bfhi(gr[i + 2][e]);
                const float yv0 = bv[q4][c0] + wv[0][q4][c0] * bflo(vr[i][e]) + wv[1][q4][c0] * bflo(vr[i + 1][e]) + wv[2][q4][c0] * bflo(vr[i + 2][e]);
                const float yv1 = bv[q4][c0 + 1] + wv[0][q4][c0 + 1] * bfhi(vr[i][e]) + wv[1][q4][c0 + 1] * bfhi(vr[i + 1][e]) + wv[2][q4][c0 + 1] * bfhi(vr[i + 2][e]);
                w[e] = pk2(yg0 * sigmoidf_(yg0) * yv0, yg1 * sigmoidf_(yg1) * yv1);
            }
            *(u32x4*)(act + (size_t)(st * 64 + i) * DFF + ch0) = w;
        }
    }
}

#define XB_TMO      128
#define XB_XCNT(j)  (256  + 64 * (j))
#define XB_XSUB(j)  (1280 + 64 * (j))
#define XB_XGEN(j)  (2304 + 64 * (j))
#define XB_TOP      3328
#define XB_TOPGEN   3392
#define XCD_BAR_WORDS 3456
#define XB_SPIN_CAP (1u << 18)

__device__ __forceinline__ unsigned xb_ld(unsigned* p)              { return __hip_atomic_load(p, __ATOMIC_RELAXED, __HIP_MEMORY_SCOPE_AGENT); }
__device__ __forceinline__ unsigned xb_add(unsigned* p, unsigned v) { return __hip_atomic_fetch_add(p, v, __ATOMIC_RELAXED, __HIP_MEMORY_SCOPE_AGENT); }
__device__ __forceinline__ unsigned xb_xcc_id() { return (unsigned)__builtin_amdgcn_s_getreg((3 << 11) | 20) & 0xFu; }
#define XB_SPIN(cond, bar) do { unsigned _sp = 0; while (cond) { __builtin_amdgcn_s_sleep(1); \
    if ((++_sp & 255u) == 0u) { if (xb_ld(&(bar)[XB_TMO])) break; if (_sp > XB_SPIN_CAP) { atomicAdd(&(bar)[XB_TMO], 1u); break; } } } } while (0)

struct XcdBarrier {
    unsigned* bar; unsigned x;
    volatile LAS unsigned* st;
};

__device__ __forceinline__ XcdBarrier xcd_barrier_post(unsigned* bar, volatile LAS unsigned* st) {
    XcdBarrier b; b.bar = bar; b.x = xb_xcc_id(); b.st = st;
    if (threadIdx.x == 0) (void)xb_add(&bar[XB_XCNT(b.x)], 1u);
    return b;
}
__device__ __forceinline__ void xcd_barrier_complete(unsigned* bar, unsigned x, unsigned& nloc, unsigned& nx) {
    const unsigned G = gridDim.x * gridDim.y * gridDim.z;
    unsigned sum, cnt, mine, sp = 0u;
    for (;;) {
        sum = 0u; cnt = 0u; mine = 0u;
#pragma unroll
        for (unsigned j = 0; j < 16; ++j) { const unsigned c = xb_ld(&bar[XB_XCNT(j)]); sum += c; cnt += (c > 0u) ? 1u : 0u; mine = (j == x) ? c : mine; }
        if (sum == G) break;
        __builtin_amdgcn_s_sleep(1);
        if ((++sp & 255u) == 0u) { if (xb_ld(&bar[XB_TMO])) break; if (sp > XB_SPIN_CAP) { atomicAdd(&bar[XB_TMO], 1u); break; } }
    }
    nloc = mine > 0u ? mine : 1u; nx = cnt > 0u ? cnt : 1u;
}

__device__ __forceinline__ void xcd_barrier(const XcdBarrier& b) {
    asm volatile("s_waitcnt vmcnt(0)" ::: "memory");
    __syncthreads();
    if (threadIdx.x == 0) {
        unsigned* bar = b.bar;
        __builtin_amdgcn_s_waitcnt(0);
        unsigned nloc = b.st[0], nx = b.st[1];
        if (nloc == 0u) { xcd_barrier_complete(bar, b.x, nloc, nx); b.st[0] = nloc; b.st[1] = nx; }
        const unsigned old = xb_add(&bar[XB_XSUB(b.x)], 1u);
        const unsigned gen = old / nloc;
        if (old + 1u == (gen + 1u) * nloc) {
            __builtin_amdgcn_fence(__ATOMIC_RELEASE, "agent");
            asm volatile("s_waitcnt vmcnt(0)" ::: "memory");
            const unsigned og = xb_add(&bar[XB_TOP], 1u);
            const unsigned tg = og / nx;
            if (og + 1u == (tg + 1u) * nx) xb_add(&bar[XB_TOPGEN], 1u);
            else XB_SPIN(xb_ld(&bar[XB_TOPGEN]) == tg, bar);
            __builtin_amdgcn_fence(__ATOMIC_ACQUIRE, "agent");
            xb_add(&bar[XB_XGEN(b.x)], 1u);
            asm volatile("s_waitcnt vmcnt(0)" ::: "memory");
        } else {
            XB_SPIN(xb_ld(&bar[XB_XGEN(b.x)]) == gen, bar);
            __builtin_amdgcn_fence(__ATOMIC_ACQUIRE, "agent");
            asm volatile("s_waitcnt vmcnt(0)" ::: "memory");
        }
    }
    __syncthreads();
}


__global__ void __launch_bounds__(NTHR) mk_fwd(Args a) {
    extern __shared__ __attribute__((aligned(16))) unsigned char lds_raw[];
    LAS unsigned char* lds = (LAS unsigned char*)lds_raw;
    cg::grid_group grid = cg::this_grid();
    const int bid = blockIdx.x, G = gridDim.x;
    volatile LAS unsigned* xst = (volatile LAS unsigned*)(lds + LDS_BYTES - 64);
    if (threadIdx.x < 16) xst[threadIdx.x] = 0u;
    __syncthreads();
    XcdBarrier xbar = xcd_barrier_post((unsigned*)(a.ws + WS_BAR), xst);
    unsigned char* ws = a.ws;
    const float* mod = (const float*)(ws + WS_MOD);
#define WSB(off) ((bf16_t*)(ws + (off)))
#ifndef MK_PHMASK
#define MK_PHMASK 0x1ffff
#endif
#define PHON(n) (((MK_PHMASK) >> (n)) & 1)
    const int lo = a.ph_lo, hi = a.ph_hi;
#define IN(k) (PHON(k) && lo <= (k) && (k) < hi)
#define SEAM(k) do { if ((k) + 1 < hi) xcd_barrier(xbar); } while (0)
    if (a.ph_lo < 0) grid.sync();
#ifndef MK_DUP
#define MK_DUP 0
#endif
#ifndef MK_XSYNC
#define MK_XSYNC 0
#endif
#define DUPON(n) (((MK_DUP) >> (n)) & 1)
#define PHASE(k, ...) if (IN(k)) { { __VA_ARGS__ } if (DUPON(k)) { __VA_ARGS__ } SEAM(k); }
    for (int xs_ = 0; xs_ < MK_XSYNC; ++xs_) grid.sync();
    PHASE(0,  p0_phase(a, lds, bid, G); )
    PHASE(1,  adaln_phase<false>(a.in[0], a.in[5], mod, 0, 1024, WSB(SL(2)), bid, G); )
    PHASE(2,  pg8::Gemm g{WSB(SL(2)), WSB(WS_WIN), T, NPROJ, 1024}; pg8::StaticOrder S; S.init(T, NPROJ, G, bid);
                 pg8::EpiBf16<0> E{WSB(SL(4)), 512, nullptr, 512, SLAB_EL, 1.f};
                 pg8::gemm_phase<pg8::EpiBf16<0>, pg8::StaticOrder, true, true>(lds, g, S, E); )
    PHASE(3,  lora_norm_phase(a, bid, G); if (DUPON(17)) lora_norm_phase(a, bid, G);
                 h1_phase(WSB(SL(6)), WSB(SL(7)), WSB(SL(8)), WSB(SL(6)), WSB(SL(7)), (const float*)(ws + WS_LB), WSB(SL(14)), (float*)(ws + WS_G), lds, bid, G);
                 if (DUPON(21)) h1_phase(WSB(SL(6)), WSB(SL(7)), WSB(SL(8)), (bf16_t*)a.out, (bf16_t*)a.out + SLAB_EL, (const float*)(ws + WS_LB), (bf16_t*)a.out + 2 * SLAB_EL, (float*)(ws + 40 * MiB), lds, bid, G); )
    PHASE(4,  { pg8::Gemm g{WSB(SL(4)), WSB(WS_WUQ), T, 768, 512}; pg8::StaticOrder S; S.init(T, 768, G, bid);
                 pg8::EpiRowScale E{(bf16_t*)a.out, 768, (const float*)(ws + WS_RSQ)};
                 pg8::gemm_phase<pg8::EpiRowScale, pg8::StaticOrder, true, true>(lds, g, S, E); }
               { pg8::Gemm g{WSB(SL(5)), WSB(WS_WUKV), T, 512, 256, 512}; pg8::StaticOrder S; S.init(T, 512, G, bid);
                 pg8::EpiRowScale E{WSB(SL(2)), 512, (const float*)(ws + WS_RSKV)};
                 pg8::gemm_phase<pg8::EpiRowScale, pg8::StaticOrder, true, true>(lds, g, S, E); }
               { pg8::Gemm g{WSB(WS_WUKV + 512 * 1024), WSB(SL(5)), 512, T, 256, 512}; pg8::StaticOrder S; S.init(512, T, G, bid);
                 pg8::EpiColScale E{WSB(SL(8)), T, (const float*)(ws + WS_RSKV)};
                 pg8::gemm_phase<pg8::EpiColScale, pg8::StaticOrder, true, true>(lds, g, S, E); } )
    PHASE(6,  qk_prep_phase(a, bid, G); if (DUPON(18)) qk_prep_phase(a, bid, G);
                 h2_phase(WSB(SL(14)), (const float*)(ws + WS_G), bid, G); )
    PHASE(7,  const bf16_t* Q = WSB(SL(3)); const bf16_t* K = (const bf16_t*)((unsigned char*)a.out + 64 * MiB); const bf16_t* Vt = WSB(SL(8)); bf16_t* O = (bf16_t*)a.out;
                 float mfix; { const int ln = threadIdx.x & 63; float gqm = fmaxf(fabsf(a.in[11][ln]), fabsf(a.in[11][64 + (ln & 31)])), gkm = fmaxf(fabsf(a.in[12][ln]), fabsf(a.in[12][64 + (ln & 31)]));
                     for (int o = 1; o < 64; o <<= 1) { gqm = fmaxf(gqm, __shfl_xor(gqm, o)); gkm = fmaxf(gkm, __shfl_xor(gkm, o)); }
                     mfix = 14.135f * 1.02f * gqm * gkm; }
                 const bool fix = mfix <= 40.f;
                 for (int rep = 0; rep < (DUPON(19) ? 2 : 1); ++rep) {
                 if (fix) { if (G == 256) { const int bh = bid >> 2, s = bid & 3; attn_unit64(Q, K, Vt, O, bh, 7 - s, mfix, lds); attn_unit64(Q, K, Vt, O, bh, s, mfix, lds); }
                            else { for (int j = bid; j < 512; j += G) attn_unit64(Q, K, Vt, O, j >> 3, 7 - (j & 7), mfix, lds); } }
                 else if (G == 256) { const int bh = bid >> 2, s = bid & 3;
                     for (int i = 0; i < 4; ++i) { const int qb = (i == 0) ? (15 - s) : (i == 1) ? (8 + s) : (i == 2) ? (7 - s) : s; attn_unit<false>(Q, K, Vt, O, bh, qb, mfix, lds); } }
                 else { for (int j = bid; j < 1024; j += G) attn_unit<false>(Q, K, Vt, O, j >> 4, 15 - (j & 15), mfix, lds); }
                 }
                 for (int j = bid; j < 512; j += G) h3_unit(j, WSB(SL(6)), WSB(SL(7)), WSB(SL(14)), WSB(SL(9)), a.in[14], (bf16_t*)a.out);
                 if (DUPON(20)) { for (int j = bid; j < 512; j += G) h3_unit(j, WSB(SL(6)), WSB(SL(7)), WSB(SL(14)), WSB(SL(9)), a.in[14], (bf16_t*)a.out); } )
    PHASE(8,  pg8::Gemm g{(const bf16_t*)a.out, WSB(WS_WA), T, 1024, 512, 1024}; pg8::PairOrder S; S.init(T, 1024, G, bid);
                 pg8::EpiBranchPair E{WSB(SL(10)), WSB(SL(12)), WSB(SL(2)), SLAB_EL};
                 pg8::gemm_phase<pg8::EpiBranchPair, pg8::PairOrder, true, true>(lds, g, S, E); )
    PHASE(10,  pg8::Gemm g{WSB(SL(2)), WSB(WS_WOUT), T, 1024, 1024}; pg8::StaticOrder S; S.init(T, 1024, G, bid);
                  pg8::EpiResGate<false, true> E{a.in[0], WSB(SL(14)), mod + 2048};
                  pg8::gemm_phase<pg8::EpiResGate<false, true>, pg8::StaticOrder, true, true>(lds, g, S, E); )
    PHASE(11,  adaln_phase<true>(WSB(SL(14)), a.in[18], mod, 3072, 4096, (bf16_t*)a.out, bid, G); )
    PHASE(12,  pg8::Gemm g{(const bf16_t*)a.out, WSB(WS_WUP), T, NUP, 1024}; pg8::StaticOrder S; S.init(T, NUP, G, bid);
                  pg8::EpiConvAct E{WSB(WS_ACT), WSB(WS_UH), a.in[20], a.in[21]};
                  pg8::gemm_phase<pg8::EpiConvAct, pg8::StaticOrder, true, true>(lds, g, S, E); )
    PHASE(13,  conv_fix_phase(a, bid, G); )
    PHASE(16,  pg8::Gemm g{WSB(WS_ACT), WSB(WS_WDOWN), T, 1024, DFF}; pg8::StaticOrder S; S.init(T, 1024, G, bid);
                  pg8::EpiResGate<true, false> E{WSB(SL(14)), a.out, mod + 5120};
                  pg8::gemm_phase<pg8::EpiResGate<true, false>, pg8::StaticOrder, true, true>(lds, g, S, E); )
#undef IN
#undef SEAM
#undef PHASE
#undef WSB
}

#ifndef MK_MULTI
#define MK_MULTI 0
#endif
extern "C" void kernel_launch(void* const* d_in, const int* in_sizes, int n_in, void* d_out, int out_size, void* d_ws, size_t ws_size, hipStream_t stream) {
    static int grid = 0;
    if (grid == 0) {
        if (n_in != 23 || out_size != T * DM || ws_size < WS_NEED) { fprintf(stderr, "kernel_launch: unexpected shapes (n_in %d out %d ws %zu)\n", n_in, out_size, ws_size); grid = -1; return; }
        int dev = 0, cus = 0, per_cu = 0;
        hipGetDevice(&dev); hipDeviceGetAttribute(&cus, hipDeviceAttributeMultiprocessorCount, dev);
        hipFuncSetAttribute((const void*)mk_fwd, hipFuncAttributeMaxDynamicSharedMemorySize, LDS_BYTES);
        hipOccupancyMaxActiveBlocksPerMultiprocessor(&per_cu, (const void*)mk_fwd, NTHR, LDS_BYTES);
        if (per_cu < 1) { fprintf(stderr, "kernel_launch: occupancy query says %d blocks per CU\n", per_cu); per_cu = 1; }
        (void)hipGetLastError();
        grid = cus * per_cu;
    }
    if (grid < 0) return;
    if (hipMemsetAsync((char*)d_ws + WS_BAR, 0, XCD_BAR_WORDS * 4, stream) != hipSuccess) { fprintf(stderr, "kernel_launch: memset failed\n"); return; }
    Args a{};
    for (int i = 0; i < 23; ++i) a.in[i] = (const float*)d_in[i];
    a.out = (float*)d_out; a.ws = (unsigned char*)d_ws;
    for (int i = 0; i < 16; ++i) a.invf[i] = powf(10000.0f, -(float)(2 * i) / 32.0f);
#if MK_MULTI
    for (int ph = 0; ph < NPHASE; ++ph) { a.ph_lo = ph; a.ph_hi = ph + 1; hipLaunchKernelGGL(mk_fwd, dim3(grid), dim3(NTHR), LDS_BYTES, stream, a); }
#else
    a.ph_lo = 0; a.ph_hi = NPHASE;
    void* args[] = {&a};
    hipError_t e = hipLaunchCooperativeKernel((const void*)mk_fwd, dim3(grid), dim3(NTHR), args, LDS_BYTES, stream);
    if (e != hipSuccess) fprintf(stderr, "cooperative launch failed: %s (grid %d)\n", hipGetErrorString(e), grid);
#endif
}
```

```cpp
#include <hip/hip_runtime.h>
#include <hip/hip_cooperative_groups.h>
#include <cstdio>
#include <cstdint>
#include <cmath>
namespace cg = cooperative_groups;
namespace pg8 {
#define PG8_LAS __attribute__((address_space(3)))
typedef unsigned short bf16_t;
typedef short bf16x8 __attribute__((ext_vector_type(8)));
typedef float f32x4 __attribute__((ext_vector_type(4)));
typedef unsigned u32x4 __attribute__((ext_vector_type(4)));
constexpr int BM = 256, BK = 64, HALF = 128, HTB = HALF * BK * 2  , STAGE_BYTES = 8 * HTB, NXCD = 8, WGM = 8;

__host__ __device__ __forceinline__ int lds_byte(int r, int c) { const int st = (r >> 4) * 2 + (c >> 5), rr = r & 15, cc = c & 31, ob = rr * 64 + cc * 2; return st * 1024 + (ob ^ (((ob >> 9) & 1) << 5)); }
__host__ __device__ __forceinline__ void stage_rc(int b, int& R, int& C) { const int st = b / 1024, sb = b % 1024, swz = sb ^ (((sb >> 9) & 1) << 5); R = (st >> 1) * 16 + swz / 64; C = (st & 1) * 32 + (swz % 64) / 2; }
__host__ __device__ __forceinline__ int perm32(int rho) { const int n = rho >> 4, i = rho & 15; return 8 * (i >> 2) + 4 * n + (i & 3); }

struct Unit { int pm, pn, kh; };
struct Gemm { const bf16_t* A; const bf16_t* Bt; int M, N, K, ldk; };

struct StaticOrder {
    int nM, nN, nwg, G, c;
    __host__ __device__ void init(int M, int N, int G_, int c_) { nM = M / BM; nN = N / BM; nwg = nM * nN; G = G_; c = c_; }
    __host__ __device__ bool next(int i, Unit& u) const {
        const long L = (long)i * G + c; if (L >= nwg) return false;
        int wgid = (int)L; { const int q = nwg / NXCD, r = nwg % NXCD, xcd = wgid % NXCD, off = wgid / NXCD; wgid = (xcd < r ? xcd * (q + 1) : r * (q + 1) + (xcd - r) * q) + off; }
        const int nig = WGM * nN, gid = wgid / nig, fm = gid * WGM, gsz = (nM - fm) < WGM ? (nM - fm) : WGM;
        u.pm = fm + ((wgid % nig) % gsz); u.pn = (wgid % nig) / gsz; u.kh = 0; return true;
    }
    __device__ __forceinline__ void a_ready(const Unit&) const {}
    __device__ __forceinline__ void done(const Unit&) const {}
};

struct PairOrder {
    StaticOrder base;
    __host__ __device__ void init(int M, int N, int G_, int c_) { base.init(M, N, G_, c_); }
    __host__ __device__ bool next(int i, Unit& u) const { if (!base.next(i >> 1, u)) return false; u.kh = i & 1; return true; }
    __device__ __forceinline__ void a_ready(const Unit&) const {}
    __device__ __forceinline__ void done(const Unit&) const {}
};

__device__ __forceinline__ unsigned cvt_pk_bf16(float lo, float hi) { unsigned r; asm volatile("v_cvt_pk_bf16_f32 %0, %1, %2" : "=v"(r) : "v"(lo), "v"(hi)); return r; }
typedef float f32x2 __attribute__((ext_vector_type(2)));
__device__ __forceinline__ f32x2 gelu_pk(f32x2 v) {
    const f32x2 av = __builtin_elementwise_abs(v), d = av * 0.2316418882f + 1.0f;
    f32x2 t; t.x = __builtin_amdgcn_rcpf(d.x); t.y = __builtin_amdgcn_rcpf(d.y);
    f32x2 q = t * 0.5307027145f + (-0.7265760135f); q = q * t + 0.7107068705f; q = q * t + (-0.142248368f); q = q * t + 0.127414796f; q = q * t;
    const f32x2 s = (v * v) * (-0.72134752044f);
    f32x2 e; e.x = __builtin_amdgcn_exp2f(s.x); e.y = __builtin_amdgcn_exp2f(s.y);
    const f32x2 m = v * (q * e), r = v - m;
    f32x2 o; o.x = v.x < 0.f ? m.x : r.x; o.y = v.y < 0.f ? m.y : r.y; return o;
}

template <int ACT  > struct EpiBf16 {
    static constexpr bool PERM = true, AFTER_DRAIN = false, ROWPERM = false; static_assert(ACT == 0 || ACT == 1, "EpiBf16: ACT is 0 (none) or 1 (gelu_pk)");
    bf16_t* O; int ldc; const float* bias; int split_cols; size_t split_stride; float scale0;
    __device__ __forceinline__ void operator()(const f32x4 (&acc)[2][2][4][2], const Unit& u, int wr, int wc, int fr, int fq) const {
        const int row0 = u.pm * BM + wr * 64 + fr; int colt = u.pn * BM; bf16_t* base = O;
        float sc = 1.f; if (split_cols) { const int t = colt / split_cols; base += (size_t)t * split_stride; colt -= t * split_cols; if (t == 0) sc = scale0; }
        const int col0 = colt + wc * 32 + 8 * fq, bcol0 = u.pn * BM + wc * 32 + 8 * fq;
        f32x4 bv[2][2];
#pragma unroll
        for (int bj = 0; bj < 2; ++bj)
#pragma unroll
            for (int n = 0; n < 2; ++n) bv[bj][n] = bias ? *(const f32x4*)(bias + bcol0 + bj * HALF + 4 * n) : (f32x4){0.f, 0.f, 0.f, 0.f};
#pragma unroll
        for (int ai = 0; ai < 2; ++ai)
#pragma unroll
            for (int m = 0; m < 4; ++m) { bf16_t* rowp = base + (size_t)(row0 + ai * HALF + m * 16) * ldc + col0;
#pragma unroll
                for (int bj = 0; bj < 2; ++bj) { f32x4 v0 = acc[ai][bj][m][0] + bv[bj][0], v1 = acc[ai][bj][m][1] + bv[bj][1];
                    if (ACT == 1) { f32x2 a = gelu_pk((f32x2){v0[0], v0[1]}), b = gelu_pk((f32x2){v0[2], v0[3]}), c = gelu_pk((f32x2){v1[0], v1[1]}), d = gelu_pk((f32x2){v1[2], v1[3]});
                        v0 = (f32x4){a.x, a.y, b.x, b.y}; v1 = (f32x4){c.x, c.y, d.x, d.y}; }
                    v0 = v0 * sc; v1 = v1 * sc; u32x4 w; w.x = cvt_pk_bf16(v0[0], v0[1]); w.y = cvt_pk_bf16(v0[2], v0[3]); w.z = cvt_pk_bf16(v1[0], v1[1]); w.w = cvt_pk_bf16(v1[2], v1[3]);
                    *(u32x4*)(rowp + bj * HALF) = w; } }
    }
};


template <bool BASE_BF16, bool OUT_BF16> struct EpiResGate {
    static constexpr bool PERM = false, AFTER_DRAIN = false, ROWPERM = false;
    const void* base; void* out; const float* gate;
    __device__ __forceinline__ void operator()(const f32x4 (&acc)[2][2][4][2], const Unit& u, int wr, int wc, int fr, int fq) const {
        const int row0 = u.pm * BM + wr * 64 + fr, col0 = u.pn * BM + wc * 32 + 4 * fq;
        const float* gp = gate + ((u.pm * BM) >> 12) * 6144 + col0;
        f32x4 gv[2][2];
#pragma unroll
        for (int bj = 0; bj < 2; ++bj)
#pragma unroll
            for (int n = 0; n < 2; ++n) gv[bj][n] = *(const f32x4*)(gp + bj * HALF + 16 * n);
#pragma unroll
        for (int ai = 0; ai < 2; ++ai) {
            f32x4 bv[4][2][2]; unsigned long long bw[4][2][2];
#pragma unroll
            for (int m = 0; m < 4; ++m) { const size_t off = (size_t)(row0 + ai * HALF + m * 16) * 1024 + col0;
#pragma unroll
                for (int bj = 0; bj < 2; ++bj)
#pragma unroll
                    for (int n = 0; n < 2; ++n) {
                        if (BASE_BF16) bw[m][bj][n] = *(const unsigned long long*)((const bf16_t*)base + off + bj * HALF + 16 * n);
                        else bv[m][bj][n] = *(const f32x4*)((const float*)base + off + bj * HALF + 16 * n); } }
            asm volatile("" ::: "memory");
#pragma unroll
            for (int m = 0; m < 4; ++m) { const size_t off = (size_t)(row0 + ai * HALF + m * 16) * 1024 + col0;
#pragma unroll
                for (int bj = 0; bj < 2; ++bj)
#pragma unroll
                    for (int n = 0; n < 2; ++n) {
                        f32x4 b4;
                        if (BASE_BF16) { const unsigned long long w = bw[m][bj][n];
                            b4 = (f32x4){__uint_as_float((unsigned)(w & 0xffffull) << 16), __uint_as_float((unsigned)((w >> 16) & 0xffffull) << 16),
                                         __uint_as_float((unsigned)((w >> 32) & 0xffffull) << 16), __uint_as_float((unsigned)((w >> 48) & 0xffffull) << 16)}; }
                        else b4 = bv[m][bj][n];
                        const f32x4 o = b4 + gv[bj][n] * acc[ai][bj][m][n];
                        if (OUT_BF16) *(unsigned long long*)((bf16_t*)out + off + bj * HALF + 16 * n) = (unsigned long long)cvt_pk_bf16(o[0], o[1]) | ((unsigned long long)cvt_pk_bf16(o[2], o[3]) << 32);
                        else *(f32x4*)((float*)out + off + bj * HALF + 16 * n) = o; } }
        }
    }
};
template <int MODE> struct EpiBranch {
    static constexpr bool PERM = false, AFTER_DRAIN = false, ROWPERM = false;
    const bf16_t* gsl; float* tmp; bf16_t* merged; size_t slab_elems;
    __device__ __forceinline__ void operator()(const f32x4 (&acc)[2][2][4][2], const Unit& u, int wr, int wc, int fr, int fq) const {
        const int row0 = u.pm * BM + wr * 64 + fr, cin = wc * 32 + 4 * fq, col0 = u.pn * BM + cin;
        const bf16_t* gb = gsl + (size_t)(u.pn >> 1) * slab_elems + (u.pn & 1) * 256 + cin;
#pragma unroll
        for (int ai = 0; ai < 2; ++ai)
#pragma unroll
            for (int m = 0; m < 4; ++m) { const int row = row0 + ai * HALF + m * 16; const size_t off = (size_t)row * 1024 + col0; const bf16_t* gr = gb + (size_t)row * 512;
#pragma unroll
                for (int bj = 0; bj < 2; ++bj)
#pragma unroll
                    for (int n = 0; n < 2; ++n) {
                        const unsigned long long gw = *(const unsigned long long*)(gr + bj * HALF + 16 * n);
                        f32x4 g; g[0] = __uint_as_float((unsigned)(gw & 0xffffull) << 16); g[1] = __uint_as_float((unsigned)((gw >> 16) & 0xffffull) << 16);
                        g[2] = __uint_as_float((unsigned)((gw >> 32) & 0xffffull) << 16); g[3] = __uint_as_float((unsigned)((gw >> 48) & 0xffffull) << 16);
                        f32x4 v;
#pragma unroll
                        for (int e = 0; e < 4; ++e) v[e] = acc[ai][bj][m][n][e] * __builtin_amdgcn_rcpf(1.0f + __expf(-g[e]));
                        unsigned long long* mp = (unsigned long long*)(merged + off + bj * HALF + 16 * n);
                        if (MODE == 0) { *mp = (unsigned long long)cvt_pk_bf16(v[0], v[1]) | ((unsigned long long)cvt_pk_bf16(v[2], v[3]) << 32); }
                        else { const unsigned long long tw = *mp;
                            const f32x4 o = {v[0] + __uint_as_float((unsigned)(tw & 0xffffull) << 16), v[1] + __uint_as_float((unsigned)((tw >> 16) & 0xffffull) << 16),
                                             v[2] + __uint_as_float((unsigned)((tw >> 32) & 0xffffull) << 16), v[3] + __uint_as_float((unsigned)((tw >> 48) & 0xffffull) << 16)};
                            *mp = (unsigned long long)cvt_pk_bf16(o[0], o[1]) | ((unsigned long long)cvt_pk_bf16(o[2], o[3]) << 32); } } }
    }
};

struct EpiBranchPair {
    static constexpr bool PERM = false, AFTER_DRAIN = false, ROWPERM = false;
    const bf16_t* ga; const bf16_t* gb; bf16_t* merged; size_t slab_elems;
    __device__ __forceinline__ void operator()(f32x4 (&acc)[2][2][4][2], const Unit& u, int wr, int wc, int fr, int fq) const {
        const int row0 = u.pm * BM + wr * 64 + fr, cin = wc * 32 + 4 * fq, col0 = u.pn * BM + cin;
        const size_t gofs = (size_t)(u.pn >> 1) * slab_elems + (u.pn & 1) * 256 + cin;
#pragma unroll
        for (int ai = 0; ai < 2; ++ai) {
            unsigned long long wbv[4][2][2], wav[4][2][2];
#pragma unroll
            for (int m = 0; m < 4; ++m) { const size_t gro = gofs + (size_t)(row0 + ai * HALF + m * 16) * 512;
#pragma unroll
                for (int bj = 0; bj < 2; ++bj)
#pragma unroll
                    for (int n = 0; n < 2; ++n) { wbv[m][bj][n] = *(const unsigned long long*)(gb + gro + bj * HALF + 16 * n);
                        if (u.kh == 0) wav[m][bj][n] = *(const unsigned long long*)(ga + gro + bj * HALF + 16 * n); else wav[m][bj][n] = 0ull; } }
            asm volatile("" ::: "memory");
#pragma unroll
            for (int m = 0; m < 4; ++m) { const size_t off = (size_t)(row0 + ai * HALF + m * 16) * 1024 + col0;
#pragma unroll
                for (int bj = 0; bj < 2; ++bj)
#pragma unroll
                    for (int n = 0; n < 2; ++n) {
                        const unsigned long long wb = wbv[m][bj][n];
                        f32x4 eb;
                        eb[0] = __expf(-fmaxf(__uint_as_float((unsigned)(wb & 0xffffull) << 16), -60.f)); eb[1] = __expf(-fmaxf(__uint_as_float((unsigned)((wb >> 16) & 0xffffull) << 16), -60.f));
                        eb[2] = __expf(-fmaxf(__uint_as_float((unsigned)((wb >> 32) & 0xffffull) << 16), -60.f)); eb[3] = __expf(-fmaxf(__uint_as_float((unsigned)((wb >> 48) & 0xffffull) << 16), -60.f));
                        if (u.kh == 0) {
                            const unsigned long long wa = wav[m][bj][n];
                            f32x4 ea;
                            ea[0] = __expf(-__uint_as_float((unsigned)(wa & 0xffffull) << 16)); ea[1] = __expf(-__uint_as_float((unsigned)((wa >> 16) & 0xffffull) << 16));
                            ea[2] = __expf(-__uint_as_float((unsigned)((wa >> 32) & 0xffffull) << 16)); ea[3] = __expf(-__uint_as_float((unsigned)((wa >> 48) & 0xffffull) << 16));
#pragma unroll
                            for (int e_ = 0; e_ < 4; ++e_) acc[ai][bj][m][n][e_] *= (1.0f + eb[e_]) * __builtin_amdgcn_rcpf(1.0f + ea[e_]);
                        } else {
                            f32x4 o;
#pragma unroll
                            for (int e_ = 0; e_ < 4; ++e_) o[e_] = acc[ai][bj][m][n][e_] * __builtin_amdgcn_rcpf(1.0f + eb[e_]);
                            *(unsigned long long*)(merged + off + bj * HALF + 16 * n) = (unsigned long long)cvt_pk_bf16(o[0], o[1]) | ((unsigned long long)cvt_pk_bf16(o[2], o[3]) << 32);
                        } } }
        }
    }
};

__device__ __forceinline__ float dpp_shr1(float v) { return __builtin_bit_cast(float, __builtin_amdgcn_update_dpp(0, __builtin_bit_cast(int, v), 0x111, 0xf, 0xf, true)); }
struct EpiConvAct {
    static constexpr bool PERM = true, AFTER_DRAIN = false, ROWPERM = true;
    bf16_t* act; bf16_t* edge; const float* cw; const float* cb;
    __device__ __forceinline__ void operator()(const f32x4 (&acc)[2][2][4][2], const Unit& u, int wr, int wc, int fr, int fq) const {
        const int chl = wc * 32 + 8 * fq, ch0 = u.pn * 128 + chl, ucol = u.pn * 256 + chl;
#pragma unroll
        for (int n = 0; n < 2; ++n) {
            const f32x4 wg0 = *(const f32x4*)(cw + ch0 + 4 * n), wg1 = *(const f32x4*)(cw + 5632 + ch0 + 4 * n), wg2 = *(const f32x4*)(cw + 2 * 5632 + ch0 + 4 * n), bg = *(const f32x4*)(cb + ch0 + 4 * n);
            const f32x4 wv0 = *(const f32x4*)(cw + 2816 + ch0 + 4 * n), wv1 = *(const f32x4*)(cw + 5632 + 2816 + ch0 + 4 * n), wv2 = *(const f32x4*)(cw + 2 * 5632 + 2816 + ch0 + 4 * n), bv = *(const f32x4*)(cb + 2816 + ch0 + 4 * n);
#pragma unroll
            for (int ai = 0; ai < 2; ++ai) {
                const int stripe = u.pm * 4 + ai * 2 + wr;
                f32x4 pg1, pg2, pv1, pv2;
#pragma unroll
                for (int e = 0; e < 4; ++e) { pg1[e] = dpp_shr1(acc[ai][0][3][n][e]); pg2[e] = dpp_shr1(acc[ai][0][2][n][e]); pv1[e] = dpp_shr1(acc[ai][1][3][n][e]); pv2[e] = dpp_shr1(acc[ai][1][2][n][e]); }
                f32x4 yg[4], yv[4];
                yg[0] = bg + wg0 * pg2 + wg1 * pg1 + wg2 * acc[ai][0][0][n];
                yg[1] = bg + wg0 * pg1 + wg1 * acc[ai][0][0][n] + wg2 * acc[ai][0][1][n];
                yg[2] = bg + wg0 * acc[ai][0][0][n] + wg1 * acc[ai][0][1][n] + wg2 * acc[ai][0][2][n];
                yg[3] = bg + wg0 * acc[ai][0][1][n] + wg1 * acc[ai][0][2][n] + wg2 * acc[ai][0][3][n];
                yv[0] = bv + wv0 * pv2 + wv1 * pv1 + wv2 * acc[ai][1][0][n];
                yv[1] = bv + wv0 * pv1 + wv1 * acc[ai][1][0][n] + wv2 * acc[ai][1][1][n];
                yv[2] = bv + wv0 * acc[ai][1][0][n] + wv1 * acc[ai][1][1][n] + wv2 * acc[ai][1][2][n];
                yv[3] = bv + wv0 * acc[ai][1][1][n] + wv1 * acc[ai][1][2][n] + wv2 * acc[ai][1][3][n];
                bf16_t* arow = act + (size_t)(stripe * 64 + 4 * fr) * 2816 + ch0 + 4 * n;
#pragma unroll
                for (int m = 0; m < 4; ++m) { f32x4 o;
#pragma unroll
                    for (int e = 0; e < 4; ++e) o[e] = yg[m][e] * __builtin_amdgcn_rcpf(1.0f + __expf(-yg[m][e])) * yv[m][e];
                    *(unsigned long long*)(arow + (size_t)m * 2816) = (unsigned long long)cvt_pk_bf16(o[0], o[1]) | ((unsigned long long)cvt_pk_bf16(o[2], o[3]) << 32); }
                if (fr == 0 || fr == 15) {
                    const int m0 = (fr == 0) ? 0 : 2;
#pragma unroll
                    for (int mm = 0; mm < 2; ++mm)
#pragma unroll
                        for (int bj = 0; bj < 2; ++bj) { const f32x4 x = (fr == 0) ? acc[ai][bj][mm][n] : acc[ai][bj][2 + mm][n];
                            *(unsigned long long*)(edge + ((size_t)stripe * 4 + m0 + mm) * 5632 + ucol + bj * HALF + 4 * n) = (unsigned long long)cvt_pk_bf16(x[0], x[1]) | ((unsigned long long)cvt_pk_bf16(x[2], x[3]) << 32); }
                }
            }
        }
    }
};

struct EpiRowScale {
    static constexpr bool PERM = true, AFTER_DRAIN = false, ROWPERM = false;
    bf16_t* O; int ldc; const float* rs; float inv_n;
    __device__ __forceinline__ void operator()(const f32x4 (&acc)[2][2][4][2], const Unit& u, int wr, int wc, int fr, int fq) const {
        const int row0 = u.pm * BM + wr * 64 + fr, col0 = u.pn * BM + wc * 32 + 8 * fq;
#pragma unroll
        for (int ai = 0; ai < 2; ++ai)
#pragma unroll
            for (int m = 0; m < 4; ++m) { const int row = row0 + ai * HALF + m * 16; const float sc = rsqrtf(rs[row] * inv_n + 1e-6f); bf16_t* rowp = O + (size_t)row * ldc + col0;
#pragma unroll
                for (int bj = 0; bj < 2; ++bj) { const f32x4 v0 = acc[ai][bj][m][0] * sc, v1 = acc[ai][bj][m][1] * sc;
                    u32x4 w; w.x = cvt_pk_bf16(v0[0], v0[1]); w.y = cvt_pk_bf16(v0[2], v0[3]); w.z = cvt_pk_bf16(v1[0], v1[1]); w.w = cvt_pk_bf16(v1[2], v1[3]);
                    *(u32x4*)(rowp + bj * HALF) = w; } }
    }
};
struct EpiColScale {
    static constexpr bool PERM = true, AFTER_DRAIN = false, ROWPERM = false;
    bf16_t* O; int ldc; const float* cs; float inv_n;
    __device__ __forceinline__ void operator()(const f32x4 (&acc)[2][2][4][2], const Unit& u, int wr, int wc, int fr, int fq) const {
        const int row0 = u.pm * BM + wr * 64 + fr, col0 = u.pn * BM + wc * 32 + 8 * fq;
#pragma unroll
        for (int bj = 0; bj < 2; ++bj) {
            f32x4 s0 = *(const f32x4*)(cs + col0 + bj * HALF), s1 = *(const f32x4*)(cs + col0 + bj * HALF + 4);
#pragma unroll
            for (int e_ = 0; e_ < 4; ++e_) { s0[e_] = rsqrtf(s0[e_] * inv_n + 1e-6f); s1[e_] = rsqrtf(s1[e_] * inv_n + 1e-6f); }
#pragma unroll
            for (int ai = 0; ai < 2; ++ai)
#pragma unroll
                for (int m = 0; m < 4; ++m) { const f32x4 v0 = acc[ai][bj][m][0] * s0, v1 = acc[ai][bj][m][1] * s1;
                    u32x4 w; w.x = cvt_pk_bf16(v0[0], v0[1]); w.y = cvt_pk_bf16(v0[2], v0[3]); w.z = cvt_pk_bf16(v1[0], v1[1]); w.w = cvt_pk_bf16(v1[2], v1[3]);
                    *(u32x4*)(O + (size_t)(row0 + ai * HALF + m * 16) * ldc + col0 + bj * HALF) = w; }
        }
    }
};

struct EpiProj {
    static constexpr bool PERM = true, AFTER_DRAIN = false, ROWPERM = false;
    bf16_t* O; size_t slab_elems; float* ssq_q; float* ssq_kv;
    __device__ __forceinline__ void operator()(const f32x4 (&acc)[2][2][4][2], const Unit& u, int wr, int wc, int fr, int fq) const {
        const int row0 = u.pm * BM + wr * 64 + fr, col0 = (u.pn & 1) * 256 + wc * 32 + 8 * fq;
        bf16_t* base = O + (size_t)(u.pn >> 1) * slab_elems;
#pragma unroll
        for (int ai = 0; ai < 2; ++ai)
#pragma unroll
            for (int m = 0; m < 4; ++m) { bf16_t* rowp = base + (size_t)(row0 + ai * HALF + m * 16) * 512 + col0;
#pragma unroll
                for (int bj = 0; bj < 2; ++bj) { const f32x4 v0 = acc[ai][bj][m][0], v1 = acc[ai][bj][m][1];
                    u32x4 w; w.x = cvt_pk_bf16(v0[0], v0[1]); w.y = cvt_pk_bf16(v0[2], v0[3]); w.z = cvt_pk_bf16(v1[0], v1[1]); w.w = cvt_pk_bf16(v1[2], v1[3]);
                    *(u32x4*)(rowp + bj * HALF) = w; } }
        if (u.pn <= 2) {
            float* dst = (u.pn < 2) ? ssq_q : ssq_kv;
#pragma unroll
            for (int ai = 0; ai < 2; ++ai)
#pragma unroll
                for (int m = 0; m < 4; ++m) { float s = 0.f;
#pragma unroll
                    for (int bj = 0; bj < 2; ++bj)
#pragma unroll
                        for (int n = 0; n < 2; ++n) { const f32x4 x = acc[ai][bj][m][n]; s += (x[0] * x[0] + x[1] * x[1]) + (x[2] * x[2] + x[3] * x[3]); }
                    s += __shfl_xor(s, 16); s += __shfl_xor(s, 32);
                    if (fq == 0) __hip_atomic_fetch_add(dst + row0 + ai * HALF + m * 16, s, __ATOMIC_RELAXED, __HIP_MEMORY_SCOPE_AGENT); }
        }
    }
};
template <class Epi, class Sched, bool ALIGN_EPI = false, bool SP2 = false>
__device__ __forceinline__ void gemm_phase(PG8_LAS unsigned char* lds, const Gemm g, const Sched& S, const Epi& E) {
    const int tid = threadIdx.x, wid = __builtin_amdgcn_readfirstlane(tid >> 6), lane = tid & 63, wr = wid >> 2, wc = wid & 3, fr = lane & 15, fq = lane >> 4;
    const int K = g.K, nt = K / BK, ldk = g.ldk ? g.ldk : g.K;
    unsigned voffA[2], voffB[2];
#pragma unroll
    for (int i = 0; i < 2; ++i) { int R, C; stage_rc(tid * 16 + i * 8192, R, C); const int Rb = Epi::PERM ? ((R & ~31) + perm32(R & 31)) : R;
        const int Ra = Epi::ROWPERM ? ((R & 64) | ((R & 15) << 2) | ((R >> 4) & 3)) : R;
        voffA[i] = (unsigned)(Ra * ldk + C) * 2u; voffB[i] = (unsigned)(Rb * ldk + C) * 2u; }
    const size_t kstep = (size_t)(BK * 2);
    const size_t hstep = (size_t)HALF * ldk * 2;
    const size_t tstep = 2 * hstep;
    const unsigned ldsw = (unsigned)wid * 1024u;
    const int aoff = lds_byte(wr * 64 + fr, fq * 8), boff = lds_byte(wc * 32 + fr, fq * 8);
#define PG8_SA(b, h) (((b) * 2 + (h)) * HTB)
#define PG8_SB(b, h) ((4 + (b) * 2 + (h)) * HTB)
#define PG8_STAGE(bufoff, gbase, voff) do { _Pragma("unroll") for (int _i = 0; _i < 2; ++_i) \
        __builtin_amdgcn_global_load_lds((const unsigned*)((const char*)(gbase) + (voff)[_i]), (PG8_LAS unsigned*)(lds + (bufoff) + ldsw + _i * 8192), 16, 0, 0); } while (0)
#define PG8_LDA(dst, b, h) do { _Pragma("unroll") for (int m = 0; m < 4; ++m) _Pragma("unroll") for (int k = 0; k < 2; ++k) dst[m][k] = *(const PG8_LAS bf16x8*)(lds + PG8_SA(b, h) + aoff + m * 2048 + k * 1024); } while (0)
#define PG8_LDB(dst, b, h) do { _Pragma("unroll") for (int n = 0; n < 2; ++n) _Pragma("unroll") for (int k = 0; k < 2; ++k) dst[n][k] = *(const PG8_LAS bf16x8*)(lds + PG8_SB(b, h) + boff + n * 2048 + k * 1024); } while (0)
#define PG8_MMA(ai, bj, At, Bt) do { __builtin_amdgcn_s_setprio(1); _Pragma("unroll") for (int m = 0; m < 4; ++m) _Pragma("unroll") for (int n = 0; n < 2; ++n) _Pragma("unroll") for (int k = 0; k < 2; ++k) \
        acc[ai][bj][m][n] = __builtin_amdgcn_mfma_f32_16x16x32_bf16(Bt[n][k], At[m][k], acc[ai][bj][m][n], 0, 0, 0); __builtin_amdgcn_s_setprio(0); } while (0)
#define PG8_WAIT_V(n) asm volatile("s_waitcnt vmcnt(" #n ")" ::: "memory")
#define PG8_WAIT_L(n) asm volatile("s_waitcnt lgkmcnt(" #n ")" ::: "memory")
#define PG8_BAR __builtin_amdgcn_s_barrier()
#define PG8_SCHED __builtin_amdgcn_sched_barrier(0)
    Unit cur, nxt; int ui = 0;
    if (!S.next(0, cur)) return;
    f32x4 acc[2][2][4][2];
#pragma unroll
    for (int a = 0; a < 2; ++a)
#pragma unroll
        for (int b = 0; b < 2; ++b)
#pragma unroll
            for (int m = 0; m < 4; ++m)
#pragma unroll
                for (int n = 0; n < 2; ++n) acc[a][b][m][n] = (f32x4){0.f, 0.f, 0.f, 0.f};
    bf16x8 At[4][2], B0[2][2], B1[2][2];
    const size_t khstep = (size_t)K * 2;
    const char* cA = (const char*)g.A + (size_t)cur.pm * tstep + cur.kh * khstep; const char* cB = (const char*)g.Bt + (size_t)cur.pn * tstep + cur.kh * khstep;
    S.a_ready(cur);
    if constexpr (SP2) {
        PG8_STAGE(PG8_SB(0, 0), cB, voffB); PG8_STAGE(PG8_SB(0, 1), cB + hstep, voffB); PG8_STAGE(PG8_SA(0, 0), cA, voffA); PG8_STAGE(PG8_SA(0, 1), cA + hstep, voffA);
        if (wr == 1) PG8_BAR;
        PG8_WAIT_V(2); PG8_BAR;
        PG8_STAGE(PG8_SB(1, 0), cB + kstep, voffB); PG8_STAGE(PG8_SA(1, 0), cA + kstep, voffA); PG8_STAGE(PG8_SB(1, 1), cB + hstep + kstep, voffB);
        PG8_WAIT_V(6); PG8_BAR;
    } else {
        PG8_STAGE(PG8_SB(0, 0), cB, voffB); PG8_STAGE(PG8_SA(0, 0), cA, voffA); PG8_STAGE(PG8_SB(0, 1), cB + hstep, voffB); PG8_STAGE(PG8_SA(0, 1), cA + hstep, voffA);
        if (wr == 1) PG8_BAR;
        PG8_WAIT_V(4); PG8_BAR;
        PG8_STAGE(PG8_SB(1, 0), cB + kstep, voffB); PG8_STAGE(PG8_SA(1, 0), cA + kstep, voffA); PG8_STAGE(PG8_SB(1, 1), cB + hstep + kstep, voffB);
        PG8_WAIT_V(6); PG8_BAR;
    }
    for (;;) {
        const bool has_next = S.next(ui + 1, nxt);
        const char* nA = has_next ? (const char*)g.A + (size_t)nxt.pm * tstep + nxt.kh * khstep : cA; const char* nB = has_next ? (const char*)g.Bt + (size_t)nxt.pn * tstep + nxt.kh * khstep : cB;
        for (int t = 0; t < nt; t += 2) {
            const bool last = (t == nt - 2);
            const char* a1 = cA + (size_t)(t + 1) * kstep;
            const char* a2 = last ? nA : cA + (size_t)(t + 2) * kstep; const char* b2 = last ? nB : cB + (size_t)(t + 2) * kstep;
            const char* a3 = a2 + kstep; const char* b3 = b2 + kstep;
            if (last && has_next) S.a_ready(nxt);
            if constexpr (SP2) {
            PG8_LDB(B0, 0, 0); PG8_LDB(B1, 0, 1); PG8_SCHED; PG8_LDA(At, 0, 0); PG8_STAGE(PG8_SA(1, 1), a1 + hstep, voffA);
            PG8_WAIT_V(8); PG8_WAIT_L(0); PG8_BAR; PG8_MMA(0, 0, At, B0); PG8_MMA(0, 1, At, B1); PG8_BAR; PG8_SCHED;
            PG8_LDA(At, 0, 1); PG8_STAGE(PG8_SB(0, 0), b2, voffB); PG8_STAGE(PG8_SB(0, 1), b2 + hstep, voffB); PG8_STAGE(PG8_SA(0, 0), a2, voffA);
            PG8_WAIT_V(8); PG8_WAIT_L(0); PG8_BAR; PG8_MMA(1, 0, At, B0); PG8_MMA(1, 1, At, B1); PG8_BAR; PG8_SCHED;
            PG8_LDB(B0, 1, 0); PG8_LDB(B1, 1, 1); PG8_SCHED; PG8_LDA(At, 1, 0); PG8_STAGE(PG8_SA(0, 1), a2 + hstep, voffA);
            PG8_WAIT_V(8); PG8_WAIT_L(0); PG8_BAR; PG8_MMA(0, 0, At, B0); PG8_MMA(0, 1, At, B1); PG8_BAR; PG8_SCHED;
            PG8_LDA(At, 1, 1); PG8_STAGE(PG8_SB(1, 0), b3, voffB); PG8_STAGE(PG8_SB(1, 1), b3 + hstep, voffB); PG8_STAGE(PG8_SA(1, 0), a3, voffA);
            PG8_WAIT_V(8); PG8_WAIT_L(0); PG8_BAR; PG8_MMA(1, 0, At, B0); PG8_MMA(1, 1, At, B1); PG8_BAR; PG8_SCHED;
            } else {
            PG8_LDB(B0, 0, 0); PG8_SCHED; PG8_LDA(At, 0, 0); PG8_STAGE(PG8_SA(1, 1), a1 + hstep, voffA);
            PG8_WAIT_L(8); PG8_BAR; PG8_WAIT_L(0); PG8_MMA(0, 0, At, B0); PG8_BAR; PG8_SCHED;
            PG8_LDB(B1, 0, 1); PG8_STAGE(PG8_SB(0, 0), b2, voffB);
            PG8_BAR; PG8_WAIT_L(0); PG8_MMA(0, 1, At, B1); PG8_BAR;
            PG8_LDA(At, 0, 1); PG8_STAGE(PG8_SA(0, 0), a2, voffA);
            PG8_BAR; PG8_WAIT_L(0); PG8_MMA(1, 0, At, B0); PG8_BAR; PG8_SCHED;
            PG8_STAGE(PG8_SB(0, 1), b2 + hstep, voffB);
            PG8_WAIT_V(6); PG8_BAR; PG8_MMA(1, 1, At, B1); PG8_BAR;
            PG8_LDB(B0, 1, 0); PG8_SCHED; PG8_LDA(At, 1, 0); PG8_STAGE(PG8_SA(0, 1), a2 + hstep, voffA);
            PG8_WAIT_L(8); PG8_BAR; PG8_WAIT_L(0); PG8_MMA(0, 0, At, B0); PG8_BAR; PG8_SCHED;
            PG8_LDB(B1, 1, 1); PG8_STAGE(PG8_SB(1, 0), b3, voffB);
            PG8_BAR; PG8_WAIT_L(0); PG8_MMA(0, 1, At, B1); PG8_BAR;
            PG8_LDA(At, 1, 1); PG8_STAGE(PG8_SA(1, 0), a3, voffA);
            PG8_BAR; PG8_WAIT_L(0); PG8_MMA(1, 0, At, B0); PG8_BAR; PG8_SCHED;
            PG8_STAGE(PG8_SB(1, 1), b3 + hstep, voffB);
            PG8_WAIT_V(6); PG8_BAR; PG8_MMA(1, 1, At, B1); PG8_BAR;
            }
        }
        if constexpr (ALIGN_EPI) { if (wr == 0) PG8_BAR; }
        if constexpr (!Epi::AFTER_DRAIN) { E(acc, cur, wr, wc, fr, fq); S.done(cur); }
        if (!has_next) break;
        if (nxt.kh == 0)
#pragma unroll
        for (int a = 0; a < 2; ++a)
#pragma unroll
            for (int b = 0; b < 2; ++b)
#pragma unroll
                for (int m = 0; m < 4; ++m)
#pragma unroll
                    for (int n = 0; n < 2; ++n) acc[a][b][m][n] = (f32x4){0.f, 0.f, 0.f, 0.f};
        cur = nxt; cA = nA; cB = nB; ++ui;
        if constexpr (ALIGN_EPI) { if (wr == 1) PG8_BAR; }
    }
    PG8_WAIT_V(0);
    if constexpr (!ALIGN_EPI) { if (wr == 0) PG8_BAR; }
    PG8_BAR;
    if constexpr (Epi::AFTER_DRAIN) { E.fused(acc, cur, wr, wc, fr, fq, lds, wid, lane); S.done(cur); }
#undef PG8_SA
#undef PG8_SB
#undef PG8_STAGE
#undef PG8_LDA
#undef PG8_LDB
#undef PG8_MMA
#undef PG8_WAIT_V
#undef PG8_WAIT_L
#undef PG8_BAR
#undef PG8_SCHED
}
}

#define LAS __attribute__((address_space(3)))
typedef unsigned short bf16_t;
typedef short bf16x8 __attribute__((ext_vector_type(8)));
typedef float f32x4 __attribute__((ext_vector_type(4)));
typedef float f32x16 __attribute__((ext_vector_type(16)));
typedef unsigned u32x4 __attribute__((ext_vector_type(4)));
typedef unsigned u32x2 __attribute__((ext_vector_type(2)));

constexpr int T = 32768, DM = 1024, SEQ = 4096;
constexpr int NMOD = 6144, NPROJ = 5120, DFF = 2816, NUP = 5632;
constexpr int NTHR = 512;
constexpr size_t MiB = 1u << 20;
constexpr size_t SLAB = 32 * MiB;
constexpr size_t SLAB_EL = (size_t)T * 512;
constexpr size_t WS_BAR = 512 * 1024;
constexpr size_t WS_MOD = 0, WS_LB = 256 * 1024, WS_G = 1 * MiB, WS_RSQ = 2 * MiB, WS_RSKV = 3 * MiB;
constexpr size_t WS_WIN = 4 * MiB, WS_WUQ = 14 * MiB, WS_WUKV = 15 * MiB, WS_WA = 16 * MiB, WS_WB = 17 * MiB, WS_WOUT = 18 * MiB, WS_WUP = 20 * MiB, WS_WDOWN = 31 * MiB;
__host__ __device__ constexpr size_t SL(int i) { return (size_t)i * SLAB; }
constexpr size_t WS_UH = SL(2);
constexpr size_t WS_ACT = SL(2) + 192 * MiB;
constexpr size_t WS_NEED = 512 * MiB;
constexpr int LDS_BYTES = 147456;
constexpr int NPHASE = 17;

__device__ __forceinline__ float bf2f(unsigned short v) { return __uint_as_float((unsigned)v << 16); }
__device__ __forceinline__ float bflo(unsigned w) { return __uint_as_float(w << 16); }
__device__ __forceinline__ float bfhi(unsigned w) { return __uint_as_float(w & 0xffff0000u); }
typedef float f32x2_t __attribute__((ext_vector_type(2))); typedef __bf16 bf16x2_t __attribute__((ext_vector_type(2)));
__device__ __forceinline__ unsigned pk2(float lo, float hi) { f32x2_t v = {lo, hi}; bf16x2_t b = __builtin_convertvector(v, bf16x2_t); return __builtin_bit_cast(unsigned, b); }
__device__ __forceinline__ unsigned short f2bf(float f) { return (unsigned short)(pk2(f, 0.f) & 0xffffu); }
__device__ __forceinline__ float wave_sum(float v) {
#pragma unroll
    for (int o = 1; o < 64; o <<= 1) v += __shfl_xor(v, o);
    return v;
}
__device__ __forceinline__ float sigmoidf_(float x) { return __builtin_amdgcn_rcpf(1.0f + __expf(-x)); }
#define MFMA16(a, b, c) __builtin_amdgcn_mfma_f32_16x16x32_bf16((a), (b), (c), 0, 0, 0)
#define MFMA32(a, b, c) __builtin_amdgcn_mfma_f32_32x32x16_bf16((a), (b), (c), 0, 0, 0)

struct Args { const float* in[23]; float* out; unsigned char* ws; float invf[16]; int ph_lo, ph_hi; };

__device__ __forceinline__ int srccol(int mapid, int nd) {
    if (mapid == 0) return nd;
    if (mapid == 1) { if (nd < 800) return nd; if (nd < 1024) return -1; return nd - 224; }
    if (mapid == 3) return (nd >> 6) * 128 + (nd & 63);
    if (mapid == 4) return (nd >> 6) * 128 + 64 + (nd & 63);
    const int pn = nd >> 8, j = nd & 255; return (j < 128) ? (128 * pn + j) : (DFF + 128 * pn + (j - 128));
}
__device__ __forceinline__ void wt_item(const float* W, int K, int Nsrc, bf16_t* WT, int mapid, int item, int nblk, LAS unsigned short* tile, int ldk = 0, int kofs = 0, const float* kgain = nullptr) {
    if (ldk == 0) ldk = K;
    const int kb = item / nblk, nb = item % nblk, k0 = kb * 64, n0 = nb * 64;
    const int tid = threadIdx.x, n = tid & 63, kq = tid >> 6;
    const int sc = srccol(mapid, n0 + n);
#pragma unroll
    for (int i = 0; i < 8; ++i) { const int k = i * 8 + kq; float v = (sc >= 0) ? W[(size_t)(k0 + k) * Nsrc + sc] : 0.f; if (kgain) v *= kgain[k0 + k]; tile[n * 66 + k] = f2bf(v); }
    __syncthreads();
    { const int nn = tid >> 3, kc = tid & 7; const LAS unsigned* tp = (const LAS unsigned*)(tile + nn * 66 + kc * 8);
      u32x4 w; w[0] = tp[0]; w[1] = tp[1]; w[2] = tp[2]; w[3] = tp[3];
      *(u32x4*)(WT + (size_t)(n0 + nn) * ldk + kofs + k0 + kc * 8) = w; }
    __syncthreads();
}
__device__ __forceinline__ void p0_phase(const Args& a, LAS unsigned char* lds, int bid, int G) {
    unsigned char* ws = a.ws;
    const int tid = threadIdx.x, lane = tid & 63, wid = tid >> 6;
    for (int cgp = bid; cgp < 96; cgp += G) {
        LAS float* red = (LAS float*)lds;
        const float* c = a.in[1]; const float* w = a.in[3]; const int n = cgp * 64 + lane;
        float acc[8];
#pragma unroll
        for (int b = 0; b < 8; ++b) acc[b] = 0.f;
        for (int k = wid * 128; k < wid * 128 + 128; ++k) { const float wv = w[(size_t)k * NMOD + n];
#pragma unroll
            for (int b = 0; b < 8; ++b) acc[b] += c[b * DM + k] * wv; }
#pragma unroll
        for (int b = 0; b < 8; ++b) red[(wid * 8 + b) * 64 + lane] = acc[b];
        __syncthreads();
        { const int b = wid; float s = 0.f;
#pragma unroll
          for (int w8 = 0; w8 < 8; ++w8) s += red[(w8 * 8 + b) * 64 + lane];
          ((float*)(ws + WS_MOD))[b * NMOD + n] = s + a.in[4][n]; }
        __syncthreads();
    }
    for (int i = bid * NTHR + tid; i < T; i += G * NTHR) { ((float*)(ws + WS_RSQ))[i] = 0.f; ((float*)(ws + WS_RSKV))[i] = 0.f; }
    if (bid == (96 % G)) { const float* t = a.in[13]; ((float*)(ws + WS_LB))[tid] = 1.0f / (1.0f + expf(t[tid] - t[512 + tid])); }
    LAS unsigned short* tile = (LAS unsigned short*)lds;
    constexpr int I0 = 16 * 80, I1 = 8 * 12, I2 = 4 * 8, I2b = 4 * 8, I3 = 8 * 16, I4 = 8 * 16, I5 = 16 * 16, I6 = 16 * 88, I7 = 44 * 16;
    constexpr int NIT = I0 + I1 + I2 + I2b + I3 + I4 + I5 + I6 + I7;
    for (int it = bid; it < NIT; it += G) {
        int r = it;
        if (r < I0) { wt_item(a.in[6], 1024, 4896, (bf16_t*)(ws + WS_WIN), 1, r, 80, tile); continue; } r -= I0;
        if (r < I1) { wt_item(a.in[8], 512, 768, (bf16_t*)(ws + WS_WUQ), 0, r, 12, tile, 0, 0, a.in[7]); continue; } r -= I1;
        if (r < I2) { wt_item(a.in[10], 256, 1024, (bf16_t*)(ws + WS_WUKV), 3, r, 8, tile, 512, 0, a.in[9]); continue; } r -= I2;
        if (r < I2b) { wt_item(a.in[10], 256, 1024, (bf16_t*)(ws + WS_WUKV + 512 * 1024), 4, r, 8, tile, 512, 0, a.in[9]); continue; } r -= I2b;
        if (r < I3) { wt_item(a.in[15], 512, 1024, (bf16_t*)(ws + WS_WA), 0, r, 16, tile, 1024, 0); continue; } r -= I3;
        if (r < I4) { wt_item(a.in[16], 512, 1024, (bf16_t*)(ws + WS_WA), 0, r, 16, tile, 1024, 512); continue; } r -= I4;
        if (r < I5) { wt_item(a.in[17], 1024, 1024, (bf16_t*)(ws + WS_WOUT), 0, r, 16, tile); continue; } r -= I5;
        if (r < I6) { wt_item(a.in[19], 1024, NUP, (bf16_t*)(ws + WS_WUP), 2, r, 88, tile); continue; } r -= I6;
        wt_item(a.in[22], DFF, 1024, (bf16_t*)(ws + WS_WDOWN), 0, r, 16, tile);
    }
}

template <bool IN_BF16> __device__ __forceinline__ void adaln_phase(const void* xin_, const float* g, const float* mod, int shift_off, int scale_off, bf16_t* out, int bid, int G) {
    const int lane = threadIdx.x & 63, wid = threadIdx.x >> 6;
    const int gw = bid * 8 + wid, NGW = G * 8;
    for (int m0 = 2 * gw; m0 < T; m0 += 2 * NGW) {
        f32x4 v[2][4]; float s[2] = {0.f, 0.f};
#pragma unroll
        for (int r = 0; r < 2; ++r) {
            if (IN_BF16) { const u32x2* xr = (const u32x2*)((const bf16_t*)xin_ + (size_t)(m0 + r) * DM) + lane;
#pragma unroll
                for (int j = 0; j < 4; ++j) { const u32x2 w = xr[64 * j]; v[r][j] = (f32x4){bflo(w[0]), bfhi(w[0]), bflo(w[1]), bfhi(w[1])}; } }
            else { const f32x4* xr = (const f32x4*)((const float*)xin_ + (size_t)(m0 + r) * DM) + lane;
#pragma unroll
                for (int j = 0; j < 4; ++j) v[r][j] = xr[64 * j]; } }
        const float* mb = mod + (m0 >> 12) * NMOD;
        f32x4 ga[4], sh[4];
#pragma unroll
        for (int j = 0; j < 4; ++j) { const int col = 4 * lane + 256 * j; const f32x4 gg = *(const f32x4*)(g + col), sc = *(const f32x4*)(mb + scale_off + col); sh[j] = *(const f32x4*)(mb + shift_off + col);
#pragma unroll
            for (int e = 0; e < 4; ++e) ga[j][e] = gg[e] * (1.0f + sc[e]); }
#pragma unroll
        for (int r = 0; r < 2; ++r)
#pragma unroll
            for (int j = 0; j < 4; ++j) s[r] += (v[r][j][0] * v[r][j][0] + v[r][j][1] * v[r][j][1]) + (v[r][j][2] * v[r][j][2] + v[r][j][3] * v[r][j][3]);
#pragma unroll
        for (int o = 1; o < 64; o <<= 1) { s[0] += __shfl_xor(s[0], o); s[1] += __shfl_xor(s[1], o); }
#pragma unroll
        for (int r = 0; r < 2; ++r) { const float rstd = rsqrtf(s[r] * (1.f / DM) + 1e-6f);
            u32x2* o8 = (u32x2*)(out + (size_t)(m0 + r) * DM) + lane;
#pragma unroll
            for (int j = 0; j < 4; ++j) { f32x4 h;
#pragma unroll
                for (int e = 0; e < 4; ++e) h[e] = v[r][j][e] * rstd * ga[j][e] + sh[j][e];
                u32x2 w; w[0] = pk2(h[0], h[1]); w[1] = pk2(h[2], h[3]); o8[64 * j] = w; } }
    }
}

__device__ __forceinline__ void lora_norm_phase(const Args& a, int bid, int G) {
    unsigned char* ws = a.ws;
    const bf16_t* cq = (const bf16_t*)(ws + SL(4)); const bf16_t* ckv = (const bf16_t*)(ws + SL(5));
    float* rsq = (float*)(ws + WS_RSQ); float* rskv = (float*)(ws + WS_RSKV);
    const int lane = threadIdx.x & 63, wid = threadIdx.x >> 6;
    const int gw = bid * 8 + wid, NGW = G * 8;
#pragma unroll 4
    for (int m = gw; m < T; m += NGW) {
        const u32x4 w = *(const u32x4*)(cq + (size_t)m * 512 + 8 * lane);
        u32x4 w2 = {0u, 0u, 0u, 0u};
        if (lane < 32) w2 = *(const u32x4*)(ckv + (size_t)m * 512 + 8 * lane);
        float s = 0.f, s2 = 0.f;
#pragma unroll
        for (int e = 0; e < 4; ++e) { const float v0 = bflo(w[e]), v1 = bfhi(w[e]), u0 = bflo(w2[e]), u1 = bfhi(w2[e]); s += v0 * v0 + v1 * v1; s2 += u0 * u0 + u1 * u1; }
#pragma unroll
        for (int o = 1; o < 64; o <<= 1) { s += __shfl_xor(s, o); s2 += __shfl_xor(s2, o); }
        if (lane == 0) { rsq[m] = rsqrtf(s * (1.f / 512.f) + 1e-6f); rskv[m] = rsqrtf(s2 * (1.f / 256.f) + 1e-6f); }
    }
}

__device__ __forceinline__ void h1_phase(const bf16_t* hq, const bf16_t* hf, const bf16_t* hi, bf16_t* qe_out, bf16_t* intra_out, const float* lb, bf16_t* Ub, float* G, LAS unsigned char* lds, int bid, int Gn) {
    LAS bf16_t* QA = (LAS bf16_t*)lds;
    LAS bf16_t* KD = QA + 4 * 64 * 136;
    LAS bf16_t* KET = KD + 64 * 136;
    LAS bf16_t* VT = KET + 128 * 72;
    LAS bf16_t* AT = VT + 128 * 72;
    LAS float* TOT = (LAS float*)(AT + 64 * 72);
    LAS bf16_t* ST = QA;
    const int tid = threadIdx.x, lane = tid & 63, wid = __builtin_amdgcn_readfirstlane(tid >> 6);
    const int k = tid & 127, I = __builtin_amdgcn_readfirstlane(tid >> 7);
    u32x4 pf[2][3];
#define H1_LOAD(uu) do { const int b_ = (uu) >> 8, h_ = ((uu) >> 6) & 3, c_ = (uu) & 63; _Pragma("unroll") for (int i = 0; i < 2; ++i) { const int id = tid + NTHR * i, row = id >> 4, cc = id & 15; \
        const size_t go = (size_t)(b_ * SEQ + c_ * 64 + row) * 512 + h_ * 128 + cc * 8; pf[i][0] = *(const u32x4*)(hq + go); pf[i][1] = *(const u32x4*)(hf + go); pf[i][2] = *(const u32x4*)(hi + go); } } while (0)
    if (bid < 2048) H1_LOAD(bid);
    for (int u = bid; u < 2048; u += Gn) {
    const int b = u >> 8, h = (u >> 6) & 3, c = u & 63, t0 = b * SEQ + c * 64, cb = h * 128;
#pragma unroll
    for (int i = 0; i < 2; ++i) { const int id = tid + NTHR * i, row = id >> 4, cc = id & 15;
        *(LAS u32x4*)(ST + row * 128 + cc * 8) = pf[i][0]; *(LAS u32x4*)(ST + 8192 + row * 128 + cc * 8) = pf[i][1]; *(LAS u32x4*)(ST + 16384 + row * 128 + cc * 8) = pf[i][2]; }
    __syncthreads();
    if (u + Gn < 2048) H1_LOAD(u + Gn);
    float q[16], kk[16], pc[16]; unsigned short vv[16];
    const float lbk = lb[cb + k]; float run = 1.0f;
#pragma unroll
    for (int i = 0; i < 16; ++i) {
        const float xq = bf2f(ST[(16 * I + i) * 128 + k]), xf = bf2f(ST[8192 + (16 * I + i) * 128 + k]); vv[i] = ST[16384 + (16 * I + i) * 128 + k];
        const float f = lbk + (1.0f - lbk) * sigmoidf_(xf);
        run *= f; pc[i] = run; kk[i] = 1.0f - f; q[i] = xq * sigmoidf_(xq);
    }
    TOT[I * 128 + k] = run;
    for (int j = tid; j < 64 * 72 / 2; j += NTHR) ((LAS unsigned*)AT)[j] = 0u;
    __syncthreads();
    const float tp0 = TOT[k], tp1 = TOT[128 + k], tp2 = TOT[256 + k], tp3 = TOT[384 + k];
    const float ej2 = (I > 2 ? tp2 : 1.f), ej1 = (I > 1 ? tp1 : 1.f) * ej2, ej0 = (I > 0 ? tp0 : 1.f) * ej1;
    const float suf = (I <= 0 ? tp0 : 1.f) * (I <= 1 ? tp1 : 1.f) * (I <= 2 ? tp2 : 1.f) * tp3;
    unsigned kw[8], vw[8];
#pragma unroll
    for (int i = 0; i < 16; ++i) {
        const int s = 16 * I + i;
        const float rp = __builtin_amdgcn_rcpf(pc[i]), qp = q[i] * pc[i];
        KD[s * 136 + k] = f2bf(kk[i] * rp);
        QA[(0 * 64 + s) * 136 + k] = f2bf(qp * ej0);
        if (I >= 1) QA[(1 * 64 + s) * 136 + k] = f2bf(qp * ej1);
        if (I >= 2) QA[(2 * 64 + s) * 136 + k] = f2bf(qp * ej2);
        if (I >= 3) QA[(3 * 64 + s) * 136 + k] = f2bf(qp);
        const float ke = kk[i] * (suf * rp);
        if (i & 1) { kw[i >> 1] |= (unsigned)f2bf(ke) << 16; vw[i >> 1] |= (unsigned)vv[i] << 16; } else { kw[i >> 1] = f2bf(ke); vw[i >> 1] = vv[i]; }
    }
    { LAS u32x4* kp = (LAS u32x4*)(KET + k * 72 + 16 * I); kp[0] = (u32x4){kw[0], kw[1], kw[2], kw[3]}; kp[1] = (u32x4){kw[4], kw[5], kw[6], kw[7]};
      LAS u32x4* vp = (LAS u32x4*)(VT + k * 72 + 16 * I); vp[0] = (u32x4){vw[0], vw[1], vw[2], vw[3]}; vp[1] = (u32x4){vw[4], vw[5], vw[6], vw[7]}; }
    if (I == 0) G[(size_t)u * 128 + k] = (tp0 * tp1) * (tp2 * tp3);
    __syncthreads();
    const int l15 = lane & 15, l4 = lane >> 4;
#pragma unroll
    for (int i = 0; i < 2; ++i) { const int id = tid + NTHR * i, row = id >> 4, cc = id & 15;
        *(u32x4*)(qe_out + (size_t)(t0 + row) * 512 + cb + cc * 8) = *(const LAS u32x4*)(QA + row * 136 + cc * 8); }
    for (int blk = wid; blk < 10; blk += 8) {
        const int Ip = (blk >= 6) ? 3 : (blk >= 3) ? 2 : (blk >= 1) ? 1 : 0, J = blk - Ip * (Ip + 1) / 2;
        f32x4 acc = {0.f, 0.f, 0.f, 0.f};
#pragma unroll
        for (int ks = 0; ks < 4; ++ks) {
            const bf16x8 x = *(const LAS bf16x8*)(QA + (J * 64 + 16 * Ip + l15) * 136 + 32 * ks + 8 * l4);
            const bf16x8 y = *(const LAS bf16x8*)(KD + (16 * J + l15) * 136 + 32 * ks + 8 * l4);
            acc = MFMA16(x, y, acc);
        }
#pragma unroll
        for (int ii = 0; ii < 4; ++ii) { const int tl = 4 * l4 + ii; const float val = (Ip == J && l15 > tl) ? 0.f : acc[ii]; AT[(16 * Ip + tl) * 72 + 16 * J + l15] = f2bf(val); }
    }
    __syncthreads();
    { const int tb = wid & 3, vb0 = (wid >> 2) * 4;
      const bf16x8 x0 = *(const LAS bf16x8*)(AT + (16 * tb + l15) * 72 + 8 * l4), x1 = *(const LAS bf16x8*)(AT + (16 * tb + l15) * 72 + 32 + 8 * l4);
#pragma unroll
      for (int j = 0; j < 4; ++j) { const int vb = vb0 + j;
          const bf16x8 y0 = *(const LAS bf16x8*)(VT + (16 * vb + l15) * 72 + 8 * l4), y1 = *(const LAS bf16x8*)(VT + (16 * vb + l15) * 72 + 32 + 8 * l4);
          f32x4 acc = {0.f, 0.f, 0.f, 0.f}; acc = MFMA16(y0, x0, acc); acc = MFMA16(y1, x1, acc);
          u32x2 w; w[0] = pk2(acc[0], acc[1]); w[1] = pk2(acc[2], acc[3]);
          *(u32x2*)(intra_out + (size_t)(t0 + 16 * tb + l15) * 512 + cb + 16 * vb + 4 * l4) = w; } }
    { const int kb = wid;
      const bf16x8 x0 = *(const LAS bf16x8*)(KET + (16 * kb + l15) * 72 + 8 * l4), x1 = *(const LAS bf16x8*)(KET + (16 * kb + l15) * 72 + 32 + 8 * l4);
#pragma unroll
      for (int vb = 0; vb < 8; ++vb) {
          const bf16x8 y0 = *(const LAS bf16x8*)(VT + (16 * vb + l15) * 72 + 8 * l4), y1 = *(const LAS bf16x8*)(VT + (16 * vb + l15) * 72 + 32 + 8 * l4);
          f32x4 acc = {0.f, 0.f, 0.f, 0.f}; acc = MFMA16(x0, y0, acc); acc = MFMA16(x1, y1, acc);
          u32x2 w; w[0] = pk2(acc[0], acc[1]); w[1] = pk2(acc[2], acc[3]);
          *(u32x2*)(Ub + (size_t)u * 16384 + (16 * vb + l15) * 128 + 16 * kb + 4 * l4) = w; } }
    __syncthreads();
    }
#undef H1_LOAD
}

__device__ __forceinline__ void h2_phase(bf16_t* Ub, const float* __restrict__ G, int bid, int Gn) {
    const int gt = bid * NTHR + threadIdx.x, NT_ = Gn * NTHR;
    for (int e4 = gt; e4 < 131072; e4 += NT_) {
        const int bh = e4 >> 12, e = (e4 & 4095) * 4, k = e & 127;
        bf16_t* p = Ub + (size_t)bh * 64 * 16384 + e; const float* gp = G + (size_t)bh * 64 * 128 + k;
        float s0 = 0.f, s1 = 0.f, s2 = 0.f, s3 = 0.f;
#pragma unroll 1
        for (int c0 = 0; c0 < 64; c0 += 16) {
            u32x2 uv[16]; f32x4 g[16];
#pragma unroll
            for (int j = 0; j < 16; ++j) { uv[j] = *(const u32x2*)(p + (size_t)(c0 + j) * 16384); g[j] = *(const f32x4*)(gp + (c0 + j) * 128); }
#pragma unroll
            for (int j = 0; j < 16; ++j) {
                u32x2 w; w[0] = pk2(s0, s1); w[1] = pk2(s2, s3); *(u32x2*)(p + (size_t)(c0 + j) * 16384) = w;
                s0 = g[j][0] * s0 + bflo(uv[j][0]); s1 = g[j][1] * s1 + bfhi(uv[j][0]); s2 = g[j][2] * s2 + bflo(uv[j][1]); s3 = g[j][3] * s3 + bfhi(uv[j][1]);
            }
        }
    }
}

__device__ __forceinline__ void h3_unit(int j, const bf16_t* qe, const bf16_t* intra, const bf16_t* Ub, const bf16_t* hg, const float* gn, bf16_t* out) {
    const int tid = threadIdx.x, lane = tid & 63, wid = __builtin_amdgcn_readfirstlane(tid >> 6), l15 = lane & 15, l4 = lane >> 4;
    const int b = j >> 6, c = j & 63, t0 = b * SEQ + c * 64;
#pragma unroll 1
    for (int cc = 0; cc < 2; ++cc) {
        const int combo = 2 * wid + cc, head = combo >> 2, tb = combo & 3, u = (b * 4 + head) * 64 + c;
        const size_t rbase = (size_t)(t0 + 16 * tb + l15) * 512 + head * 128;
        bf16x8 x[4];
#pragma unroll
        for (int ks = 0; ks < 4; ++ks) x[ks] = *(const bf16x8*)(qe + rbase + 8 * l4 + 32 * ks);
        u32x2 iv[8], gv[8];
#pragma unroll
        for (int vb = 0; vb < 8; ++vb) { iv[vb] = *(const u32x2*)(intra + rbase + 16 * vb + 4 * l4); gv[vb] = *(const u32x2*)(hg + rbase + 16 * vb + 4 * l4); }
        const bf16_t* ub = Ub + (size_t)u * 16384 + l15 * 128 + 8 * l4;
        f32x4 acc[8];
#pragma unroll
        for (int vb = 0; vb < 8; ++vb) { acc[vb] = (f32x4){0.f, 0.f, 0.f, 0.f};
#pragma unroll
            for (int ks = 0; ks < 4; ++ks) { const bf16x8 y = *(const bf16x8*)(ub + vb * 2048 + 32 * ks); acc[vb] = MFMA16(y, x[ks], acc[vb]); } }
        float ss = 0.f;
#pragma unroll
        for (int vb = 0; vb < 8; ++vb) { acc[vb][0] += bflo(iv[vb][0]); acc[vb][1] += bfhi(iv[vb][0]); acc[vb][2] += bflo(iv[vb][1]); acc[vb][3] += bfhi(iv[vb][1]);
            ss += (acc[vb][0] * acc[vb][0] + acc[vb][1] * acc[vb][1]) + (acc[vb][2] * acc[vb][2] + acc[vb][3] * acc[vb][3]); }
        ss += __shfl_xor(ss, 16); ss += __shfl_xor(ss, 32);
        const float rstd = rsqrtf(ss * (1.f / 128.f) + 1e-6f);
#pragma unroll
        for (int vb = 0; vb < 8; ++vb) { const f32x4 gnv = *(const f32x4*)(gn + 16 * vb + 4 * l4);
            const float g0 = bflo(gv[vb][0]), g1 = bfhi(gv[vb][0]), g2 = bflo(gv[vb][1]), g3 = bfhi(gv[vb][1]);
            u32x2 w; w[0] = pk2(acc[vb][0] * rstd * gnv[0] * (g0 * sigmoidf_(g0)), acc[vb][1] * rstd * gnv[1] * (g1 * sigmoidf_(g1)));
            w[1] = pk2(acc[vb][2] * rstd * gnv[2] * (g2 * sigmoidf_(g2)), acc[vb][3] * rstd * gnv[3] * (g3 * sigmoidf_(g3)));
            *(u32x2*)(out + (size_t)(t0 + 16 * tb + l15) * 1024 + 512 + head * 128 + 16 * vb + 4 * l4) = w; }
    }
}

__device__ __forceinline__ void qk_prep_phase(const Args& a, int bid, int G) {
    unsigned char* ws = a.ws;
    const bf16_t* qraw = (const bf16_t*)a.out; const bf16_t* knope = (const bf16_t*)(ws + SL(2)); const bf16_t* krope = (const bf16_t*)(ws + SL(5)) + 256;
    bf16_t* Q = (bf16_t*)(ws + SL(3)); bf16_t* K = (bf16_t*)((unsigned char*)a.out + 64 * MiB);
    const int* positions = (const int*)a.in[2]; const float* gq = a.in[11]; const float* gk = a.in[12];
    const int lane = threadIdx.x & 63, wid = threadIdx.x >> 6, h = lane >> 3, c = lane & 7, c3 = c & 3;
    const float QS = 0.10206207261596577f * 1.4426950408889634f;
    float gqn[8], gkn[8], gqr[4], gkr[4], invf[4];
#pragma unroll
    for (int j = 0; j < 8; ++j) { gqn[j] = gq[8 * c + j] * QS; gkn[j] = gk[8 * c + j]; }
#pragma unroll
    for (int j = 0; j < 4; ++j) { gqr[j] = gq[64 + 4 * c + j] * QS; gkr[j] = gk[64 + 4 * c + j];
        invf[j] = (c3 == 0) ? a.invf[j] : (c3 == 1) ? a.invf[4 + j] : (c3 == 2) ? a.invf[8 + j] : a.invf[12 + j]; }
    const int gw = bid * 8 + wid, NGW = G * 8;
#pragma unroll 2
    for (int m = gw; m < T; m += NGW) {
        const int b = m >> 12, s = m & 4095;
        const u32x4 qn = *(const u32x4*)(qraw + (size_t)m * 768 + h * 96 + 8 * c); const u32x2 qr = *(const u32x2*)(qraw + (size_t)m * 768 + h * 96 + 64 + 4 * c);
        const u32x4 kn = *(const u32x4*)(knope + (size_t)m * 512 + h * 64 + 8 * c); const u32x2 kr = *(const u32x2*)(krope + (size_t)m * 512 + 4 * c);
        const float posf = (float)positions[m];
        float cs[4], sn[4];
#pragma unroll
        for (int j = 0; j < 4; ++j) { const float ang = posf * invf[j]; double rv = (double)ang * 0.15915494309189535; rv -= __builtin_rint(rv);
            const float fr = (float)rv; sn[j] = __builtin_amdgcn_sinf(fr); cs[j] = __builtin_amdgcn_cosf(fr); }
        size_t ob = ((size_t)(b * 8 + h) * SEQ + s) * 96;
        { float v[8], w[4]; float ss = 0.f;
#pragma unroll
          for (int e = 0; e < 4; ++e) { v[2 * e] = bflo(qn[e]); v[2 * e + 1] = bfhi(qn[e]); ss += v[2 * e] * v[2 * e] + v[2 * e + 1] * v[2 * e + 1]; }
          w[0] = bflo(qr[0]); w[1] = bfhi(qr[0]); w[2] = bflo(qr[1]); w[3] = bfhi(qr[1]); ss += (w[0] * w[0] + w[1] * w[1]) + (w[2] * w[2] + w[3] * w[3]);
          ss += __shfl_xor(ss, 1); ss += __shfl_xor(ss, 2); ss += __shfl_xor(ss, 4);
          const float rstd = rsqrtf(ss * (1.f / 96.f) + 1e-6f);
          u32x4 o; o[0] = pk2(v[0] * rstd * gqn[0], v[1] * rstd * gqn[1]); o[1] = pk2(v[2] * rstd * gqn[2], v[3] * rstd * gqn[3]);
          o[2] = pk2(v[4] * rstd * gqn[4], v[5] * rstd * gqn[5]); o[3] = pk2(v[6] * rstd * gqn[6], v[7] * rstd * gqn[7]);
          float rot[4];
#pragma unroll
          for (int j = 0; j < 4; ++j) { const float n1 = w[j] * rstd * gqr[j], pr = __shfl_xor(n1, 4); rot[j] = (c & 4) ? (n1 * cs[j] + pr * sn[j]) : (n1 * cs[j] - pr * sn[j]); }
          u32x2 o2; o2[0] = pk2(rot[0], rot[1]); o2[1] = pk2(rot[2], rot[3]);
          *(u32x4*)(Q + ob + 8 * c) = o; *(u32x2*)(Q + ob + 64 + 4 * c) = o2; }
        { float v[8], w[4]; float ss = 0.f;
#pragma unroll
          for (int e = 0; e < 4; ++e) { v[2 * e] = bflo(kn[e]); v[2 * e + 1] = bfhi(kn[e]); ss += v[2 * e] * v[2 * e] + v[2 * e + 1] * v[2 * e + 1]; }
          w[0] = bflo(kr[0]); w[1] = bfhi(kr[0]); w[2] = bflo(kr[1]); w[3] = bfhi(kr[1]); ss += (w[0] * w[0] + w[1] * w[1]) + (w[2] * w[2] + w[3] * w[3]);
          ss += __shfl_xor(ss, 1); ss += __shfl_xor(ss, 2); ss += __shfl_xor(ss, 4);
          const float rstd = rsqrtf(ss * (1.f / 96.f) + 1e-6f);
          u32x4 o; o[0] = pk2(v[0] * rstd * gkn[0], v[1] * rstd * gkn[1]); o[1] = pk2(v[2] * rstd * gkn[2], v[3] * rstd * gkn[3]);
          o[2] = pk2(v[4] * rstd * gkn[4], v[5] * rstd * gkn[5]); o[3] = pk2(v[6] * rstd * gkn[6], v[7] * rstd * gkn[7]);
          float rot[4];
#pragma unroll
          for (int j = 0; j < 4; ++j) { const float n1 = w[j] * rstd * gkr[j], pr = __shfl_xor(n1, 4); rot[j] = (c & 4) ? (n1 * cs[j] + pr * sn[j]) : (n1 * cs[j] - pr * sn[j]); }
          u32x2 o2; o2[0] = pk2(rot[0], rot[1]); o2[1] = pk2(rot[2], rot[3]);
          *(u32x4*)(K + ob + 8 * c) = o; *(u32x2*)(K + ob + 64 + 4 * c) = o2; }
    }
}

__device__ __forceinline__ int crow(int r, int hi) { return (r & 3) + 8 * (r >> 2) + 4 * hi; }
template <bool FIX> __device__ __forceinline__ void attn_unit(const bf16_t* Q, const bf16_t* K, const bf16_t* Vt, bf16_t* O, int bh, int qb, float mfix, LAS unsigned char* lds) {
    const int tid = threadIdx.x, lane = tid & 63, wid = __builtin_amdgcn_readfirstlane(tid >> 6), r = lane & 31, hh = lane >> 5;
    LAS bf16_t* Kb = (LAS bf16_t*)lds;
    LAS bf16_t* Vb = (LAS bf16_t*)(lds + 2 * 64 * 104 * 2);
    const bf16_t* Qh = Q + (size_t)bh * SEQ * 96; const bf16_t* Kh = K + (size_t)bh * SEQ * 96; const bf16_t* Vh = Vt + (size_t)(bh & 7) * 64 * T + (size_t)(bh >> 3) * SEQ;
    const int q0 = qb * 256, qw = q0 + wid * 32, NTL = 4 * (qb + 1);
    bf16x8 qf[6];
#pragma unroll
    for (int d0 = 0; d0 < 6; ++d0) qf[d0] = *(const bf16x8*)(Qh + (size_t)(qw + r) * 96 + 16 * d0 + 8 * hh);
    f32x16 o0, o1;
#pragma unroll
    for (int i = 0; i < 16; ++i) { o0[i] = 0.f; o1[i] = 0.f; }
    float mrun = -1e30f, lrun = 0.f;
    f32x16 cinit;
#pragma unroll
    for (int i = 0; i < 16; ++i) cinit[i] = FIX ? -mfix : 0.f;
    asm volatile("" : "+v"(cinit));
    const int c2 = 512 + tid, kr1 = tid / 12, kc1 = tid % 12, kr2 = c2 / 12, kc2 = c2 % 12, vr = tid >> 3, vc = tid & 7;
    u32x4 kA, kB = {0u, 0u, 0u, 0u}, vA;
#define ATT_LOADG(t) do { kA = *(const u32x4*)(Kh + (size_t)(t) * 6144 + tid * 8); if (tid < 256) kB = *(const u32x4*)(Kh + (size_t)(t) * 6144 + c2 * 8); \
        vA = *(const u32x4*)(Vh + (size_t)vr * T + 64 * (t) + vc * 8); } while (0)
#define ATT_STORE(buf) do { *(LAS u32x4*)(Kb + (buf) * 6656 + kr1 * 104 + kc1 * 8) = kA; if (tid < 256) *(LAS u32x4*)(Kb + (buf) * 6656 + kr2 * 104 + kc2 * 8) = kB; \
        *(LAS u32x2*)(Vb + (buf) * 4352 + vr * 68 + vc * 8) = (u32x2){vA[0], vA[1]}; *(LAS u32x2*)(Vb + (buf) * 4352 + vr * 68 + vc * 8 + 4) = (u32x2){vA[2], vA[3]}; } while (0)
    ATT_LOADG(0); ATT_STORE(0); __syncthreads();
    for (int t = 0; t < NTL; ++t) {
        const int buf = t & 1;
        if (t + 1 < NTL) ATT_LOADG(t + 1);
        if (64 * t <= qw + 31) {
            f32x16 s0, s1;
            const LAS bf16_t* kp = Kb + buf * 6656 + r * 104 + 8 * hh;
#pragma unroll
            for (int d0 = 0; d0 < 6; ++d0) {
                const bf16x8 a0 = *(const LAS bf16x8*)(kp + 16 * d0), a1 = *(const LAS bf16x8*)(kp + 32 * 104 + 16 * d0);
                if (d0 == 0) { s0 = MFMA32(a0, qf[0], cinit); s1 = MFMA32(a1, qf[0], cinit); }
                else { s0 = MFMA32(a0, qf[d0], s0); s1 = MFMA32(a1, qf[d0], s1); }
            }
            if (64 * t + 63 > qw) {
                const int qrow = qw + r;
#pragma unroll
                for (int i = 0; i < 16; ++i) { const int kv = 64 * t + crow(i, hh); if (kv > qrow) s0[i] = -1e30f; if (kv + 32 > qrow) s1[i] = -1e30f; }
            }
            if constexpr (FIX) {
                f32x2_t l2 = {0.f, 0.f};
#pragma unroll
                for (int i = 0; i < 16; i += 2) { s0[i] = __builtin_amdgcn_exp2f(s0[i]); s0[i + 1] = __builtin_amdgcn_exp2f(s0[i + 1]); s1[i] = __builtin_amdgcn_exp2f(s1[i]); s1[i + 1] = __builtin_amdgcn_exp2f(s1[i + 1]);
                    l2 += (f32x2_t){s0[i], s0[i + 1]}; l2 += (f32x2_t){s1[i], s1[i + 1]}; }
                lrun += l2[0] + l2[1];
            } else {
            float mx = s0[0];
#pragma unroll
            for (int i = 1; i < 16; ++i) mx = fmaxf(mx, s0[i]);
#pragma unroll
            for (int i = 0; i < 16; ++i) mx = fmaxf(mx, s1[i]);
            mx = fmaxf(mx, __shfl_xor(mx, 32));
            const float mnew = fmaxf(mrun, mx), alpha = __builtin_amdgcn_exp2f(mrun - mnew);
            mrun = mnew;
            float ls = 0.f;
#pragma unroll
            for (int i = 0; i < 16; ++i) { s0[i] = __builtin_amdgcn_exp2f(s0[i] - mnew); s1[i] = __builtin_amdgcn_exp2f(s1[i] - mnew); ls += s0[i] + s1[i]; }
            lrun = lrun * alpha + ls;
            if (__any(alpha != 1.0f)) {
#pragma unroll
                for (int i = 0; i < 16; ++i) { const float ai = __shfl(alpha, crow(i, hh)); o0[i] *= ai; o1[i] *= ai; } }
            }
            u32x4 pw[4];
#pragma unroll
            for (int e = 0; e < 4; ++e) { pw[0][e] = pk2(s0[2 * e], s0[2 * e + 1]); pw[1][e] = pk2(s0[8 + 2 * e], s0[8 + 2 * e + 1]); pw[2][e] = pk2(s1[2 * e], s1[2 * e + 1]); pw[3][e] = pk2(s1[8 + 2 * e], s1[8 + 2 * e + 1]); }
            const LAS bf16_t* vp = Vb + buf * 4352 + r * 68 + 4 * hh;
#pragma unroll
            for (int ks = 0; ks < 4; ++ks) {
                const u32x2 va0 = *(const LAS u32x2*)(vp + 16 * ks), va1 = *(const LAS u32x2*)(vp + 16 * ks + 8), vb0 = *(const LAS u32x2*)(vp + 32 * 68 + 16 * ks), vb1 = *(const LAS u32x2*)(vp + 32 * 68 + 16 * ks + 8);
                const bf16x8 v0 = __builtin_bit_cast(bf16x8, (u32x4){va0[0], va0[1], va1[0], va1[1]}), v1 = __builtin_bit_cast(bf16x8, (u32x4){vb0[0], vb0[1], vb1[0], vb1[1]});
                const bf16x8 pf = __builtin_bit_cast(bf16x8, pw[ks]);
                o0 = MFMA32(pf, v0, o0); o1 = MFMA32(pf, v1, o1);
            }
        }
        if (t + 1 < NTL) ATT_STORE(buf ^ 1);
        __syncthreads();
    }
#undef ATT_LOADG
#undef ATT_STORE
    const float ltot = lrun + __shfl_xor(lrun, 32), inv = 1.0f / ltot;
    const int b = bh >> 3, head = bh & 7;
#pragma unroll
    for (int i = 0; i < 16; ++i) { const int qr = crow(i, hh); const float f = __shfl(inv, qr);
        bf16_t* op = O + (size_t)(b * SEQ + qw + qr) * 1024 + head * 64 + r;
        op[0] = f2bf(o0[i] * f); op[32] = f2bf(o1[i] * f); }
}

__device__ __forceinline__ void attn_unit64(const bf16_t* Q, const bf16_t* K, const bf16_t* Vt, bf16_t* O, int bh, int qb8, float mfix, LAS unsigned char* lds) {
    const int tid = threadIdx.x, lane = tid & 63, wid = __builtin_amdgcn_readfirstlane(tid >> 6), r = lane & 31, hh = lane >> 5;
    LAS bf16_t* Kb = (LAS bf16_t*)lds;
    LAS bf16_t* Vb = (LAS bf16_t*)(lds + 2 * 64 * 104 * 2);
    const bf16_t* Qh = Q + (size_t)bh * SEQ * 96; const bf16_t* Kh = K + (size_t)bh * SEQ * 96; const bf16_t* Vh = Vt + (size_t)(bh & 7) * 64 * T + (size_t)(bh >> 3) * SEQ;
    const int q0 = qb8 * 512, qw = q0 + wid * 64, NTL = 8 * (qb8 + 1), tmaxw = 8 * qb8 + wid;
    LAS bf16x8* Qs = (LAS bf16x8*)(lds + 2 * 64 * 104 * 2 + 2 * 64 * 68 * 2) + tid;
#pragma unroll
    for (int d0 = 0; d0 < 6; ++d0) { Qs[512 * d0] = *(const bf16x8*)(Qh + (size_t)(qw + r) * 96 + 16 * d0 + 8 * hh); Qs[512 * (6 + d0)] = *(const bf16x8*)(Qh + (size_t)(qw + 32 + r) * 96 + 16 * d0 + 8 * hh); }
    f32x16 oA0, oA1, oB0, oB1;
#pragma unroll
    for (int i = 0; i < 16; ++i) { oA0[i] = 0.f; oA1[i] = 0.f; oB0[i] = 0.f; oB1[i] = 0.f; }
    float lA = 0.f, lB = 0.f;
    const int c2 = 512 + tid, kr1 = tid / 12, kc1 = tid % 12, kr2 = c2 / 12, kc2 = c2 % 12, vr = tid >> 3, vc = tid & 7;
    u32x4 kA, kB = {0u, 0u, 0u, 0u}, vA;
#define ATT_LOADG(t) do { kA = *(const u32x4*)(Kh + (size_t)(t) * 6144 + tid * 8); if (tid < 256) kB = *(const u32x4*)(Kh + (size_t)(t) * 6144 + c2 * 8); \
        vA = *(const u32x4*)(Vh + (size_t)vr * T + 64 * (t) + vc * 8); } while (0)
#define ATT_STORE(buf) do { *(LAS u32x4*)(Kb + (buf) * 6656 + kr1 * 104 + kc1 * 8) = kA; if (tid < 256) *(LAS u32x4*)(Kb + (buf) * 6656 + kr2 * 104 + kc2 * 8) = kB; \
        *(LAS u32x2*)(Vb + (buf) * 4352 + vr * 68 + vc * 8) = (u32x2){vA[0], vA[1]}; *(LAS u32x2*)(Vb + (buf) * 4352 + vr * 68 + vc * 8 + 4) = (u32x2){vA[2], vA[3]}; } while (0)
    ATT_LOADG(0); ATT_STORE(0); __syncthreads();
    for (int t = 0; t < NTL; ++t) {
        const int buf = t & 1;
        if (t + 1 < NTL) ATT_LOADG(t + 1);
        if (t <= tmaxw) {
            const LAS bf16_t* kp = Kb + buf * 6656 + r * 104 + 8 * hh;
            const LAS bf16_t* vp = Vb + buf * 4352 + r * 68 + 4 * hh;
#pragma unroll
            for (int half = 0; half < 2; ++half) {
                f32x16 sA, sB;
#pragma unroll
                for (int i = 0; i < 16; ++i) { sA[i] = -mfix; sB[i] = -mfix; }
#pragma unroll
                for (int d0 = 0; d0 < 6; ++d0) { const bf16x8 a = *(const LAS bf16x8*)(kp + half * 32 * 104 + 16 * d0); const bf16x8 qa_ = Qs[512 * d0], qb_ = Qs[512 * (6 + d0)]; sA = MFMA32(a, qa_, sA); sB = MFMA32(a, qb_, sB); }
                if (t == tmaxw) {
                    const int rowA = qw + r, rowB = qw + 32 + r;
#pragma unroll
                    for (int i = 0; i < 16; ++i) { const int kv = 64 * t + 32 * half + crow(i, hh); if (kv > rowA) sA[i] = -1e30f; if (kv > rowB) sB[i] = -1e30f; }
                }
                float la = 0.f, lb_ = 0.f;
#pragma unroll
                for (int i = 0; i < 16; ++i) { sA[i] = __builtin_amdgcn_exp2f(sA[i]); sB[i] = __builtin_amdgcn_exp2f(sB[i]); la += sA[i]; lb_ += sB[i]; }
                lA += la; lB += lb_;
                u32x4 pwA[2], pwB[2];
#pragma unroll
                for (int e = 0; e < 4; ++e) { pwA[0][e] = pk2(sA[2 * e], sA[2 * e + 1]); pwA[1][e] = pk2(sA[8 + 2 * e], sA[8 + 2 * e + 1]); pwB[0][e] = pk2(sB[2 * e], sB[2 * e + 1]); pwB[1][e] = pk2(sB[8 + 2 * e], sB[8 + 2 * e + 1]); }
#pragma unroll
                for (int k2 = 0; k2 < 2; ++k2) { const int ks = 2 * half + k2;
                    const u32x2 va0 = *(const LAS u32x2*)(vp + 16 * ks), va1 = *(const LAS u32x2*)(vp + 16 * ks + 8), vb0 = *(const LAS u32x2*)(vp + 32 * 68 + 16 * ks), vb1 = *(const LAS u32x2*)(vp + 32 * 68 + 16 * ks + 8);
                    const bf16x8 v0 = __builtin_bit_cast(bf16x8, (u32x4){va0[0], va0[1], va1[0], va1[1]}), v1 = __builtin_bit_cast(bf16x8, (u32x4){vb0[0], vb0[1], vb1[0], vb1[1]});
                    const bf16x8 pfA = __builtin_bit_cast(bf16x8, pwA[k2]), pfB = __builtin_bit_cast(bf16x8, pwB[k2]);
                    oA0 = MFMA32(pfA, v0, oA0); oA1 = MFMA32(pfA, v1, oA1); oB0 = MFMA32(pfB, v0, oB0); oB1 = MFMA32(pfB, v1, oB1); }
                __builtin_amdgcn_sched_barrier(0);
            }
        }
        if (t + 1 < NTL) ATT_STORE(buf ^ 1);
        __syncthreads();
    }
#undef ATT_LOADG
#undef ATT_STORE
    const float ltA = lA + __shfl_xor(lA, 32), ltB = lB + __shfl_xor(lB, 32), invA = 1.0f / ltA, invB = 1.0f / ltB;
    const int b = bh >> 3, head = bh & 7;
#pragma unroll
    for (int i = 0; i < 16; ++i) { const int qr = crow(i, hh); const float fA = __shfl(invA, qr), fB = __shfl(invB, qr);
        bf16_t* opA = O + (size_t)(b * SEQ + qw + qr) * 1024 + head * 64 + r; bf16_t* opB = opA + (size_t)32 * 1024;
        opA[0] = f2bf(oA0[i] * fA); opA[32] = f2bf(oA1[i] * fA); opB[0] = f2bf(oB0[i] * fB); opB[32] = f2bf(oB1[i] * fB); }
}

__device__ __forceinline__ void conv_phase(const Args& a, int tile0, int ntile, int bid, int G) {
    const bf16_t* UH = (const bf16_t*)(a.ws + WS_UH); bf16_t* act = (bf16_t*)(a.ws + WS_ACT);
    const float* cw = a.in[20]; const float* cbias = a.in[21];
    const int gt = bid * NTHR + threadIdx.x, NT_ = G * NTHR;
    const int nit = ntile * 4096 * 16;
    for (int it = gt; it < nit; it += NT_) {
        const int jj = it & 15, tblk = (it >> 4) & 4095, pn = it >> 16;
        const int ch0 = 128 * (tile0 + pn) + 8 * jj, t0 = tblk * 8;
        const bf16_t* up = UH + (size_t)pn * T * 256 + 8 * jj;
        u32x4 gr[10], vr[10];
        const bool first = (t0 & 4095) == 0;
#pragma unroll
        for (int i = 0; i < 10; ++i) { const int t = t0 - 2 + i;
            if (i >= 2 || !first) { gr[i] = *(const u32x4*)(up + (size_t)t * 256); vr[i] = *(const u32x4*)(up + (size_t)t * 256 + 128); }
            else { gr[i] = (u32x4){0u, 0u, 0u, 0u}; vr[i] = (u32x4){0u, 0u, 0u, 0u}; } }
        f32x4 wg[3][2], wv[3][2], bg[2], bv[2];
#pragma unroll
        for (int j = 0; j < 3; ++j)
#pragma unroll
            for (int e = 0; e < 2; ++e) { wg[j][e] = *(const f32x4*)(cw + j * NUP + ch0 + 4 * e); wv[j][e] = *(const f32x4*)(cw + j * NUP + DFF + ch0 + 4 * e); }
#pragma unroll
        for (int e = 0; e < 2; ++e) { bg[e] = *(const f32x4*)(cbias + ch0 + 4 * e); bv[e] = *(const f32x4*)(cbias + DFF + ch0 + 4 * e); }
#pragma unroll
        for (int i = 0; i < 8; ++i) {
            u32x4 w;
#pragma unroll
            for (int e = 0; e < 4; ++e) {
                const int q4 = e >> 1, c0 = 2 * (e & 1);
                const float yg0 = bg[q4][c0] + wg[0][q4][c0] * bflo(gr[i][e]) + wg[1][q4][c0] * bflo(gr[i + 1][e]) + wg[2][q4][c0] * bflo(gr[i + 2][e]);
                const float yg1 = bg[q4][c0 + 1] + wg[0][q4][c0 + 1] * bfhi(gr[i][e]) + wg[1][q4][c0 + 1] * bfhi(gr[i + 1][e]) + wg[2][q4][c0 + 1] * bfhi(gr[i + 2][e]);
                const float yv0 = bv[q4][c0] + wv[0][q4][c0] * bflo(vr[i][e]) + wv[1][q4][c0] * bflo(vr[i + 1][e]) + wv[2][q4][c0] * bflo(vr[i + 2][e]);
                const float yv1 = bv[q4][c0 + 1] + wv[0][q4][c0 + 1] * bfhi(vr[i][e]) + wv[1][q4][c0 + 1] * bfhi(vr[i + 1][e]) + wv[2][q4][c0 + 1] * bfhi(vr[i + 2][e]);
                w[e] = pk2(yg0 * sigmoidf_(yg0) * yv0, yg1 * sigmoidf_(yg1) * yv1);
            }
            *(u32x4*)(act + (size_t)(t0 + i) * DFF + ch0) = w;
        }
    }
}

__device__ __forceinline__ void conv_fix_phase(const Args& a, int bid, int G) {
    const bf16_t* edge = (const bf16_t*)(a.ws + WS_UH); bf16_t* act = (bf16_t*)(a.ws + WS_ACT);
    const float* cw = a.in[20]; const float* cbias = a.in[21];
    const int gt = bid * NTHR + threadIdx.x, NT_ = G * NTHR;
    for (int it = gt; it < 512 * 352; it += NT_) {
        const int cg8 = it % 352, st = it / 352, ch0 = cg8 * 8, pn = ch0 >> 7, j = ch0 & 127, gcol = 256 * pn + j;
        u32x4 gr[4], vr[4];
        const bool first = (st & 63) == 0;
#pragma unroll
        for (int i = 0; i < 4; ++i) {
            if (i >= 2) { const bf16_t* p = edge + ((size_t)st * 4 + (i - 2)) * 5632 + gcol; gr[i] = *(const u32x4*)p; vr[i] = *(const u32x4*)(p + 128); }
            else if (!first) { const bf16_t* p = edge + ((size_t)(st - 1) * 4 + 2 + i) * 5632 + gcol; gr[i] = *(const u32x4*)p; vr[i] = *(const u32x4*)(p + 128); }
            else { gr[i] = (u32x4){0u, 0u, 0u, 0u}; vr[i] = (u32x4){0u, 0u, 0u, 0u}; } }
        f32x4 wg[3][2], wv[3][2], bg[2], bv[2];
#pragma unroll
        for (int jx = 0; jx < 3; ++jx)
#pragma unroll
            for (int e = 0; e < 2; ++e) { wg[jx][e] = *(const f32x4*)(cw + jx * NUP + ch0 + 4 * e); wv[jx][e] = *(const f32x4*)(cw + jx * NUP + DFF + ch0 + 4 * e); }
#pragma unroll
        for (int e = 0; e < 2; ++e) { bg[e] = *(const f32x4*)(cbias + ch0 + 4 * e); bv[e] = *(const f32x4*)(cbias + DFF + ch0 + 4 * e); }
#pragma unroll
        for (int i = 0; i < 2; ++i) {
            u32x4 w;
#pragma unroll
            for (int e = 0; e < 4; ++e) {
                const int q4 = e >> 1, c0 = 2 * (e & 1);
                const float yg0 = bg[q4][c0] + wg[0][q4][c0] * bflo(gr[i][e]) + wg[1][q4][c0] * bflo(gr[i + 1][e]) + wg[2][q4][c0] * bflo(gr[i + 2][e]);
                const float yg1 = bg[q4][c0 + 1] + wg[0][q4][c0 + 1] * bfhi(gr[i][e]) + wg[1][q4][c0 + 1] * bfhi(gr[i + 1][e]) + wg[2][q4][c0 + 1] * bfhi(gr[i + 2][e]);
                const float yv0 = bv[q4][c0] + wv[0][q4][c0] * bflo(vr[i][e]) + wv[1][q4][c0] * bflo(vr[i + 1][e]) + wv[2][q4][c0] * bflo(vr[i + 2][e]);
                const float yv1 = bv[q4][c0 + 1] + wv[0][q4][c0 + 1] * bfhi(vr[i][e]) + wv[1][q4][c0 + 1] * bfhi(vr[i + 1][e]) + wv[2][q4][c0 + 1] * bfhi(vr[i + 2][e]);
                w[e] = pk2(yg0 * sigmoidf_(yg0) * yv0, yg1 * sigmoidf_(yg1) * yv1);
            }
            *(u32x4*)(act + (size_t)(st * 64 + i) * DFF + ch0) = w;
        }
    }
}

#define XB_TMO      128
#define XB_XCNT(j)  (256  + 64 * (j))
#define XB_XSUB(j)  (1280 + 64 * (j))
#define XB_XGEN(j)  (2304 + 64 * (j))
#define XB_TOP      3328
#define XB_TOPGEN   3392
#define XCD_BAR_WORDS 3456
#define XB_SPIN_CAP (1u << 18)

__device__ __forceinline__ unsigned xb_ld(unsigned* p)              { return __hip_atomic_load(p, __ATOMIC_RELAXED, __HIP_MEMORY_SCOPE_AGENT); }
__device__ __forceinline__ unsigned xb_add(unsigned* p, unsigned v) { return __hip_atomic_fetch_add(p, v, __ATOMIC_RELAXED, __HIP_MEMORY_SCOPE_AGENT); }
__device__ __forceinline__ unsigned xb_xcc_id() { return (unsigned)__builtin_amdgcn_s_getreg((3 << 11) | 20) & 0xFu; }
#define XB_SPIN(cond, bar) do { unsigned _sp = 0; while (cond) { __builtin_amdgcn_s_sleep(1); \
    if ((++_sp & 255u) == 0u) { if (xb_ld(&(bar)[XB_TMO])) break; if (_sp > XB_SPIN_CAP) { atomicAdd(&(bar)[XB_TMO], 1u); break; } } } } while (0)

struct XcdBarrier {
    unsigned* bar; unsigned x;
    volatile LAS unsigned* st;
};

__device__ __forceinline__ XcdBarrier xcd_barrier_post(unsigned* bar, volatile LAS unsigned* st) {
    XcdBarrier b; b.bar = bar; b.x = xb_xcc_id(); b.st = st;
    if (threadIdx.x == 0) (void)xb_add(&bar[XB_XCNT(b.x)], 1u);
    return b;
}
__device__ __forceinline__ void xcd_barrier_complete(unsigned* bar, unsigned x, unsigned& nloc, unsigned& nx) {
    const unsigned G = gridDim.x * gridDim.y * gridDim.z;
    unsigned sum, cnt, mine, sp = 0u;
    for (;;) {
        sum = 0u; cnt = 0u; mine = 0u;
#pragma unroll
        for (unsigned j = 0; j < 16; ++j) { const unsigned c = xb_ld(&bar[XB_XCNT(j)]); sum += c; cnt += (c > 0u) ? 1u : 0u; mine = (j == x) ? c : mine; }
        if (sum == G) break;
        __builtin_amdgcn_s_sleep(1);
        if ((++sp & 255u) == 0u) { if (xb_ld(&bar[XB_TMO])) break; if (sp > XB_SPIN_CAP) { atomicAdd(&bar[XB_TMO], 1u); break; } }
    }
    nloc = mine > 0u ? mine : 1u; nx = cnt > 0u ? cnt : 1u;
}

__device__ __forceinline__ void xcd_barrier(const XcdBarrier& b) {
    asm volatile("s_waitcnt vmcnt(0)" ::: "memory");
    __syncthreads();
    if (threadIdx.x == 0) {
        unsigned* bar = b.bar;
        __builtin_amdgcn_s_waitcnt(0);
        unsigned nloc = b.st[0], nx = b.st[1];
        if (nloc == 0u) { xcd_barrier_complete(bar, b.x, nloc, nx); b.st[0] = nloc; b.st[1] = nx; }
        const unsigned old = xb_add(&bar[XB_XSUB(b.x)], 1u);
        const unsigned gen = old / nloc;
        if (old + 1u == (gen + 1u) * nloc) {
            __builtin_amdgcn_fence(__ATOMIC_RELEASE, "agent");
            asm volatile("s_waitcnt vmcnt(0)" ::: "memory");
            const unsigned og = xb_add(&bar[XB_TOP], 1u);
            const unsigned tg = og / nx;
            if (og + 1u == (tg + 1u) * nx) xb_add(&bar[XB_TOPGEN], 1u);
            else XB_SPIN(xb_ld(&bar[XB_TOPGEN]) == tg, bar);
            __builtin_amdgcn_fence(__ATOMIC_ACQUIRE, "agent");
            xb_add(&bar[XB_XGEN(b.x)], 1u);
            asm volatile("s_waitcnt vmcnt(0)" ::: "memory");
        } else {
            XB_SPIN(xb_ld(&bar[XB_XGEN(b.x)]) == gen, bar);
            __builtin_amdgcn_fence(__ATOMIC_ACQUIRE, "agent");
            asm volatile("s_waitcnt vmcnt(0)" ::: "memory");
        }
    }
    __syncthreads();
}


__global__ void __launch_bounds__(NTHR) mk_fwd(Args a) {
    extern __shared__ __attribute__((aligned(16))) unsigned char lds_raw[];
    LAS unsigned char* lds = (LAS unsigned char*)lds_raw;
    cg::grid_group grid = cg::this_grid();
    const int bid = blockIdx.x, G = gridDim.x;
    volatile LAS unsigned* xst = (volatile LAS unsigned*)(lds + LDS_BYTES - 64);
    if (threadIdx.x < 16) xst[threadIdx.x] = 0u;
    __syncthreads();
    XcdBarrier xbar = xcd_barrier_post((unsigned*)(a.ws + WS_BAR), xst);
    unsigned char* ws = a.ws;
    const float* mod = (const float*)(ws + WS_MOD);
#define WSB(off) ((bf16_t*)(ws + (off)))
#ifndef MK_PHMASK
#define MK_PHMASK 0x1ffff
#endif
#define PHON(n) (((MK_PHMASK) >> (n)) & 1)
    const int lo = a.ph_lo, hi = a.ph_hi;
#define IN(k) (PHON(k) && lo <= (k) && (k) < hi)
#define SEAM(k) do { if ((k) + 1 < hi) xcd_barrier(xbar); } while (0)
    if (a.ph_lo < 0) grid.sync();
#ifndef MK_DUP
#define MK_DUP 0
#endif
#ifndef MK_XSYNC
#define MK_XSYNC 0
#endif
#define DUPON(n) (((MK_DUP) >> (n)) & 1)
#define PHASE(k, ...) if (IN(k)) { { __VA_ARGS__ } if (DUPON(k)) { __VA_ARGS__ } SEAM(k); }
    for (int xs_ = 0; xs_ < MK_XSYNC; ++xs_) grid.sync();
    PHASE(0,  p0_phase(a, lds, bid, G); )
    PHASE(1,  adaln_phase<false>(a.in[0], a.in[5], mod, 0, 1024, WSB(SL(2)), bid, G); )
    PHASE(2,  pg8::Gemm g{WSB(SL(2)), WSB(WS_WIN), T, NPROJ, 1024}; pg8::StaticOrder S; S.init(T, NPROJ, G, bid);
                 pg8::EpiProj E{WSB(SL(4)), SLAB_EL, (float*)(ws + WS_RSQ), (float*)(ws + WS_RSKV)};
                 pg8::gemm_phase<pg8::EpiProj, pg8::StaticOrder, true, true>(lds, g, S, E); )
    PHASE(3,
                 h1_phase(WSB(SL(6)), WSB(SL(7)), WSB(SL(8)), WSB(SL(6)), WSB(SL(7)), (const float*)(ws + WS_LB), WSB(SL(14)), (float*)(ws + WS_G), lds, bid, G);
                 if (DUPON(21)) h1_phase(WSB(SL(6)), WSB(SL(7)), WSB(SL(8)), (bf16_t*)a.out, (bf16_t*)a.out + SLAB_EL, (const float*)(ws + WS_LB), (bf16_t*)a.out + 2 * SLAB_EL, (float*)(ws + 40 * MiB), lds, bid, G); )
    PHASE(4,  { pg8::Gemm g{WSB(SL(4)), WSB(WS_WUQ), T, 768, 512}; pg8::StaticOrder S; S.init(T, 768, G, bid);
                 pg8::EpiRowScale E{(bf16_t*)a.out, 768, (const float*)(ws + WS_RSQ), 1.f / 512.f};
                 pg8::gemm_phase<pg8::EpiRowScale, pg8::StaticOrder, true, true>(lds, g, S, E); }
               { pg8::Gemm g{WSB(SL(5)), WSB(WS_WUKV), T, 512, 256, 512}; pg8::StaticOrder S; S.init(T, 512, G, bid);
                 pg8::EpiRowScale E{WSB(SL(2)), 512, (const float*)(ws + WS_RSKV), 1.f / 256.f};
                 pg8::gemm_phase<pg8::EpiRowScale, pg8::StaticOrder, true, true>(lds, g, S, E); }
               { pg8::Gemm g{WSB(WS_WUKV + 512 * 1024), WSB(SL(5)), 512, T, 256, 512}; pg8::StaticOrder S; S.init(512, T, G, bid);
                 pg8::EpiColScale E{WSB(SL(8)), T, (const float*)(ws + WS_RSKV), 1.f / 256.f};
                 pg8::gemm_phase<pg8::EpiColScale, pg8::StaticOrder, true, true>(lds, g, S, E); } )
    PHASE(6,  qk_prep_phase(a, bid, G); if (DUPON(18)) qk_prep_phase(a, bid, G);
                 h2_phase(WSB(SL(14)), (const float*)(ws + WS_G), bid, G); )
    PHASE(7,  const bf16_t* Q = WSB(SL(3)); const bf16_t* K = (const bf16_t*)((unsigned char*)a.out + 64 * MiB); const bf16_t* Vt = WSB(SL(8)); bf16_t* O = (bf16_t*)a.out;
                 float mfix; { const int ln = threadIdx.x & 63; float gqm = fmaxf(fabsf(a.in[11][ln]), fabsf(a.in[11][64 + (ln & 31)])), gkm = fmaxf(fabsf(a.in[12][ln]), fabsf(a.in[12][64 + (ln & 31)]));
                     for (int o = 1; o < 64; o <<= 1) { gqm = fmaxf(gqm, __shfl_xor(gqm, o)); gkm = fmaxf(gkm, __shfl_xor(gkm, o)); }
                     mfix = 14.135f * 1.02f * gqm * gkm; }
                 const bool fix = mfix <= 40.f;
                 for (int rep = 0; rep < (DUPON(19) ? 2 : 1); ++rep) {
                 if (fix) { if (G == 256) { const int bh = bid >> 2, s = bid & 3; attn_unit64(Q, K, Vt, O, bh, 7 - s, mfix, lds); attn_unit64(Q, K, Vt, O, bh, s, mfix, lds); }
                            else { for (int j = bid; j < 512; j += G) attn_unit64(Q, K, Vt, O, j >> 3, 7 - (j & 7), mfix, lds); } }
                 else if (G == 256) { const int bh = bid >> 2, s = bid & 3;
                     for (int i = 0; i < 4; ++i) { const int qb = (i == 0) ? (15 - s) : (i == 1) ? (8 + s) : (i == 2) ? (7 - s) : s; attn_unit<false>(Q, K, Vt, O, bh, qb, mfix, lds); } }
                 else { for (int j = bid; j < 1024; j += G) attn_unit<false>(Q, K, Vt, O, j >> 4, 15 - (j & 15), mfix, lds); }
                 }
                 for (int j = bid; j < 512; j += G) h3_unit(j, WSB(SL(6)), WSB(SL(7)), WSB(SL(14)), WSB(SL(9)), a.in[14], (bf16_t*)a.out);
                 if (DUPON(20)) { for (int j = bid; j < 512; j += G) h3_unit(j, WSB(SL(6)), WSB(SL(7)), WSB(SL(14)), WSB(SL(9)), a.in[14], (bf16_t*)a.out); } )
    PHASE(8,  pg8::Gemm g{(const bf16_t*)a.out, WSB(WS_WA), T, 1024, 512, 1024}; pg8::PairOrder S; S.init(T, 1024, G, bid);
                 pg8::EpiBranchPair E{WSB(SL(10)), WSB(SL(12)), WSB(SL(2)), SLAB_EL};
                 pg8::gemm_phase<pg8::EpiBranchPair, pg8::PairOrder, true, true>(lds, g, S, E); )
    PHASE(10,  pg8::Gemm g{WSB(SL(2)), WSB(WS_WOUT), T, 1024, 1024}; pg8::StaticOrder S; S.init(T, 1024, G, bid);
                  pg8::EpiResGate<false, true> E{a.in[0], WSB(SL(14)), mod + 2048};
                  pg8::gemm_phase<pg8::EpiResGate<false, true>, pg8::StaticOrder, true, true>(lds, g, S, E); )
    PHASE(11,  adaln_phase<true>(WSB(SL(14)), a.in[18], mod, 3072, 4096, (bf16_t*)a.out, bid, G); )
    PHASE(12,  pg8::Gemm g{(const bf16_t*)a.out, WSB(WS_WUP), T, NUP, 1024}; pg8::StaticOrder S; S.init(T, NUP, G, bid);
                  pg8::EpiConvAct E{WSB(WS_ACT), WSB(WS_UH), a.in[20], a.in[21]};
                  pg8::gemm_phase<pg8::EpiConvAct, pg8::StaticOrder, true, true>(lds, g, S, E); )
    PHASE(13,  conv_fix_phase(a, bid, G); )
    PHASE(16,  pg8::Gemm g{WSB(WS_ACT), WSB(WS_WDOWN), T, 1024, DFF}; pg8::StaticOrder S; S.init(T, 1024, G, bid);
                  pg8::EpiResGate<true, false> E{WSB(SL(14)), a.out, mod + 5120};
                  pg8::gemm_phase<pg8::EpiResGate<true, false>, pg8::StaticOrder, true, true>(lds, g, S, E); )
#undef IN
#undef SEAM
#undef PHASE
#undef WSB
}

#ifndef MK_MULTI
#define MK_MULTI 0
#endif
extern "C" void kernel_launch(void* const* d_in, const int* in_sizes, int n_in, void* d_out, int out_size, void* d_ws, size_t ws_size, hipStream_t stream) {
    static int grid = 0;
    if (grid == 0) {
        if (n_in != 23 || out_size != T * DM || ws_size < WS_NEED) { fprintf(stderr, "kernel_launch: unexpected shapes (n_in %d out %d ws %zu)\n", n_in, out_size, ws_size); grid = -1; return; }
        int dev = 0, cus = 0, per_cu = 0;
        hipGetDevice(&dev); hipDeviceGetAttribute(&cus, hipDeviceAttributeMultiprocessorCount, dev);
        hipFuncSetAttribute((const void*)mk_fwd, hipFuncAttributeMaxDynamicSharedMemorySize, LDS_BYTES);
        hipOccupancyMaxActiveBlocksPerMultiprocessor(&per_cu, (const void*)mk_fwd, NTHR, LDS_BYTES);
        if (per_cu < 1) { fprintf(stderr, "kernel_launch: occupancy query says %d blocks per CU\n", per_cu); per_cu = 1; }
        (void)hipGetLastError();
        grid = cus * per_cu;
    }
    if (grid < 0) return;
    if (hipMemsetAsync((char*)d_ws + WS_BAR, 0, XCD_BAR_WORDS * 4, stream) != hipSuccess) { fprintf(stderr, "kernel_launch: memset failed\n"); return; }
    Args a{};
    for (int i = 0; i < 23; ++i) a.in[i] = (const float*)d_in[i];
    a.out = (float*)d_out; a.ws = (unsigned char*)d_ws;
    for (int i = 0; i < 16; ++i) a.invf[i] = powf(10000.0f, -(float)(2 * i) / 32.0f);
#if MK_MULTI
    for (int ph = 0; ph < NPHASE; ++ph) { a.ph_lo = ph; a.ph_hi = ph + 1; hipLaunchKernelGGL(mk_fwd, dim3(grid), dim3(NTHR), LDS_BYTES, stream, a); }
#else
    a.ph_lo = 0; a.ph_hi = NPHASE;
    void* args[] = {&a};
    hipError_t e = hipLaunchCooperativeKernel((const void*)mk_fwd, dim3(grid), dim3(NTHR), args, LDS_BYTES, stream);
    if (e != hipSuccess) fprintf(stderr, "cooperative launch failed: %s (grid %d)\n", hipGetErrorString(e), grid);
#endif
}
```

```cpp
#include <hip/hip_runtime.h>
#include <hip/hip_cooperative_groups.h>
#include <cstdio>
#include <cstdint>
#include <cmath>
namespace cg = cooperative_groups;
namespace pg8 {
#define PG8_LAS __attribute__((address_space(3)))
typedef unsigned short bf16_t;
typedef short bf16x8 __attribute__((ext_vector_type(8)));
typedef float f32x4 __attribute__((ext_vector_type(4)));
typedef unsigned u32x4 __attribute__((ext_vector_type(4)));
constexpr int BM = 256, BK = 64, HALF = 128, HTB = HALF * BK * 2  , STAGE_BYTES = 8 * HTB, NXCD = 8, WGM = 8;

__host__ __device__ __forceinline__ int lds_byte(int r, int c) { const int st = (r >> 4) * 2 + (c >> 5), rr = r & 15, cc = c & 31, ob = rr * 64 + cc * 2; return st * 1024 + (ob ^ (((ob >> 9) & 1) << 5)); }
__host__ __device__ __forceinline__ void stage_rc(int b, int& R, int& C) { const int st = b / 1024, sb = b % 1024, swz = sb ^ (((sb >> 9) & 1) << 5); R = (st >> 1) * 16 + swz / 64; C = (st & 1) * 32 + (swz % 64) / 2; }
__host__ __device__ __forceinline__ int perm32(int rho) { const int n = rho >> 4, i = rho & 15; return 8 * (i >> 2) + 4 * n + (i & 3); }

struct Unit { int pm, pn, kh; };
struct Gemm { const bf16_t* A; const bf16_t* Bt; int M, N, K, ldk; };

struct StaticOrder {
    int nM, nN, nwg, G, c;
    __host__ __device__ void init(int M, int N, int G_, int c_) { nM = M / BM; nN = N / BM; nwg = nM * nN; G = G_; c = c_; }
    __host__ __device__ bool next(int i, Unit& u) const {
        const long L = (long)i * G + c; if (L >= nwg) return false;
        int wgid = (int)L; { const int q = nwg / NXCD, r = nwg % NXCD, xcd = wgid % NXCD, off = wgid / NXCD; wgid = (xcd < r ? xcd * (q + 1) : r * (q + 1) + (xcd - r) * q) + off; }
        const int nig = WGM * nN, gid = wgid / nig, fm = gid * WGM, gsz = (nM - fm) < WGM ? (nM - fm) : WGM;
        u.pm = fm + ((wgid % nig) % gsz); u.pn = (wgid % nig) / gsz; u.kh = 0; return true;
    }
    __device__ __forceinline__ void a_ready(const Unit&) const {}
    __device__ __forceinline__ void done(const Unit&) const {}
};

struct PairOrder {
    StaticOrder base;
    __host__ __device__ void init(int M, int N, int G_, int c_) { base.init(M, N, G_, c_); }
    __host__ __device__ bool next(int i, Unit& u) const { if (!base.next(i >> 1, u)) return false; u.kh = i & 1; return true; }
    __device__ __forceinline__ void a_ready(const Unit&) const {}
    __device__ __forceinline__ void done(const Unit&) const {}
};

__device__ __forceinline__ unsigned cvt_pk_bf16(float lo, float hi) { unsigned r; asm volatile("v_cvt_pk_bf16_f32 %0, %1, %2" : "=v"(r) : "v"(lo), "v"(hi)); return r; }
typedef float f32x2 __attribute__((ext_vector_type(2)));
__device__ __forceinline__ f32x2 gelu_pk(f32x2 v) {
    const f32x2 av = __builtin_elementwise_abs(v), d = av * 0.2316418882f + 1.0f;
    f32x2 t; t.x = __builtin_amdgcn_rcpf(d.x); t.y = __builtin_amdgcn_rcpf(d.y);
    f32x2 q = t * 0.5307027145f + (-0.7265760135f); q = q * t + 0.7107068705f; q = q * t + (-0.142248368f); q = q * t + 0.127414796f; q = q * t;
    const f32x2 s = (v * v) * (-0.72134752044f);
    f32x2 e; e.x = __builtin_amdgcn_exp2f(s.x); e.y = __builtin_amdgcn_exp2f(s.y);
    const f32x2 m = v * (q * e), r = v - m;
    f32x2 o; o.x = v.x < 0.f ? m.x : r.x; o.y = v.y < 0.f ? m.y : r.y; return o;
}

template <int ACT  > struct EpiBf16 {
    static constexpr bool PERM = true, AFTER_DRAIN = false, ROWPERM = false; static_assert(ACT == 0 || ACT == 1, "EpiBf16: ACT is 0 (none) or 1 (gelu_pk)");
    bf16_t* O; int ldc; const float* bias; int split_cols; size_t split_stride; float scale0;
    __device__ __forceinline__ void operator()(const f32x4 (&acc)[2][2][4][2], const Unit& u, int wr, int wc, int fr, int fq) const {
        const int row0 = u.pm * BM + wr * 64 + fr; int colt = u.pn * BM; bf16_t* base = O;
        float sc = 1.f; if (split_cols) { const int t = colt / split_cols; base += (size_t)t * split_stride; colt -= t * split_cols; if (t == 0) sc = scale0; }
        const int col0 = colt + wc * 32 + 8 * fq, bcol0 = u.pn * BM + wc * 32 + 8 * fq;
        f32x4 bv[2][2];
#pragma unroll
        for (int bj = 0; bj < 2; ++bj)
#pragma unroll
            for (int n = 0; n < 2; ++n) bv[bj][n] = bias ? *(const f32x4*)(bias + bcol0 + bj * HALF + 4 * n) : (f32x4){0.f, 0.f, 0.f, 0.f};
#pragma unroll
        for (int ai = 0; ai < 2; ++ai)
#pragma unroll
            for (int m = 0; m < 4; ++m) { bf16_t* rowp = base + (size_t)(row0 + ai * HALF + m * 16) * ldc + col0;
#pragma unroll
                for (int bj = 0; bj < 2; ++bj) { f32x4 v0 = acc[ai][bj][m][0] + bv[bj][0], v1 = acc[ai][bj][m][1] + bv[bj][1];
                    if (ACT == 1) { f32x2 a = gelu_pk((f32x2){v0[0], v0[1]}), b = gelu_pk((f32x2){v0[2], v0[3]}), c = gelu_pk((f32x2){v1[0], v1[1]}), d = gelu_pk((f32x2){v1[2], v1[3]});
                        v0 = (f32x4){a.x, a.y, b.x, b.y}; v1 = (f32x4){c.x, c.y, d.x, d.y}; }
                    v0 = v0 * sc; v1 = v1 * sc; u32x4 w; w.x = cvt_pk_bf16(v0[0], v0[1]); w.y = cvt_pk_bf16(v0[2], v0[3]); w.z = cvt_pk_bf16(v1[0], v1[1]); w.w = cvt_pk_bf16(v1[2], v1[3]);
                    *(u32x4*)(rowp + bj * HALF) = w; } }
    }
};


template <bool BASE_BF16, bool OUT_BF16> struct EpiResGate {
    static constexpr bool PERM = false, AFTER_DRAIN = false, ROWPERM = false;
    const void* base; void* out; const float* gate;
    __device__ __forceinline__ void operator()(const f32x4 (&acc)[2][2][4][2], const Unit& u, int wr, int wc, int fr, int fq) const {
        const int row0 = u.pm * BM + wr * 64 + fr, col0 = u.pn * BM + wc * 32 + 4 * fq;
        const float* gp = gate + ((u.pm * BM) >> 12) * 6144 + col0;
        f32x4 gv[2][2];
#pragma unroll
        for (int bj = 0; bj < 2; ++bj)
#pragma unroll
            for (int n = 0; n < 2; ++n) gv[bj][n] = *(const f32x4*)(gp + bj * HALF + 16 * n);
#pragma unroll
        for (int ai = 0; ai < 2; ++ai) {
            f32x4 bv[4][2][2]; unsigned long long bw[4][2][2];
#pragma unroll
            for (int m = 0; m < 4; ++m) { const size_t off = (size_t)(row0 + ai * HALF + m * 16) * 1024 + col0;
#pragma unroll
                for (int bj = 0; bj < 2; ++bj)
#pragma unroll
                    for (int n = 0; n < 2; ++n) {
                        if (BASE_BF16) bw[m][bj][n] = *(const unsigned long long*)((const bf16_t*)base + off + bj * HALF + 16 * n);
                        else bv[m][bj][n] = *(const f32x4*)((const float*)base + off + bj * HALF + 16 * n); } }
            asm volatile("" ::: "memory");
#pragma unroll
            for (int m = 0; m < 4; ++m) { const size_t off = (size_t)(row0 + ai * HALF + m * 16) * 1024 + col0;
#pragma unroll
                for (int bj = 0; bj < 2; ++bj)
#pragma unroll
                    for (int n = 0; n < 2; ++n) {
                        f32x4 b4;
                        if (BASE_BF16) { const unsigned long long w = bw[m][bj][n];
                            b4 = (f32x4){__uint_as_float((unsigned)(w & 0xffffull) << 16), __uint_as_float((unsigned)((w >> 16) & 0xffffull) << 16),
                                         __uint_as_float((unsigned)((w >> 32) & 0xffffull) << 16), __uint_as_float((unsigned)((w >> 48) & 0xffffull) << 16)}; }
                        else b4 = bv[m][bj][n];
                        const f32x4 o = b4 + gv[bj][n] * acc[ai][bj][m][n];
                        if (OUT_BF16) *(unsigned long long*)((bf16_t*)out + off + bj * HALF + 16 * n) = (unsigned long long)cvt_pk_bf16(o[0], o[1]) | ((unsigned long long)cvt_pk_bf16(o[2], o[3]) << 32);
                        else *(f32x4*)((float*)out + off + bj * HALF + 16 * n) = o; } }
        }
    }
};
template <int MODE> struct EpiBranch {
    static constexpr bool PERM = false, AFTER_DRAIN = false, ROWPERM = false;
    const bf16_t* gsl; float* tmp; bf16_t* merged; size_t slab_elems;
    __device__ __forceinline__ void operator()(const f32x4 (&acc)[2][2][4][2], const Unit& u, int wr, int wc, int fr, int fq) const {
        const int row0 = u.pm * BM + wr * 64 + fr, cin = wc * 32 + 4 * fq, col0 = u.pn * BM + cin;
        const bf16_t* gb = gsl + (size_t)(u.pn >> 1) * slab_elems + (u.pn & 1) * 256 + cin;
#pragma unroll
        for (int ai = 0; ai < 2; ++ai)
#pragma unroll
            for (int m = 0; m < 4; ++m) { const int row = row0 + ai * HALF + m * 16; const size_t off = (size_t)row * 1024 + col0; const bf16_t* gr = gb + (size_t)row * 512;
#pragma unroll
                for (int bj = 0; bj < 2; ++bj)
#pragma unroll
                    for (int n = 0; n < 2; ++n) {
                        const unsigned long long gw = *(const unsigned long long*)(gr + bj * HALF + 16 * n);
                        f32x4 g; g[0] = __uint_as_float((unsigned)(gw & 0xffffull) << 16); g[1] = __uint_as_float((unsigned)((gw >> 16) & 0xffffull) << 16);
                        g[2] = __uint_as_float((unsigned)((gw >> 32) & 0xffffull) << 16); g[3] = __uint_as_float((unsigned)((gw >> 48) & 0xffffull) << 16);
                        f32x4 v;
#pragma unroll
                        for (int e = 0; e < 4; ++e) v[e] = acc[ai][bj][m][n][e] * __builtin_amdgcn_rcpf(1.0f + __expf(-g[e]));
                        unsigned long long* mp = (unsigned long long*)(merged + off + bj * HALF + 16 * n);
                        if (MODE == 0) { *mp = (unsigned long long)cvt_pk_bf16(v[0], v[1]) | ((unsigned long long)cvt_pk_bf16(v[2], v[3]) << 32); }
                        else { const unsigned long long tw = *mp;
                            const f32x4 o = {v[0] + __uint_as_float((unsigned)(tw & 0xffffull) << 16), v[1] + __uint_as_float((unsigned)((tw >> 16) & 0xffffull) << 16),
                                             v[2] + __uint_as_float((unsigned)((tw >> 32) & 0xffffull) << 16), v[3] + __uint_as_float((unsigned)((tw >> 48) & 0xffffull) << 16)};
                            *mp = (unsigned long long)cvt_pk_bf16(o[0], o[1]) | ((unsigned long long)cvt_pk_bf16(o[2], o[3]) << 32); } } }
    }
};

struct EpiBranchPair {
    static constexpr bool PERM = false, AFTER_DRAIN = false, ROWPERM = false;
    const bf16_t* ga; const bf16_t* gb; bf16_t* merged; size_t slab_elems;
    __device__ __forceinline__ void operator()(f32x4 (&acc)[2][2][4][2], const Unit& u, int wr, int wc, int fr, int fq) const {
        const int row0 = u.pm * BM + wr * 64 + fr, cin = wc * 32 + 4 * fq, col0 = u.pn * BM + cin;
        const size_t gofs = (size_t)(u.pn >> 1) * slab_elems + (u.pn & 1) * 256 + cin;
#pragma unroll
        for (int ai = 0; ai < 2; ++ai) {
            unsigned long long wbv[4][2][2], wav[4][2][2];
#pragma unroll
            for (int m = 0; m < 4; ++m) { const size_t gro = gofs + (size_t)(row0 + ai * HALF + m * 16) * 512;
#pragma unroll
                for (int bj = 0; bj < 2; ++bj)
#pragma unroll
                    for (int n = 0; n < 2; ++n) { wbv[m][bj][n] = *(const unsigned long long*)(gb + gro + bj * HALF + 16 * n);
                        if (u.kh == 0) wav[m][bj][n] = *(const unsigned long long*)(ga + gro + bj * HALF + 16 * n); else wav[m][bj][n] = 0ull; } }
            asm volatile("" ::: "memory");
#pragma unroll
            for (int m = 0; m < 4; ++m) { const size_t off = (size_t)(row0 + ai * HALF + m * 16) * 1024 + col0;
#pragma unroll
                for (int bj = 0; bj < 2; ++bj)
#pragma unroll
                    for (int n = 0; n < 2; ++n) {
                        const unsigned long long wb = wbv[m][bj][n];
                        f32x4 eb;
                        eb[0] = __expf(-fmaxf(__uint_as_float((unsigned)(wb & 0xffffull) << 16), -60.f)); eb[1] = __expf(-fmaxf(__uint_as_float((unsigned)((wb >> 16) & 0xffffull) << 16), -60.f));
                        eb[2] = __expf(-fmaxf(__uint_as_float((unsigned)((wb >> 32) & 0xffffull) << 16), -60.f)); eb[3] = __expf(-fmaxf(__uint_as_float((unsigned)((wb >> 48) & 0xffffull) << 16), -60.f));
                        if (u.kh == 0) {
                            const unsigned long long wa = wav[m][bj][n];
                            f32x4 ea;
                            ea[0] = __expf(-__uint_as_float((unsigned)(wa & 0xffffull) << 16)); ea[1] = __expf(-__uint_as_float((unsigned)((wa >> 16) & 0xffffull) << 16));
                            ea[2] = __expf(-__uint_as_float((unsigned)((wa >> 32) & 0xffffull) << 16)); ea[3] = __expf(-__uint_as_float((unsigned)((wa >> 48) & 0xffffull) << 16));
#pragma unroll
                            for (int e_ = 0; e_ < 4; ++e_) acc[ai][bj][m][n][e_] *= (1.0f + eb[e_]) * __builtin_amdgcn_rcpf(1.0f + ea[e_]);
                        } else {
                            f32x4 o;
#pragma unroll
                            for (int e_ = 0; e_ < 4; ++e_) o[e_] = acc[ai][bj][m][n][e_] * __builtin_amdgcn_rcpf(1.0f + eb[e_]);
                            *(unsigned long long*)(merged + off + bj * HALF + 16 * n) = (unsigned long long)cvt_pk_bf16(o[0], o[1]) | ((unsigned long long)cvt_pk_bf16(o[2], o[3]) << 32);
                        } } }
        }
    }
};

__device__ __forceinline__ float dpp_shr1(float v) { return __builtin_bit_cast(float, __builtin_amdgcn_update_dpp(0, __builtin_bit_cast(int, v), 0x111, 0xf, 0xf, true)); }
struct EpiConvAct {
    static constexpr bool PERM = true, AFTER_DRAIN = false, ROWPERM = true;
    bf16_t* act; bf16_t* edge; const float* cw; const float* cb;
    __device__ __forceinline__ void operator()(const f32x4 (&acc)[2][2][4][2], const Unit& u, int wr, int wc, int fr, int fq) const {
        const int chl = wc * 32 + 8 * fq, ch0 = u.pn * 128 + chl, ucol = u.pn * 256 + chl;
#pragma unroll
        for (int n = 0; n < 2; ++n) {
            const f32x4 wg0 = *(const f32x4*)(cw + ch0 + 4 * n), wg1 = *(const f32x4*)(cw + 5632 + ch0 + 4 * n), wg2 = *(const f32x4*)(cw + 2 * 5632 + ch0 + 4 * n), bg = *(const f32x4*)(cb + ch0 + 4 * n);
            const f32x4 wv0 = *(const f32x4*)(cw + 2816 + ch0 + 4 * n), wv1 = *(const f32x4*)(cw + 5632 + 2816 + ch0 + 4 * n), wv2 = *(const f32x4*)(cw + 2 * 5632 + 2816 + ch0 + 4 * n), bv = *(const f32x4*)(cb + 2816 + ch0 + 4 * n);
#pragma unroll
            for (int ai = 0; ai < 2; ++ai) {
                const int stripe = u.pm * 4 + ai * 2 + wr;
                f32x4 pg1, pg2, pv1, pv2;
#pragma unroll
                for (int e = 0; e < 4; ++e) { pg1[e] = dpp_shr1(acc[ai][0][3][n][e]); pg2[e] = dpp_shr1(acc[ai][0][2][n][e]); pv1[e] = dpp_shr1(acc[ai][1][3][n][e]); pv2[e] = dpp_shr1(acc[ai][1][2][n][e]); }
                f32x4 yg[4], yv[4];
                yg[0] = bg + wg0 * pg2 + wg1 * pg1 + wg2 * acc[ai][0][0][n];
                yg[1] = bg + wg0 * pg1 + wg1 * acc[ai][0][0][n] + wg2 * acc[ai][0][1][n];
                yg[2] = bg + wg0 * acc[ai][0][0][n] + wg1 * acc[ai][0][1][n] + wg2 * acc[ai][0][2][n];
                yg[3] = bg + wg0 * acc[ai][0][1][n] + wg1 * acc[ai][0][2][n] + wg2 * acc[ai][0][3][n];
                yv[0] = bv + wv0 * pv2 + wv1 * pv1 + wv2 * acc[ai][1][0][n];
                yv[1] = bv + wv0 * pv1 + wv1 * acc[ai][1][0][n] + wv2 * acc[ai][1][1][n];
                yv[2] = bv + wv0 * acc[ai][1][0][n] + wv1 * acc[ai][1][1][n] + wv2 * acc[ai][1][2][n];
                yv[3] = bv + wv0 * acc[ai][1][1][n] + wv1 * acc[ai][1][2][n] + wv2 * acc[ai][1][3][n];
                bf16_t* arow = act + (size_t)(stripe * 64 + 4 * fr) * 2816 + ch0 + 4 * n;
#pragma unroll
                for (int m = 0; m < 4; ++m) { f32x4 o;
#pragma unroll
                    for (int e = 0; e < 4; ++e) o[e] = yg[m][e] * __builtin_amdgcn_rcpf(1.0f + __expf(-yg[m][e])) * yv[m][e];
                    *(unsigned long long*)(arow + (size_t)m * 2816) = (unsigned long long)cvt_pk_bf16(o[0], o[1]) | ((unsigned long long)cvt_pk_bf16(o[2], o[3]) << 32); }
                if (fr == 0 || fr == 15) {
                    const int m0 = (fr == 0) ? 0 : 2;
#pragma unroll
                    for (int mm = 0; mm < 2; ++mm)
#pragma unroll
                        for (int bj = 0; bj < 2; ++bj) { const f32x4 x = (fr == 0) ? acc[ai][bj][mm][n] : acc[ai][bj][2 + mm][n];
                            *(unsigned long long*)(edge + ((size_t)stripe * 4 + m0 + mm) * 5632 + ucol + bj * HALF + 4 * n) = (unsigned long long)cvt_pk_bf16(x[0], x[1]) | ((unsigned long long)cvt_pk_bf16(x[2], x[3]) << 32); }
                }
            }
        }
    }
};

struct EpiRowScale {
    static constexpr bool PERM = true, AFTER_DRAIN = false, ROWPERM = false;
    bf16_t* O; int ldc; const float* rs; float inv_n;
    __device__ __forceinline__ void operator()(const f32x4 (&acc)[2][2][4][2], const Unit& u, int wr, int wc, int fr, int fq) const {
        const int row0 = u.pm * BM + wr * 64 + fr, col0 = u.pn * BM + wc * 32 + 8 * fq;
#pragma unroll
        for (int ai = 0; ai < 2; ++ai)
#pragma unroll
            for (int m = 0; m < 4; ++m) { const int row = row0 + ai * HALF + m * 16; const float sc = rsqrtf(rs[row] * inv_n + 1e-6f); bf16_t* rowp = O + (size_t)row * ldc + col0;
#pragma unroll
                for (int bj = 0; bj < 2; ++bj) { const f32x4 v0 = acc[ai][bj][m][0] * sc, v1 = acc[ai][bj][m][1] * sc;
                    u32x4 w; w.x = cvt_pk_bf16(v0[0], v0[1]); w.y = cvt_pk_bf16(v0[2], v0[3]); w.z = cvt_pk_bf16(v1[0], v1[1]); w.w = cvt_pk_bf16(v1[2], v1[3]);
                    *(u32x4*)(rowp + bj * HALF) = w; } }
    }
};
struct EpiColScale {
    static constexpr bool PERM = true, AFTER_DRAIN = false, ROWPERM = false;
    bf16_t* O; int ldc; const float* cs; float inv_n;
    __device__ __forceinline__ void operator()(const f32x4 (&acc)[2][2][4][2], const Unit& u, int wr, int wc, int fr, int fq) const {
        const int row0 = u.pm * BM + wr * 64 + fr, col0 = u.pn * BM + wc * 32 + 8 * fq;
#pragma unroll
        for (int bj = 0; bj < 2; ++bj) {
            f32x4 s0 = *(const f32x4*)(cs + col0 + bj * HALF), s1 = *(const f32x4*)(cs + col0 + bj * HALF + 4);
#pragma unroll
            for (int e_ = 0; e_ < 4; ++e_) { s0[e_] = rsqrtf(s0[e_] * inv_n + 1e-6f); s1[e_] = rsqrtf(s1[e_] * inv_n + 1e-6f); }
#pragma unroll
            for (int ai = 0; ai < 2; ++ai)
#pragma unroll
                for (int m = 0; m < 4; ++m) { const f32x4 v0 = acc[ai][bj][m][0] * s0, v1 = acc[ai][bj][m][1] * s1;
                    u32x4 w; w.x = cvt_pk_bf16(v0[0], v0[1]); w.y = cvt_pk_bf16(v0[2], v0[3]); w.z = cvt_pk_bf16(v1[0], v1[1]); w.w = cvt_pk_bf16(v1[2], v1[3]);
                    *(u32x4*)(O + (size_t)(row0 + ai * HALF + m * 16) * ldc + col0 + bj * HALF) = w; }
        }
    }
};

struct EpiProj {
    static constexpr bool PERM = true, AFTER_DRAIN = false, ROWPERM = false;
    bf16_t* O; size_t slab_elems; float* ssq_q; float* ssq_kv;
    __device__ __forceinline__ void operator()(const f32x4 (&acc)[2][2][4][2], const Unit& u, int wr, int wc, int fr, int fq) const {
        const int row0 = u.pm * BM + wr * 64 + fr, col0 = (u.pn & 1) * 256 + wc * 32 + 8 * fq;
        bf16_t* base = O + (size_t)(u.pn >> 1) * slab_elems;
#pragma unroll
        for (int ai = 0; ai < 2; ++ai)
#pragma unroll
            for (int m = 0; m < 4; ++m) { bf16_t* rowp = base + (size_t)(row0 + ai * HALF + m * 16) * 512 + col0;
#pragma unroll
                for (int bj = 0; bj < 2; ++bj) { const f32x4 v0 = acc[ai][bj][m][0], v1 = acc[ai][bj][m][1];
                    u32x4 w; w.x = cvt_pk_bf16(v0[0], v0[1]); w.y = cvt_pk_bf16(v0[2], v0[3]); w.z = cvt_pk_bf16(v1[0], v1[1]); w.w = cvt_pk_bf16(v1[2], v1[3]);
                    *(u32x4*)(rowp + bj * HALF) = w; } }
        if (u.pn <= 2) {
            float* dst = (u.pn < 2) ? ssq_q : ssq_kv;
#pragma unroll
            for (int ai = 0; ai < 2; ++ai)
#pragma unroll
                for (int m = 0; m < 4; ++m) { float s = 0.f;
#pragma unroll
                    for (int bj = 0; bj < 2; ++bj)
#pragma unroll
                        for (int n = 0; n < 2; ++n) { const f32x4 x = acc[ai][bj][m][n]; s += (x[0] * x[0] + x[1] * x[1]) + (x[2] * x[2] + x[3] * x[3]); }
                    s += __shfl_xor(s, 16); s += __shfl_xor(s, 32);
                    if (fq == 0) __hip_atomic_fetch_add(dst + row0 + ai * HALF + m * 16, s, __ATOMIC_RELAXED, __HIP_MEMORY_SCOPE_AGENT); }
        }
    }
};
template <class Epi, class Sched, bool ALIGN_EPI = false, bool SP2 = false>
__device__ __forceinline__ void gemm_phase(PG8_LAS unsigned char* lds, const Gemm g, const Sched& S, const Epi& E) {
    const int tid = threadIdx.x, wid = __builtin_amdgcn_readfirstlane(tid >> 6), lane = tid & 63, wr = wid >> 2, wc = wid & 3, fr = lane & 15, fq = lane >> 4;
    const int K = g.K, nt = K / BK, ldk = g.ldk ? g.ldk : g.K;
    unsigned voffA[2], voffB[2];
#pragma unroll
    for (int i = 0; i < 2; ++i) { int R, C; stage_rc(tid * 16 + i * 8192, R, C); const int Rb = Epi::PERM ? ((R & ~31) + perm32(R & 31)) : R;
        const int Ra = Epi::ROWPERM ? ((R & 64) | ((R & 15) << 2) | ((R >> 4) & 3)) : R;
        voffA[i] = (unsigned)(Ra * ldk + C) * 2u; voffB[i] = (unsigned)(Rb * ldk + C) * 2u; }
    const size_t kstep = (size_t)(BK * 2);
    const size_t hstep = (size_t)HALF * ldk * 2;
    const size_t tstep = 2 * hstep;
    const unsigned ldsw = (unsigned)wid * 1024u;
    const int aoff = lds_byte(wr * 64 + fr, fq * 8), boff = lds_byte(wc * 32 + fr, fq * 8);
#define PG8_SA(b, h) (((b) * 2 + (h)) * HTB)
#define PG8_SB(b, h) ((4 + (b) * 2 + (h)) * HTB)
#define PG8_STAGE(bufoff, gbase, voff) do { _Pragma("unroll") for (int _i = 0; _i < 2; ++_i) \
        __builtin_amdgcn_global_load_lds((const unsigned*)((const char*)(gbase) + (voff)[_i]), (PG8_LAS unsigned*)(lds + (bufoff) + ldsw + _i * 8192), 16, 0, 0); } while (0)
#define PG8_LDA(dst, b, h) do { _Pragma("unroll") for (int m = 0; m < 4; ++m) _Pragma("unroll") for (int k = 0; k < 2; ++k) dst[m][k] = *(const PG8_LAS bf16x8*)(lds + PG8_SA(b, h) + aoff + m * 2048 + k * 1024); } while (0)
#define PG8_LDB(dst, b, h) do { _Pragma("unroll") for (int n = 0; n < 2; ++n) _Pragma("unroll") for (int k = 0; k < 2; ++k) dst[n][k] = *(const PG8_LAS bf16x8*)(lds + PG8_SB(b, h) + boff + n * 2048 + k * 1024); } while (0)
#define PG8_MMA(ai, bj, At, Bt) do { __builtin_amdgcn_s_setprio(1); _Pragma("unroll") for (int m = 0; m < 4; ++m) _Pragma("unroll") for (int n = 0; n < 2; ++n) _Pragma("unroll") for (int k = 0; k < 2; ++k) \
        acc[ai][bj][m][n] = __builtin_amdgcn_mfma_f32_16x16x32_bf16(Bt[n][k], At[m][k], acc[ai][bj][m][n], 0, 0, 0); __builtin_amdgcn_s_setprio(0); } while (0)
#define PG8_WAIT_V(n) asm volatile("s_waitcnt vmcnt(" #n ")" ::: "memory")
#define PG8_WAIT_L(n) asm volatile("s_waitcnt lgkmcnt(" #n ")" ::: "memory")
#define PG8_BAR __builtin_amdgcn_s_barrier()
#define PG8_SCHED __builtin_amdgcn_sched_barrier(0)
    Unit cur, nxt; int ui = 0;
    if (!S.next(0, cur)) return;
    f32x4 acc[2][2][4][2];
#pragma unroll
    for (int a = 0; a < 2; ++a)
#pragma unroll
        for (int b = 0; b < 2; ++b)
#pragma unroll
            for (int m = 0; m < 4; ++m)
#pragma unroll
                for (int n = 0; n < 2; ++n) acc[a][b][m][n] = (f32x4){0.f, 0.f, 0.f, 0.f};
    bf16x8 At[4][2], B0[2][2], B1[2][2];
    const size_t khstep = (size_t)K * 2;
    const char* cA = (const char*)g.A + (size_t)cur.pm * tstep + cur.kh * khstep; const char* cB = (const char*)g.Bt + (size_t)cur.pn * tstep + cur.kh * khstep;
    S.a_ready(cur);
    if constexpr (SP2) {
        PG8_STAGE(PG8_SB(0, 0), cB, voffB); PG8_STAGE(PG8_SB(0, 1), cB + hstep, voffB); PG8_STAGE(PG8_SA(0, 0), cA, voffA); PG8_STAGE(PG8_SA(0, 1), cA + hstep, voffA);
        if (wr == 1) PG8_BAR;
        PG8_WAIT_V(2); PG8_BAR;
        PG8_STAGE(PG8_SB(1, 0), cB + kstep, voffB); PG8_STAGE(PG8_SA(1, 0), cA + kstep, voffA); PG8_STAGE(PG8_SB(1, 1), cB + hstep + kstep, voffB);
        PG8_WAIT_V(6); PG8_BAR;
    } else {
        PG8_STAGE(PG8_SB(0, 0), cB, voffB); PG8_STAGE(PG8_SA(0, 0), cA, voffA); PG8_STAGE(PG8_SB(0, 1), cB + hstep, voffB); PG8_STAGE(PG8_SA(0, 1), cA + hstep, voffA);
        if (wr == 1) PG8_BAR;
        PG8_WAIT_V(4); PG8_BAR;
        PG8_STAGE(PG8_SB(1, 0), cB + kstep, voffB); PG8_STAGE(PG8_SA(1, 0), cA + kstep, voffA); PG8_STAGE(PG8_SB(1, 1), cB + hstep + kstep, voffB);
        PG8_WAIT_V(6); PG8_BAR;
    }
    for (;;) {
        const bool has_next = S.next(ui + 1, nxt);
        const char* nA = has_next ? (const char*)g.A + (size_t)nxt.pm * tstep + nxt.kh * khstep : cA; const char* nB = has_next ? (const char*)g.Bt + (size_t)nxt.pn * tstep + nxt.kh * khstep : cB;
        for (int t = 0; t < nt; t += 2) {
            const bool last = (t == nt - 2);
            const char* a1 = cA + (size_t)(t + 1) * kstep;
            const char* a2 = last ? nA : cA + (size_t)(t + 2) * kstep; const char* b2 = last ? nB : cB + (size_t)(t + 2) * kstep;
            const char* a3 = a2 + kstep; const char* b3 = b2 + kstep;
            if (last && has_next) S.a_ready(nxt);
            if constexpr (SP2) {
            PG8_LDB(B0, 0, 0); PG8_LDB(B1, 0, 1); PG8_SCHED; PG8_LDA(At, 0, 0); PG8_STAGE(PG8_SA(1, 1), a1 + hstep, voffA);
            PG8_WAIT_V(8); PG8_WAIT_L(0); PG8_BAR; PG8_MMA(0, 0, At, B0); PG8_MMA(0, 1, At, B1); PG8_BAR; PG8_SCHED;
            PG8_LDA(At, 0, 1); PG8_STAGE(PG8_SB(0, 0), b2, voffB); PG8_STAGE(PG8_SB(0, 1), b2 + hstep, voffB); PG8_STAGE(PG8_SA(0, 0), a2, voffA);
            PG8_WAIT_V(8); PG8_WAIT_L(0); PG8_BAR; PG8_MMA(1, 0, At, B0); PG8_MMA(1, 1, At, B1); PG8_BAR; PG8_SCHED;
            PG8_LDB(B0, 1, 0); PG8_LDB(B1, 1, 1); PG8_SCHED; PG8_LDA(At, 1, 0); PG8_STAGE(PG8_SA(0, 1), a2 + hstep, voffA);
            PG8_WAIT_V(8); PG8_WAIT_L(0); PG8_BAR; PG8_MMA(0, 0, At, B0); PG8_MMA(0, 1, At, B1); PG8_BAR; PG8_SCHED;
            PG8_LDA(At, 1, 1); PG8_STAGE(PG8_SB(1, 0), b3, voffB); PG8_STAGE(PG8_SB(1, 1), b3 + hstep, voffB); PG8_STAGE(PG8_SA(1, 0), a3, voffA);
            PG8_WAIT_V(8); PG8_WAIT_L(0); PG8_BAR; PG8_MMA(1, 0, At, B0); PG8_MMA(1, 1, At, B1); PG8_BAR; PG8_SCHED;
            } else {
            PG8_LDB(B0, 0, 0); PG8_SCHED; PG8_LDA(At, 0, 0); PG8_STAGE(PG8_SA(1, 1), a1 + hstep, voffA);
            PG8_WAIT_L(8); PG8_BAR; PG8_WAIT_L(0); PG8_MMA(0, 0, At, B0); PG8_BAR; PG8_SCHED;
            PG8_LDB(B1, 0, 1); PG8_STAGE(PG8_SB(0, 0), b2, voffB);
            PG8_BAR; PG8_WAIT_L(0); PG8_MMA(0, 1, At, B1); PG8_BAR;
            PG8_LDA(At, 0, 1); PG8_STAGE(PG8_SA(0, 0), a2, voffA);
            PG8_BAR; PG8_WAIT_L(0); PG8_MMA(1, 0, At, B0); PG8_BAR; PG8_SCHED;
            PG8_STAGE(PG8_SB(0, 1), b2 + hstep, voffB);
            PG8_WAIT_V(6); PG8_BAR; PG8_MMA(1, 1, At, B1); PG8_BAR;
            PG8_LDB(B0, 1, 0); PG8_SCHED; PG8_LDA(At, 1, 0); PG8_STAGE(PG8_SA(0, 1), a2 + hstep, voffA);
            PG8_WAIT_L(8); PG8_BAR; PG8_WAIT_L(0); PG8_MMA(0, 0, At, B0); PG8_BAR; PG8_SCHED;
            PG8_LDB(B1, 1, 1); PG8_STAGE(PG8_SB(1, 0), b3, voffB);
            PG8_BAR; PG8_WAIT_L(0); PG8_MMA(0, 1, At, B1); PG8_BAR;
            PG8_LDA(At, 1, 1); PG8_STAGE(PG8_SA(1, 0), a3, voffA);
            PG8_BAR; PG8_WAIT_L(0); PG8_MMA(1, 0, At, B0); PG8_BAR; PG8_SCHED;
            PG8_STAGE(PG8_SB(1, 1), b3 + hstep, voffB);
            PG8_WAIT_V(6); PG8_BAR; PG8_MMA(1, 1, At, B1); PG8_BAR;
            }
        }
        if constexpr (ALIGN_EPI) { if (wr == 0) PG8_BAR; }
        if constexpr (!Epi::AFTER_DRAIN) { E(acc, cur, wr, wc, fr, fq); S.done(cur); }
        if (!has_next) break;
        if (nxt.kh == 0)
#pragma unroll
        for (int a = 0; a < 2; ++a)
#pragma unroll
            for (int b = 0; b < 2; ++b)
#pragma unroll
                for (int m = 0; m < 4; ++m)
#pragma unroll
                    for (int n = 0; n < 2; ++n) acc[a][b][m][n] = (f32x4){0.f, 0.f, 0.f, 0.f};
        cur = nxt; cA = nA; cB = nB; ++ui;
        if constexpr (ALIGN_EPI) { if (wr == 1) PG8_BAR; }
    }
    PG8_WAIT_V(0);
    if constexpr (!ALIGN_EPI) { if (wr == 0) PG8_BAR; }
    PG8_BAR;
    if constexpr (Epi::AFTER_DRAIN) { E.fused(acc, cur, wr, wc, fr, fq, lds, wid, lane); S.done(cur); }
#undef PG8_SA
#undef PG8_SB
#undef PG8_STAGE
#undef PG8_LDA
#undef PG8_LDB
#undef PG8_MMA
#undef PG8_WAIT_V
#undef PG8_WAIT_L
#undef PG8_BAR
#undef PG8_SCHED
}
}

#define LAS __attribute__((address_space(3)))
typedef unsigned short bf16_t;
typedef short bf16x8 __attribute__((ext_vector_type(8)));
typedef float f32x4 __attribute__((ext_vector_type(4)));
typedef float f32x16 __attribute__((ext_vector_type(16)));
typedef unsigned u32x4 __attribute__((ext_vector_type(4)));
typedef unsigned u32x2 __attribute__((ext_vector_type(2)));

constexpr int T = 32768, DM = 1024, SEQ = 4096;
constexpr int NMOD = 6144, NPROJ = 5120, DFF = 2816, NUP = 5632;
constexpr int NTHR = 512;
constexpr size_t MiB = 1u << 20;
constexpr size_t SLAB = 32 * MiB;
constexpr size_t SLAB_EL = (size_t)T * 512;
constexpr size_t WS_BAR = 512 * 1024;
constexpr size_t WS_MOD = 0, WS_LB = 256 * 1024, WS_G = 1 * MiB, WS_RSQ = 2 * MiB, WS_RSKV = 3 * MiB;
constexpr size_t WS_WIN = 4 * MiB, WS_WUQ = 14 * MiB, WS_WUKV = 15 * MiB, WS_WA = 16 * MiB, WS_WB = 17 * MiB, WS_WOUT = 18 * MiB, WS_WUP = 20 * MiB, WS_WDOWN = 31 * MiB;
__host__ __device__ constexpr size_t SL(int i) { return (size_t)i * SLAB; }
constexpr size_t WS_UH = SL(2);
constexpr size_t WS_ACT = SL(2) + 192 * MiB;
constexpr size_t WS_NEED = 512 * MiB;
constexpr int LDS_BYTES = 147456;
constexpr int NPHASE = 17;

__device__ __forceinline__ float bf2f(unsigned short v) { return __uint_as_float((unsigned)v << 16); }
__device__ __forceinline__ float bflo(unsigned w) { return __uint_as_float(w << 16); }
__device__ __forceinline__ float bfhi(unsigned w) { return __uint_as_float(w & 0xffff0000u); }
typedef float f32x2_t __attribute__((ext_vector_type(2))); typedef __bf16 bf16x2_t __attribute__((ext_vector_type(2)));
__device__ __forceinline__ unsigned pk2(float lo, float hi) { f32x2_t v = {lo, hi}; bf16x2_t b = __builtin_convertvector(v, bf16x2_t); return __builtin_bit_cast(unsigned, b); }
__device__ __forceinline__ unsigned short f2bf(float f) { return (unsigned short)(pk2(f, 0.f) & 0xffffu); }
__device__ __forceinline__ float wave_sum(float v) {
#pragma unroll
    for (int o = 1; o < 64; o <<= 1) v += __shfl_xor(v, o);
    return v;
}
__device__ __forceinline__ float sigmoidf_(float x) { return __builtin_amdgcn_rcpf(1.0f + __expf(-x)); }
#define MFMA16(a, b, c) __builtin_amdgcn_mfma_f32_16x16x32_bf16((a), (b), (c), 0, 0, 0)
#define MFMA32(a, b, c) __builtin_amdgcn_mfma_f32_32x32x16_bf16((a), (b), (c), 0, 0, 0)

struct Args { const float* in[23]; float* out; unsigned char* ws; float invf[16]; int ph_lo, ph_hi; };

__device__ __forceinline__ int srccol(int mapid, int nd) {
    if (mapid == 0) return nd;
    if (mapid == 1) { if (nd < 800) return nd; if (nd < 1024) return -1; return nd - 224; }
    if (mapid == 3) return (nd >> 6) * 128 + (nd & 63);
    if (mapid == 4) return (nd >> 6) * 128 + 64 + (nd & 63);
    const int pn = nd >> 8, j = nd & 255; return (j < 128) ? (128 * pn + j) : (DFF + 128 * pn + (j - 128));
}
__device__ __forceinline__ void wt_item(const float* W, int K, int Nsrc, bf16_t* WT, int mapid, int item, int nblk, LAS unsigned short* tile, int ldk = 0, int kofs = 0, const float* kgain = nullptr) {
    if (ldk == 0) ldk = K;
    const int kb = item / nblk, nb = item % nblk, k0 = kb * 64, n0 = nb * 64;
    const int tid = threadIdx.x, n = tid & 63, kq = tid >> 6;
    const int sc = srccol(mapid, n0 + n);
#pragma unroll
    for (int i = 0; i < 8; ++i) { const int k = i * 8 + kq; float v = (sc >= 0) ? W[(size_t)(k0 + k) * Nsrc + sc] : 0.f; if (kgain) v *= kgain[k0 + k]; tile[n * 66 + k] = f2bf(v); }
    __syncthreads();
    { const int nn = tid >> 3, kc = tid & 7; const LAS unsigned* tp = (const LAS unsigned*)(tile + nn * 66 + kc * 8);
      u32x4 w; w[0] = tp[0]; w[1] = tp[1]; w[2] = tp[2]; w[3] = tp[3];
      *(u32x4*)(WT + (size_t)(n0 + nn) * ldk + kofs + k0 + kc * 8) = w; }
    __syncthreads();
}
__device__ __forceinline__ void p0_phase(const Args& a, LAS unsigned char* lds, int bid, int G) {
    unsigned char* ws = a.ws;
    const int tid = threadIdx.x, lane = tid & 63, wid = tid >> 6;
    for (int cgp = bid; cgp < 96; cgp += G) {
        LAS float* red = (LAS float*)lds;
        const float* c = a.in[1]; const float* w = a.in[3]; const int n = cgp * 64 + lane;
        float acc[8];
#pragma unroll
        for (int b = 0; b < 8; ++b) acc[b] = 0.f;
        for (int k = wid * 128; k < wid * 128 + 128; ++k) { const float wv = w[(size_t)k * NMOD + n];
#pragma unroll
            for (int b = 0; b < 8; ++b) acc[b] += c[b * DM + k] * wv; }
#pragma unroll
        for (int b = 0; b < 8; ++b) red[(wid * 8 + b) * 64 + lane] = acc[b];
        __syncthreads();
        { const int b = wid; float s = 0.f;
#pragma unroll
          for (int w8 = 0; w8 < 8; ++w8) s += red[(w8 * 8 + b) * 64 + lane];
          ((float*)(ws + WS_MOD))[b * NMOD + n] = s + a.in[4][n]; }
        __syncthreads();
    }
    for (int i = bid * NTHR + tid; i < T; i += G * NTHR) { ((float*)(ws + WS_RSQ))[i] = 0.f; ((float*)(ws + WS_RSKV))[i] = 0.f; }
    if (bid == (96 % G)) { const float* t = a.in[13]; ((float*)(ws + WS_LB))[tid] = 1.0f / (1.0f + expf(t[tid] - t[512 + tid])); }
    LAS unsigned short* tile = (LAS unsigned short*)lds;
    constexpr int I0 = 16 * 80, I1 = 8 * 12, I2 = 4 * 8, I2b = 4 * 8, I3 = 8 * 16, I4 = 8 * 16, I5 = 16 * 16, I6 = 16 * 88, I7 = 44 * 16;
    constexpr int NIT = I0 + I1 + I2 + I2b + I3 + I4 + I5 + I6 + I7;
    for (int it = bid; it < NIT; it += G) {
        int r = it;
        if (r < I0) { wt_item(a.in[6], 1024, 4896, (bf16_t*)(ws + WS_WIN), 1, r, 80, tile); continue; } r -= I0;
        if (r < I1) { wt_item(a.in[8], 512, 768, (bf16_t*)(ws + WS_WUQ), 0, r, 12, tile, 0, 0, a.in[7]); continue; } r -= I1;
        if (r < I2) { wt_item(a.in[10], 256, 1024, (bf16_t*)(ws + WS_WUKV), 3, r, 8, tile, 512, 0, a.in[9]); continue; } r -= I2;
        if (r < I2b) { wt_item(a.in[10], 256, 1024, (bf16_t*)(ws + WS_WUKV + 512 * 1024), 4, r, 8, tile, 512, 0, a.in[9]); continue; } r -= I2b;
        if (r < I3) { wt_item(a.in[15], 512, 1024, (bf16_t*)(ws + WS_WA), 0, r, 16, tile, 1024, 0); continue; } r -= I3;
        if (r < I4) { wt_item(a.in[16], 512, 1024, (bf16_t*)(ws + WS_WA), 0, r, 16, tile, 1024, 512); continue; } r -= I4;
        if (r < I5) { wt_item(a.in[17], 1024, 1024, (bf16_t*)(ws + WS_WOUT), 0, r, 16, tile); continue; } r -= I5;
        if (r < I6) { wt_item(a.in[19], 1024, NUP, (bf16_t*)(ws + WS_WUP), 2, r, 88, tile); continue; } r -= I6;
        wt_item(a.in[22], DFF, 1024, (bf16_t*)(ws + WS_WDOWN), 0, r, 16, tile);
    }
}

template <bool IN_BF16> __device__ __forceinline__ void adaln_phase(const void* xin_, const float* g, const float* mod, int shift_off, int scale_off, bf16_t* out, int bid, int G) {
    const int lane = threadIdx.x & 63, wid = threadIdx.x >> 6;
    const int gw = bid * 8 + wid, NGW = G * 8;
    for (int m0 = 2 * gw; m0 < T; m0 += 2 * NGW) {
        f32x4 v[2][4]; float s[2] = {0.f, 0.f};
#pragma unroll
        for (int r = 0; r < 2; ++r) {
            if (IN_BF16) { const u32x2* xr = (const u32x2*)((const bf16_t*)xin_ + (size_t)(m0 + r) * DM) + lane;
#pragma unroll
                for (int j = 0; j < 4; ++j) { const u32x2 w = xr[64 * j]; v[r][j] = (f32x4){bflo(w[0]), bfhi(w[0]), bflo(w[1]), bfhi(w[1])}; } }
            else { const f32x4* xr = (const f32x4*)((const float*)xin_ + (size_t)(m0 + r) * DM) + lane;
#pragma unroll
                for (int j = 0; j < 4; ++j) v[r][j] = xr[64 * j]; } }
        const float* mb = mod + (m0 >> 12) * NMOD;
        f32x4 ga[4], sh[4];
#pragma unroll
        for (int j = 0; j < 4; ++j) { const int col = 4 * lane + 256 * j; const f32x4 gg = *(const f32x4*)(g + col), sc = *(const f32x4*)(mb + scale_off + col); sh[j] = *(const f32x4*)(mb + shift_off + col);
#pragma unroll
            for (int e = 0; e < 4; ++e) ga[j][e] = gg[e] * (1.0f + sc[e]); }
#pragma unroll
        for (int r = 0; r < 2; ++r)
#pragma unroll
            for (int j = 0; j < 4; ++j) s[r] += (v[r][j][0] * v[r][j][0] + v[r][j][1] * v[r][j][1]) + (v[r][j][2] * v[r][j][2] + v[r][j][3] * v[r][j][3]);
#pragma unroll
        for (int o = 1; o < 64; o <<= 1) { s[0] += __shfl_xor(s[0], o); s[1] += __shfl_xor(s[1], o); }
#pragma unroll
        for (int r = 0; r < 2; ++r) { const float rstd = rsqrtf(s[r] * (1.f / DM) + 1e-6f);
            u32x2* o8 = (u32x2*)(out + (size_t)(m0 + r) * DM) + lane;
#pragma unroll
            for (int j = 0; j < 4; ++j) { f32x4 h;
#pragma unroll
                for (int e = 0; e < 4; ++e) h[e] = v[r][j][e] * rstd * ga[j][e] + sh[j][e];
                u32x2 w; w[0] = pk2(h[0], h[1]); w[1] = pk2(h[2], h[3]); o8[64 * j] = w; } }
    }
}

__device__ __forceinline__ void lora_norm_phase(const Args& a, int bid, int G) {
    unsigned char* ws = a.ws;
    const bf16_t* cq = (const bf16_t*)(ws + SL(4)); const bf16_t* ckv = (const bf16_t*)(ws + SL(5));
    float* rsq = (float*)(ws + WS_RSQ); float* rskv = (float*)(ws + WS_RSKV);
    const int lane = threadIdx.x & 63, wid = threadIdx.x >> 6;
    const int gw = bid * 8 + wid, NGW = G * 8;
#pragma unroll 4
    for (int m = gw; m < T; m += NGW) {
        const u32x4 w = *(const u32x4*)(cq + (size_t)m * 512 + 8 * lane);
        u32x4 w2 = {0u, 0u, 0u, 0u};
        if (lane < 32) w2 = *(const u32x4*)(ckv + (size_t)m * 512 + 8 * lane);
        float s = 0.f, s2 = 0.f;
#pragma unroll
        for (int e = 0; e < 4; ++e) { const float v0 = bflo(w[e]), v1 = bfhi(w[e]), u0 = bflo(w2[e]), u1 = bfhi(w2[e]); s += v0 * v0 + v1 * v1; s2 += u0 * u0 + u1 * u1; }
#pragma unroll
        for (int o = 1; o < 64; o <<= 1) { s += __shfl_xor(s, o); s2 += __shfl_xor(s2, o); }
        if (lane == 0) { rsq[m] = rsqrtf(s * (1.f / 512.f) + 1e-6f); rskv[m] = rsqrtf(s2 * (1.f / 256.f) + 1e-6f); }
    }
}

__device__ __forceinline__ void h1_phase(const bf16_t* hq, const bf16_t* hf, const bf16_t* hi, bf16_t* qe_out, bf16_t* intra_out, const float* lb, bf16_t* Ub, float* G, LAS unsigned char* lds, int bid, int Gn) {
    LAS bf16_t* QA = (LAS bf16_t*)lds;
    LAS bf16_t* KD = QA + 4 * 64 * 136;
    LAS bf16_t* KET = KD + 64 * 136;
    LAS bf16_t* VT = KET + 128 * 72;
    LAS bf16_t* AT = VT + 128 * 72;
    LAS float* TOT = (LAS float*)(AT + 64 * 72);
    LAS bf16_t* ST = QA;
    const int tid = threadIdx.x, lane = tid & 63, wid = __builtin_amdgcn_readfirstlane(tid >> 6);
    const int k = tid & 127, I = __builtin_amdgcn_readfirstlane(tid >> 7);
    u32x4 pf[2][3];
#define H1_LOAD(uu) do { const int b_ = (uu) >> 8, h_ = ((uu) >> 6) & 3, c_ = (uu) & 63; _Pragma("unroll") for (int i = 0; i < 2; ++i) { const int id = tid + NTHR * i, row = id >> 4, cc = id & 15; \
        const size_t go = (size_t)(b_ * SEQ + c_ * 64 + row) * 512 + h_ * 128 + cc * 8; pf[i][0] = *(const u32x4*)(hq + go); pf[i][1] = *(const u32x4*)(hf + go); pf[i][2] = *(const u32x4*)(hi + go); } } while (0)
    if (bid < 2048) H1_LOAD(bid);
    for (int u = bid; u < 2048; u += Gn) {
    const int b = u >> 8, h = (u >> 6) & 3, c = u & 63, t0 = b * SEQ + c * 64, cb = h * 128;
#pragma unroll
    for (int i = 0; i < 2; ++i) { const int id = tid + NTHR * i, row = id >> 4, cc = id & 15;
        *(LAS u32x4*)(ST + row * 128 + cc * 8) = pf[i][0]; *(LAS u32x4*)(ST + 8192 + row * 128 + cc * 8) = pf[i][1]; *(LAS u32x4*)(ST + 16384 + row * 128 + cc * 8) = pf[i][2]; }
    __syncthreads();
    if (u + Gn < 2048) H1_LOAD(u + Gn);
    float q[16], kk[16], pc[16]; unsigned short vv[16];
    const float lbk = lb[cb + k]; float run = 1.0f;
#pragma unroll
    for (int i = 0; i < 16; ++i) {
        const float xq = bf2f(ST[(16 * I + i) * 128 + k]), xf = bf2f(ST[8192 + (16 * I + i) * 128 + k]); vv[i] = ST[16384 + (16 * I + i) * 128 + k];
        const float f = lbk + (1.0f - lbk) * sigmoidf_(xf);
        run *= f; pc[i] = run; kk[i] = 1.0f - f; q[i] = xq * sigmoidf_(xq);
    }
    TOT[I * 128 + k] = run;
    for (int j = tid; j < 64 * 72 / 2; j += NTHR) ((LAS unsigned*)AT)[j] = 0u;
    __syncthreads();
    const float tp0 = TOT[k], tp1 = TOT[128 + k], tp2 = TOT[256 + k], tp3 = TOT[384 + k];
    const float ej2 = (I > 2 ? tp2 : 1.f), ej1 = (I > 1 ? tp1 : 1.f) * ej2, ej0 = (I > 0 ? tp0 : 1.f) * ej1;
    const float suf = (I <= 0 ? tp0 : 1.f) * (I <= 1 ? tp1 : 1.f) * (I <= 2 ? tp2 : 1.f) * tp3;
    unsigned kw[8], vw[8];
#pragma unroll
    for (int i = 0; i < 16; ++i) {
        const int s = 16 * I + i;
        const float rp = __builtin_amdgcn_rcpf(pc[i]), qp = q[i] * pc[i];
        KD[s * 136 + k] = f2bf(kk[i] * rp);
        QA[(0 * 64 + s) * 136 + k] = f2bf(qp * ej0);
        if (I >= 1) QA[(1 * 64 + s) * 136 + k] = f2bf(qp * ej1);
        if (I >= 2) QA[(2 * 64 + s) * 136 + k] = f2bf(qp * ej2);
        if (I >= 3) QA[(3 * 64 + s) * 136 + k] = f2bf(qp);
        const float ke = kk[i] * (suf * rp);
        if (i & 1) { kw[i >> 1] |= (unsigned)f2bf(ke) << 16; vw[i >> 1] |= (unsigned)vv[i] << 16; } else { kw[i >> 1] = f2bf(ke); vw[i >> 1] = vv[i]; }
    }
    { LAS u32x4* kp = (LAS u32x4*)(KET + k * 72 + 16 * I); kp[0] = (u32x4){kw[0], kw[1], kw[2], kw[3]}; kp[1] = (u32x4){kw[4], kw[5], kw[6], kw[7]};
      LAS u32x4* vp = (LAS u32x4*)(VT + k * 72 + 16 * I); vp[0] = (u32x4){vw[0], vw[1], vw[2], vw[3]}; vp[1] = (u32x4){vw[4], vw[5], vw[6], vw[7]}; }
    if (I == 0) G[(size_t)u * 128 + k] = (tp0 * tp1) * (tp2 * tp3);
    __syncthreads();
    const int l15 = lane & 15, l4 = lane >> 4;
#pragma unroll
    for (int i = 0; i < 2; ++i) { const int id = tid + NTHR * i, row = id >> 4, cc = id & 15;
        *(u32x4*)(qe_out + (size_t)(t0 + row) * 512 + cb + cc * 8) = *(const LAS u32x4*)(QA + row * 136 + cc * 8); }
    for (int blk = wid; blk < 10; blk += 8) {
        const int Ip = (blk >= 6) ? 3 : (blk >= 3) ? 2 : (blk >= 1) ? 1 : 0, J = blk - Ip * (Ip + 1) / 2;
        f32x4 acc = {0.f, 0.f, 0.f, 0.f};
#pragma unroll
        for (int ks = 0; ks < 4; ++ks) {
            const bf16x8 x = *(const LAS bf16x8*)(QA + (J * 64 + 16 * Ip + l15) * 136 + 32 * ks + 8 * l4);
            const bf16x8 y = *(const LAS bf16x8*)(KD + (16 * J + l15) * 136 + 32 * ks + 8 * l4);
            acc = MFMA16(x, y, acc);
        }
#pragma unroll
        for (int ii = 0; ii < 4; ++ii) { const int tl = 4 * l4 + ii; const float val = (Ip == J && l15 > tl) ? 0.f : acc[ii]; AT[(16 * Ip + tl) * 72 + 16 * J + l15] = f2bf(val); }
    }
    __syncthreads();
    { const int tb = wid & 3, vb0 = (wid >> 2) * 4;
      const bf16x8 x0 = *(const LAS bf16x8*)(AT + (16 * tb + l15) * 72 + 8 * l4), x1 = *(const LAS bf16x8*)(AT + (16 * tb + l15) * 72 + 32 + 8 * l4);
#pragma unroll
      for (int j = 0; j < 4; ++j) { const int vb = vb0 + j;
          const bf16x8 y0 = *(const LAS bf16x8*)(VT + (16 * vb + l15) * 72 + 8 * l4), y1 = *(const LAS bf16x8*)(VT + (16 * vb + l15) * 72 + 32 + 8 * l4);
          f32x4 acc = {0.f, 0.f, 0.f, 0.f}; acc = MFMA16(y0, x0, acc); acc = MFMA16(y1, x1, acc);
          u32x2 w; w[0] = pk2(acc[0], acc[1]); w[1] = pk2(acc[2], acc[3]);
          *(u32x2*)(intra_out + (size_t)(t0 + 16 * tb + l15) * 512 + cb + 16 * vb + 4 * l4) = w; } }
    { const int kb = wid;
      const bf16x8 x0 = *(const LAS bf16x8*)(KET + (16 * kb + l15) * 72 + 8 * l4), x1 = *(const LAS bf16x8*)(KET + (16 * kb + l15) * 72 + 32 + 8 * l4);
#pragma unroll
      for (int vb = 0; vb < 8; ++vb) {
          const bf16x8 y0 = *(const LAS bf16x8*)(VT + (16 * vb + l15) * 72 + 8 * l4), y1 = *(const LAS bf16x8*)(VT + (16 * vb + l15) * 72 + 32 + 8 * l4);
          f32x4 acc = {0.f, 0.f, 0.f, 0.f}; acc = MFMA16(x0, y0, acc); acc = MFMA16(x1, y1, acc);
          u32x2 w; w[0] = pk2(acc[0], acc[1]); w[1] = pk2(acc[2], acc[3]);
          *(u32x2*)(Ub + (size_t)u * 16384 + (16 * vb + l15) * 128 + 16 * kb + 4 * l4) = w; } }
    __syncthreads();
    }
#undef H1_LOAD
}

__device__ __forceinline__ void h2_phase(bf16_t* Ub, const float* __restrict__ G, int bid, int Gn) {
    const int gt = bid * NTHR + threadIdx.x, NT_ = Gn * NTHR;
    for (int e4 = gt; e4 < 131072; e4 += NT_) {
        const int bh = e4 >> 12, e = (e4 & 4095) * 4, k = e & 127;
        bf16_t* p = Ub + (size_t)bh * 64 * 16384 + e; const float* gp = G + (size_t)bh * 64 * 128 + k;
        float s0 = 0.f, s1 = 0.f, s2 = 0.f, s3 = 0.f;
#pragma unroll 1
        for (int c0 = 0; c0 < 64; c0 += 16) {
            u32x2 uv[16]; f32x4 g[16];
#pragma unroll
            for (int j = 0; j < 16; ++j) { uv[j] = *(const u32x2*)(p + (size_t)(c0 + j) * 16384); g[j] = *(const f32x4*)(gp + (c0 + j) * 128); }
#pragma unroll
            for (int j = 0; j < 16; ++j) {
                u32x2 w; w[0] = pk2(s0, s1); w[1] = pk2(s2, s3); *(u32x2*)(p + (size_t)(c0 + j) * 16384) = w;
                s0 = g[j][0] * s0 + bflo(uv[j][0]); s1 = g[j][1] * s1 + bfhi(uv[j][0]); s2 = g[j][2] * s2 + bflo(uv[j][1]); s3 = g[j][3] * s3 + bfhi(uv[j][1]);
            }
        }
    }
}

__device__ __forceinline__ void h3_unit(int j, const bf16_t* qe, const bf16_t* intra, const bf16_t* Ub, const bf16_t* hg, const float* gn, bf16_t* out) {
    const int tid = threadIdx.x, lane = tid & 63, wid = __builtin_amdgcn_readfirstlane(tid >> 6), l15 = lane & 15, l4 = lane >> 4;
    const int b = j >> 6, c = j & 63, t0 = b * SEQ + c * 64;
#pragma unroll 1
    for (int cc = 0; cc < 2; ++cc) {
        const int combo = 2 * wid + cc, head = combo >> 2, tb = combo & 3, u = (b * 4 + head) * 64 + c;
        const size_t rbase = (size_t)(t0 + 16 * tb + l15) * 512 + head * 128;
        bf16x8 x[4];
#pragma unroll
        for (int ks = 0; ks < 4; ++ks) x[ks] = *(const bf16x8*)(qe + rbase + 8 * l4 + 32 * ks);
        u32x2 iv[8], gv[8];
#pragma unroll
        for (int vb = 0; vb < 8; ++vb) { iv[vb] = *(const u32x2*)(intra + rbase + 16 * vb + 4 * l4); gv[vb] = *(const u32x2*)(hg + rbase + 16 * vb + 4 * l4); }
        const bf16_t* ub = Ub + (size_t)u * 16384 + l15 * 128 + 8 * l4;
        f32x4 acc[8];
#pragma unroll
        for (int vb = 0; vb < 8; ++vb) { acc[vb] = (f32x4){0.f, 0.f, 0.f, 0.f};
#pragma unroll
            for (int ks = 0; ks < 4; ++ks) { const bf16x8 y = *(const bf16x8*)(ub + vb * 2048 + 32 * ks); acc[vb] = MFMA16(y, x[ks], acc[vb]); } }
        float ss = 0.f;
#pragma unroll
        for (int vb = 0; vb < 8; ++vb) { acc[vb][0] += bflo(iv[vb][0]); acc[vb][1] += bfhi(iv[vb][0]); acc[vb][2] += bflo(iv[vb][1]); acc[vb][3] += bfhi(iv[vb][1]);
            ss += (acc[vb][0] * acc[vb][0] + acc[vb][1] * acc[vb][1]) + (acc[vb][2] * acc[vb][2] + acc[vb][3] * acc[vb][3]); }
        ss += __shfl_xor(ss, 16); ss += __shfl_xor(ss, 32);
        const float rstd = rsqrtf(ss * (1.f / 128.f) + 1e-6f);
#pragma unroll
        for (int vb = 0; vb < 8; ++vb) { const f32x4 gnv = *(const f32x4*)(gn + 16 * vb + 4 * l4);
            const float g0 = bflo(gv[vb][0]), g1 = bfhi(gv[vb][0]), g2 = bflo(gv[vb][1]), g3 = bfhi(gv[vb][1]);
            u32x2 w; w[0] = pk2(acc[vb][0] * rstd * gnv[0] * (g0 * sigmoidf_(g0)), acc[vb][1] * rstd * gnv[1] * (g1 * sigmoidf_(g1)));
            w[1] = pk2(acc[vb][2] * rstd * gnv[2] * (g2 * sigmoidf_(g2)), acc[vb][3] * rstd * gnv[3] * (g3 * sigmoidf_(g3)));
            *(u32x2*)(out + (size_t)(t0 + 16 * tb + l15) * 1024 + 512 + head * 128 + 16 * vb + 4 * l4) = w; }
    }
}

__device__ __forceinline__ void qk_prep_phase(const Args& a, int bid, int G) {
    unsigned char* ws = a.ws;
    const bf16_t* qraw = (const bf16_t*)a.out; const bf16_t* knope = (const bf16_t*)(ws + SL(2)); const bf16_t* krope = (const bf16_t*)(ws + SL(5)) + 256;
    bf16_t* Q = (bf16_t*)(ws + SL(3)); bf16_t* K = (bf16_t*)((unsigned char*)a.out + 64 * MiB);
    const int* positions = (const int*)a.in[2]; const float* gq = a.in[11]; const float* gk = a.in[12];
    const int lane = threadIdx.x & 63, wid = threadIdx.x >> 6, h = lane >> 3, c = lane & 7, c3 = c & 3;
    const float QS = 0.10206207261596577f * 1.4426950408889634f;
    float gqn[8], gkn[8], gqr[4], gkr[4], invf[4];
#pragma unroll
    for (int j = 0; j < 8; ++j) { gqn[j] = gq[8 * c + j] * QS; gkn[j] = gk[8 * c + j]; }
#pragma unroll
    for (int j = 0; j < 4; ++j) { gqr[j] = gq[64 + 4 * c + j] * QS; gkr[j] = gk[64 + 4 * c + j];
        invf[j] = (c3 == 0) ? a.invf[j] : (c3 == 1) ? a.invf[4 + j] : (c3 == 2) ? a.invf[8 + j] : a.invf[12 + j]; }
    const int gw = bid * 8 + wid, NGW = G * 8;
#pragma unroll 2
    for (int m = gw; m < T; m += NGW) {
        const int b = m >> 12, s = m & 4095;
        const u32x4 qn = *(const u32x4*)(qraw + (size_t)m * 768 + h * 96 + 8 * c); const u32x2 qr = *(const u32x2*)(qraw + (size_t)m * 768 + h * 96 + 64 + 4 * c);
        const u32x4 kn = *(const u32x4*)(knope + (size_t)m * 512 + h * 64 + 8 * c); const u32x2 kr = *(const u32x2*)(krope + (size_t)m * 512 + 4 * c);
        const float posf = (float)positions[m];
        float cs[4], sn[4];
#pragma unroll
        for (int j = 0; j < 4; ++j) { const float ang = posf * invf[j]; double rv = (double)ang * 0.15915494309189535; rv -= __builtin_rint(rv);
            const float fr = (float)rv; sn[j] = __builtin_amdgcn_sinf(fr); cs[j] = __builtin_amdgcn_cosf(fr); }
        size_t ob = ((size_t)(b * 8 + h) * SEQ + s) * 96;
        { float v[8], w[4]; float ss = 0.f;
#pragma unroll
          for (int e = 0; e < 4; ++e) { v[2 * e] = bflo(qn[e]); v[2 * e + 1] = bfhi(qn[e]); ss += v[2 * e] * v[2 * e] + v[2 * e + 1] * v[2 * e + 1]; }
          w[0] = bflo(qr[0]); w[1] = bfhi(qr[0]); w[2] = bflo(qr[1]); w[3] = bfhi(qr[1]); ss += (w[0] * w[0] + w[1] * w[1]) + (w[2] * w[2] + w[3] * w[3]);
          ss += __shfl_xor(ss, 1); ss += __shfl_xor(ss, 2); ss += __shfl_xor(ss, 4);
          const float rstd = rsqrtf(ss * (1.f / 96.f) + 1e-6f);
          u32x4 o; o[0] = pk2(v[0] * rstd * gqn[0], v[1] * rstd * gqn[1]); o[1] = pk2(v[2] * rstd * gqn[2], v[3] * rstd * gqn[3]);
          o[2] = pk2(v[4] * rstd * gqn[4], v[5] * rstd * gqn[5]); o[3] = pk2(v[6] * rstd * gqn[6], v[7] * rstd * gqn[7]);
          float rot[4];
#pragma unroll
          for (int j = 0; j < 4; ++j) { const float n1 = w[j] * rstd * gqr[j], pr = __shfl_xor(n1, 4); rot[j] = (c & 4) ? (n1 * cs[j] + pr * sn[j]) : (n1 * cs[j] - pr * sn[j]); }
          u32x2 o2; o2[0] = pk2(rot[0], rot[1]); o2[1] = pk2(rot[2], rot[3]);
          *(u32x4*)(Q + ob + 8 * c) = o; *(u32x2*)(Q + ob + 64 + 4 * c) = o2; }
        { float v[8], w[4]; float ss = 0.f;
#pragma unroll
          for (int e = 0; e < 4; ++e) { v[2 * e] = bflo(kn[e]); v[2 * e + 1] = bfhi(kn[e]); ss += v[2 * e] * v[2 * e] + v[2 * e + 1] * v[2 * e + 1]; }
          w[0] = bflo(kr[0]); w[1] = bfhi(kr[0]); w[2] = bflo(kr[1]); w[3] = bfhi(kr[1]); ss += (w[0] * w[0] + w[1] * w[1]) + (w[2] * w[2] + w[3] * w[3]);
          ss += __shfl_xor(ss, 1); ss += __shfl_xor(ss, 2); ss += __shfl_xor(ss, 4);
          const float rstd = rsqrtf(ss * (1.f / 96.f) + 1e-6f);
          u32x4 o; o[0] = pk2(v[0] * rstd * gkn[0], v[1] * rstd * gkn[1]); o[1] = pk2(v[2] * rstd * gkn[2], v[3] * rstd * gkn[3]);
          o[2] = pk2(v[4] * rstd * gkn[4], v[5] * rstd * gkn[5]); o[3] = pk2(v[6] * rstd * gkn[6], v[7] * rstd * gkn[7]);
          float rot[4];
#pragma unroll
          for (int j = 0; j < 4; ++j) { const float n1 = w[j] * rstd * gkr[j], pr = __shfl_xor(n1, 4); rot[j] = (c & 4) ? (n1 * cs[j] + pr * sn[j]) : (n1 * cs[j] - pr * sn[j]); }
          u32x2 o2; o2[0] = pk2(rot[0], rot[1]); o2[1] = pk2(rot[2], rot[3]);
          *(u32x4*)(K + ob + 8 * c) = o; *(u32x2*)(K + ob + 64 + 4 * c) = o2; }
    }
}

__device__ __forceinline__ int crow(int r, int hi) { return (r & 3) + 8 * (r >> 2) + 4 * hi; }
template <bool FIX> __device__ __forceinline__ void attn_unit(const bf16_t* Q, const bf16_t* K, const bf16_t* Vt, bf16_t* O, int bh, int qb, float mfix, LAS unsigned char* lds) {
    const int tid = threadIdx.x, lane = tid & 63, wid = __builtin_amdgcn_readfirstlane(tid >> 6), r = lane & 31, hh = lane >> 5;
    LAS bf16_t* Kb = (LAS bf16_t*)lds;
    LAS bf16_t* Vb = (LAS bf16_t*)(lds + 2 * 64 * 104 * 2);
    const bf16_t* Qh = Q + (size_t)bh * SEQ * 96; const bf16_t* Kh = K + (size_t)bh * SEQ * 96; const bf16_t* Vh = Vt + (size_t)(bh & 7) * 64 * T + (size_t)(bh >> 3) * SEQ;
    const int q0 = qb * 256, qw = q0 + wid * 32, NTL = 4 * (qb + 1);
    bf16x8 qf[6];
#pragma unroll
    for (int d0 = 0; d0 < 6; ++d0) qf[d0] = *(const bf16x8*)(Qh + (size_t)(qw + r) * 96 + 16 * d0 + 8 * hh);
    f32x16 o0, o1;
#pragma unroll
    for (int i = 0; i < 16; ++i) { o0[i] = 0.f; o1[i] = 0.f; }
    float mrun = -1e30f, lrun = 0.f;
    f32x16 cinit;
#pragma unroll
    for (int i = 0; i < 16; ++i) cinit[i] = FIX ? -mfix : 0.f;
    asm volatile("" : "+v"(cinit));
    const int c2 = 512 + tid, kr1 = tid / 12, kc1 = tid % 12, kr2 = c2 / 12, kc2 = c2 % 12, vr = tid >> 3, vc = tid & 7;
    u32x4 kA, kB = {0u, 0u, 0u, 0u}, vA;
#define ATT_LOADG(t) do { kA = *(const u32x4*)(Kh + (size_t)(t) * 6144 + tid * 8); if (tid < 256) kB = *(const u32x4*)(Kh + (size_t)(t) * 6144 + c2 * 8); \
        vA = *(const u32x4*)(Vh + (size_t)vr * T + 64 * (t) + vc * 8); } while (0)
#define ATT_STORE(buf) do { *(LAS u32x4*)(Kb + (buf) * 6656 + kr1 * 104 + kc1 * 8) = kA; if (tid < 256) *(LAS u32x4*)(Kb + (buf) * 6656 + kr2 * 104 + kc2 * 8) = kB; \
        *(LAS u32x2*)(Vb + (buf) * 4352 + vr * 68 + vc * 8) = (u32x2){vA[0], vA[1]}; *(LAS u32x2*)(Vb + (buf) * 4352 + vr * 68 + vc * 8 + 4) = (u32x2){vA[2], vA[3]}; } while (0)
    ATT_LOADG(0); ATT_STORE(0); __syncthreads();
    for (int t = 0; t < NTL; ++t) {
        const int buf = t & 1;
        if (t + 1 < NTL) ATT_LOADG(t + 1);
        if (64 * t <= qw + 31) {
            f32x16 s0, s1;
            const LAS bf16_t* kp = Kb + buf * 6656 + r * 104 + 8 * hh;
#pragma unroll
            for (int d0 = 0; d0 < 6; ++d0) {
                const bf16x8 a0 = *(const LAS bf16x8*)(kp + 16 * d0), a1 = *(const LAS bf16x8*)(kp + 32 * 104 + 16 * d0);
                if (d0 == 0) { s0 = MFMA32(a0, qf[0], cinit); s1 = MFMA32(a1, qf[0], cinit); }
                else { s0 = MFMA32(a0, qf[d0], s0); s1 = MFMA32(a1, qf[d0], s1); }
            }
            if (64 * t + 63 > qw) {
                const int qrow = qw + r;
#pragma unroll
                for (int i = 0; i < 16; ++i) { const int kv = 64 * t + crow(i, hh); if (kv > qrow) s0[i] = -1e30f; if (kv + 32 > qrow) s1[i] = -1e30f; }
            }
            if constexpr (FIX) {
                f32x2_t l2 = {0.f, 0.f};
#pragma unroll
                for (int i = 0; i < 16; i += 2) { s0[i] = __builtin_amdgcn_exp2f(s0[i]); s0[i + 1] = __builtin_amdgcn_exp2f(s0[i + 1]); s1[i] = __builtin_amdgcn_exp2f(s1[i]); s1[i + 1] = __builtin_amdgcn_exp2f(s1[i + 1]);
                    l2 += (f32x2_t){s0[i], s0[i + 1]}; l2 += (f32x2_t){s1[i], s1[i + 1]}; }
                lrun += l2[0] + l2[1];
            } else {
            float mx = s0[0];
#pragma unroll
            for (int i = 1; i < 16; ++i) mx = fmaxf(mx, s0[i]);
#pragma unroll
            for (int i = 0; i < 16; ++i) mx = fmaxf(mx, s1[i]);
            mx = fmaxf(mx, __shfl_xor(mx, 32));
            const float mnew = fmaxf(mrun, mx), alpha = __builtin_amdgcn_exp2f(mrun - mnew);
            mrun = mnew;
            float ls = 0.f;
#pragma unroll
            for (int i = 0; i < 16; ++i) { s0[i] = __builtin_amdgcn_exp2f(s0[i] - mnew); s1[i] = __builtin_amdgcn_exp2f(s1[i] - mnew); ls += s0[i] + s1[i]; }
            lrun = lrun * alpha + ls;
            if (__any(alpha != 1.0f)) {
#pragma unroll
                for (int i = 0; i < 16; ++i) { const float ai = __shfl(alpha, crow(i, hh)); o0[i] *= ai; o1[i] *= ai; } }
            }
            u32x4 pw[4];
#pragma unroll
            for (int e = 0; e < 4; ++e) { pw[0][e] = pk2(s0[2 * e], s0[2 * e + 1]); pw[1][e] = pk2(s0[8 + 2 * e], s0[8 + 2 * e + 1]); pw[2][e] = pk2(s1[2 * e], s1[2 * e + 1]); pw[3][e] = pk2(s1[8 + 2 * e], s1[8 + 2 * e + 1]); }
            const LAS bf16_t* vp = Vb + buf * 4352 + r * 68 + 4 * hh;
#pragma unroll
            for (int ks = 0; ks < 4; ++ks) {
                const u32x2 va0 = *(const LAS u32x2*)(vp + 16 * ks), va1 = *(const LAS u32x2*)(vp + 16 * ks + 8), vb0 = *(const LAS u32x2*)(vp + 32 * 68 + 16 * ks), vb1 = *(const LAS u32x2*)(vp + 32 * 68 + 16 * ks + 8);
                const bf16x8 v0 = __builtin_bit_cast(bf16x8, (u32x4){va0[0], va0[1], va1[0], va1[1]}), v1 = __builtin_bit_cast(bf16x8, (u32x4){vb0[0], vb0[1], vb1[0], vb1[1]});
                const bf16x8 pf = __builtin_bit_cast(bf16x8, pw[ks]);
                o0 = MFMA32(pf, v0, o0); o1 = MFMA32(pf, v1, o1);
            }
        }
        if (t + 1 < NTL) ATT_STORE(buf ^ 1);
        __syncthreads();
    }
#undef ATT_LOADG
#undef ATT_STORE
    const float ltot = lrun + __shfl_xor(lrun, 32), inv = 1.0f / ltot;
    const int b = bh >> 3, head = bh & 7;
#pragma unroll
    for (int i = 0; i < 16; ++i) { const int qr = crow(i, hh); const float f = __shfl(inv, qr);
        bf16_t* op = O + (size_t)(b * SEQ + qw + qr) * 1024 + head * 64 + r;
        op[0] = f2bf(o0[i] * f); op[32] = f2bf(o1[i] * f); }
}

__device__ __forceinline__ void attn_unit64(const bf16_t* Q, const bf16_t* K, const bf16_t* Vt, bf16_t* O, int bh, int qb8, float mfix, LAS unsigned char* lds) {
    const int tid = threadIdx.x, lane = tid & 63, wid = __builtin_amdgcn_readfirstlane(tid >> 6), r = lane & 31, hh = lane >> 5;
    LAS bf16_t* Kb = (LAS bf16_t*)lds;
    LAS bf16_t* Vb = (LAS bf16_t*)(lds + 2 * 64 * 104 * 2);
    const bf16_t* Qh = Q + (size_t)bh * SEQ * 96; const bf16_t* Kh = K + (size_t)bh * SEQ * 96; const bf16_t* Vh = Vt + (size_t)(bh & 7) * 64 * T + (size_t)(bh >> 3) * SEQ;
    const int q0 = qb8 * 512, qw = q0 + wid * 64, NTL = 8 * (qb8 + 1), tmaxw = 8 * qb8 + wid;
    LAS bf16x8* Qs = (LAS bf16x8*)(lds + 2 * 64 * 104 * 2 + 2 * 64 * 68 * 2) + tid;
#pragma unroll
    for (int d0 = 0; d0 < 6; ++d0) { Qs[512 * d0] = *(const bf16x8*)(Qh + (size_t)(qw + r) * 96 + 16 * d0 + 8 * hh); Qs[512 * (6 + d0)] = *(const bf16x8*)(Qh + (size_t)(qw + 32 + r) * 96 + 16 * d0 + 8 * hh); }
    f32x16 oA0, oA1, oB0, oB1;
#pragma unroll
    for (int i = 0; i < 16; ++i) { oA0[i] = 0.f; oA1[i] = 0.f; oB0[i] = 0.f; oB1[i] = 0.f; }
    float lA = 0.f, lB = 0.f;
    const int c2 = 512 + tid, kr1 = tid / 12, kc1 = tid % 12, kr2 = c2 / 12, kc2 = c2 % 12, vr = tid >> 3, vc = tid & 7;
    u32x4 kA, kB = {0u, 0u, 0u, 0u}, vA;
#define ATT_LOADG(t) do { kA = *(const u32x4*)(Kh + (size_t)(t) * 6144 + tid * 8); if (tid < 256) kB = *(const u32x4*)(Kh + (size_t)(t) * 6144 + c2 * 8); \
        vA = *(const u32x4*)(Vh + (size_t)vr * T + 64 * (t) + vc * 8); } while (0)
#define ATT_STORE(buf) do { *(LAS u32x4*)(Kb + (buf) * 6656 + kr1 * 104 + kc1 * 8) = kA; if (tid < 256) *(LAS u32x4*)(Kb + (buf) * 6656 + kr2 * 104 + kc2 * 8) = kB; \
        *(LAS u32x2*)(Vb + (buf) * 4352 + vr * 68 + vc * 8) = (u32x2){vA[0], vA[1]}; *(LAS u32x2*)(Vb + (buf) * 4352 + vr * 68 + vc * 8 + 4) = (u32x2){vA[2], vA[3]}; } while (0)
    ATT_LOADG(0); ATT_STORE(0); __syncthreads();
    for (int t = 0; t < NTL; ++t) {
        const int buf = t & 1;
        if (t + 1 < NTL) ATT_LOADG(t + 1);
        if (t <= tmaxw) {
            const LAS bf16_t* kp = Kb + buf * 6656 + r * 104 + 8 * hh;
            const LAS bf16_t* vp = Vb + buf * 4352 + r * 68 + 4 * hh;
#pragma unroll
            for (int half = 0; half < 2; ++half) {
                f32x16 sA, sB;
#pragma unroll
                for (int i = 0; i < 16; ++i) { sA[i] = -mfix; sB[i] = -mfix; }
#pragma unroll
                for (int d0 = 0; d0 < 6; ++d0) { const bf16x8 a = *(const LAS bf16x8*)(kp + half * 32 * 104 + 16 * d0); const bf16x8 qa_ = Qs[512 * d0], qb_ = Qs[512 * (6 + d0)]; sA = MFMA32(a, qa_, sA); sB = MFMA32(a, qb_, sB); }
                if (t == tmaxw) {
                    const int rowA = qw + r, rowB = qw + 32 + r;
#pragma unroll
                    for (int i = 0; i < 16; ++i) { const int kv = 64 * t + 32 * half + crow(i, hh); if (kv > rowA) sA[i] = -1e30f; if (kv > rowB) sB[i] = -1e30f; }
                }
                float la = 0.f, lb_ = 0.f;
#pragma unroll
                for (int i = 0; i < 16; ++i) { sA[i] = __builtin_amdgcn_exp2f(sA[i]); sB[i] = __builtin_amdgcn_exp2f(sB[i]); la += sA[i]; lb_ += sB[i]; }
                lA += la; lB += lb_;
                u32x4 pwA[2], pwB[2];
#pragma unroll
                for (int e = 0; e < 4; ++e) { pwA[0][e] = pk2(sA[2 * e], sA[2 * e + 1]); pwA[1][e] = pk2(sA[8 + 2 * e], sA[8 + 2 * e + 1]); pwB[0][e] = pk2(sB[2 * e], sB[2 * e + 1]); pwB[1][e] = pk2(sB[8 + 2 * e], sB[8 + 2 * e + 1]); }
#pragma unroll
                for (int k2 = 0; k2 < 2; ++k2) { const int ks = 2 * half + k2;
                    const u32x2 va0 = *(const LAS u32x2*)(vp + 16 * ks), va1 = *(const LAS u32x2*)(vp + 16 * ks + 8), vb0 = *(const LAS u32x2*)(vp + 32 * 68 + 16 * ks), vb1 = *(const LAS u32x2*)(vp + 32 * 68 + 16 * ks + 8);
                    const bf16x8 v0 = __builtin_bit_cast(bf16x8, (u32x4){va0[0], va0[1], va1[0], va1[1]}), v1 = __builtin_bit_cast(bf16x8, (u32x4){vb0[0], vb0[1], vb1[0], vb1[1]});
                    const bf16x8 pfA = __builtin_bit_cast(bf16x8, pwA[k2]), pfB = __builtin_bit_cast(bf16x8, pwB[k2]);
                    oA0 = MFMA32(v0, pfA, oA0); oA1 = MFMA32(v1, pfA, oA1); oB0 = MFMA32(v0, pfB, oB0); oB1 = MFMA32(v1, pfB, oB1); }
                __builtin_amdgcn_sched_barrier(0);
            }
        }
        if (t + 1 < NTL) ATT_STORE(buf ^ 1);
        __syncthreads();
    }
#undef ATT_LOADG
#undef ATT_STORE
    const float ltA = lA + __shfl_xor(lA, 32), ltB = lB + __shfl_xor(lB, 32), invA = 1.0f / ltA, invB = 1.0f / ltB;
    const int b = bh >> 3, head = bh & 7;
#define ATT_OSTORE(o0_, o1_, inv_, rowp_) do { \
        _Pragma("unroll") for (int blk_ = 0; blk_ < 2; ++blk_) { \
            _Pragma("unroll") for (int p_ = 0; p_ < 2; ++p_) { const int g_ = 2 * p_; \
                unsigned ax, ay, bx, by; \
                if (blk_ == 0) { ax = pk2(o0_[4 * g_] * inv_, o0_[4 * g_ + 1] * inv_); ay = pk2(o0_[4 * g_ + 2] * inv_, o0_[4 * g_ + 3] * inv_); bx = pk2(o0_[4 * g_ + 4] * inv_, o0_[4 * g_ + 5] * inv_); by = pk2(o0_[4 * g_ + 6] * inv_, o0_[4 * g_ + 7] * inv_); } \
                else { ax = pk2(o1_[4 * g_] * inv_, o1_[4 * g_ + 1] * inv_); ay = pk2(o1_[4 * g_ + 2] * inv_, o1_[4 * g_ + 3] * inv_); bx = pk2(o1_[4 * g_ + 4] * inv_, o1_[4 * g_ + 5] * inv_); by = pk2(o1_[4 * g_ + 6] * inv_, o1_[4 * g_ + 7] * inv_); } \
                { auto r_ = __builtin_amdgcn_permlane32_swap(ax, bx, false, false); ax = r_[0]; bx = r_[1]; } \
                { auto r_ = __builtin_amdgcn_permlane32_swap(ay, by, false, false); ay = r_[0]; by = r_[1]; } \
                *(u32x4*)((rowp_) + 32 * blk_ + 16 * p_ + 8 * hh) = (u32x4){ax, ay, bx, by}; } } } while (0)
    { bf16_t* rowA = O + (size_t)(b * SEQ + qw + r) * 1024 + head * 64; ATT_OSTORE(oA0, oA1, invA, rowA); ATT_OSTORE(oB0, oB1, invB, rowA + (size_t)32 * 1024); }
#undef ATT_OSTORE
}

__device__ __forceinline__ void conv_phase(const Args& a, int tile0, int ntile, int bid, int G) {
    const bf16_t* UH = (const bf16_t*)(a.ws + WS_UH); bf16_t* act = (bf16_t*)(a.ws + WS_ACT);
    const float* cw = a.in[20]; const float* cbias = a.in[21];
    const int gt = bid * NTHR + threadIdx.x, NT_ = G * NTHR;
    const int nit = ntile * 4096 * 16;
    for (int it = gt; it < nit; it += NT_) {
        const int jj = it & 15, tblk = (it >> 4) & 4095, pn = it >> 16;
        const int ch0 = 128 * (tile0 + pn) + 8 * jj, t0 = tblk * 8;
        const bf16_t* up = UH + (size_t)pn * T * 256 + 8 * jj;
        u32x4 gr[10], vr[10];
        const bool first = (t0 & 4095) == 0;
#pragma unroll
        for (int i = 0; i < 10; ++i) { const int t = t0 - 2 + i;
            if (i >= 2 || !first) { gr[i] = *(const u32x4*)(up + (size_t)t * 256); vr[i] = *(const u32x4*)(up + (size_t)t * 256 + 128); }
            else { gr[i] = (u32x4){0u, 0u, 0u, 0u}; vr[i] = (u32x4){0u, 0u, 0u, 0u}; } }
        f32x4 wg[3][2], wv[3][2], bg[2], bv[2];
#pragma unroll
        for (int j = 0; j < 3; ++j)
#pragma unroll
            for (int e = 0; e < 2; ++e) { wg[j][e] = *(const f32x4*)(cw + j * NUP + ch0 + 4 * e); wv[j][e] = *(const f32x4*)(cw + j * NUP + DFF + ch0 + 4 * e); }
#pragma unroll
        for (int e = 0; e < 2; ++e) { bg[e] = *(const f32x4*)(cbias + ch0 + 4 * e); bv[e] = *(const f32x4*)(cbias + DFF + ch0 + 4 * e); }
#pragma unroll
        for (int i = 0; i < 8; ++i) {
            u32x4 w;
#pragma unroll
            for (int e = 0; e < 4; ++e) {
                const int q4 = e >> 1, c0 = 2 * (e & 1);
                const float yg0 = bg[q4][c0] + wg[0][q4][c0] * bflo(gr[i][e]) + wg[1][q4][c0] * bflo(gr[i + 1][e]) + wg[2][q4][c0] * bflo(gr[i + 2][e]);
                const float yg1 = bg[q4][c0 + 1] + wg[0][q4][c0 + 1] * bfhi(gr[i][e]) + wg[1][q4][c0 + 1] * bfhi(gr[i + 1][e]) + wg[2][q4][c0 + 1] * bfhi(gr[i + 2][e]);
                const float yv0 = bv[q4][c0] + wv[0][q4][c0] * bflo(vr[i][e]) + wv[1][q4][c0] * bflo(vr[i + 1][e]) + wv[2][q4][c0] * bflo(vr[i + 2][e]);
                const float yv1 = bv[q4][c0 + 1] + wv[0][q4][c0 + 1] * bfhi(vr[i][e]) + wv[1][q4][c0 + 1] * bfhi(vr[i + 1][e]) + wv[2][q4][c0 + 1] * bfhi(vr[i + 2][e]);
                w[e] = pk2(yg0 * sigmoidf_(yg0) * yv0, yg1 * sigmoidf_(yg1) * yv1);
            }
            *(u32x4*)(act + (size_t)(t0 + i) * DFF + ch0) = w;
        }
    }
}

__device__ __forceinline__ void conv_fix_phase(const Args& a, int bid, int G) {
    const bf16_t* edge = (const bf16_t*)(a.ws + WS_UH); bf16_t* act = (bf16_t*)(a.ws + WS_ACT);
    const float* cw = a.in[20]; const float* cbias = a.in[21];
    const int gt = bid * NTHR + threadIdx.x, NT_ = G * NTHR;
    for (int it = gt; it < 512 * 352; it += NT_) {
        const int cg8 = it % 352, st = it / 352, ch0 = cg8 * 8, pn = ch0 >> 7, j = ch0 & 127, gcol = 256 * pn + j;
        u32x4 gr[4], vr[4];
        const bool first = (st & 63) == 0;
#pragma unroll
        for (int i = 0; i < 4; ++i) {
            if (i >= 2) { const bf16_t* p = edge + ((size_t)st * 4 + (i - 2)) * 5632 + gcol; gr[i] = *(const u32x4*)p; vr[i] = *(const u32x4*)(p + 128); }
            else if (!first) { const bf16_t* p = edge + ((size_t)(st - 1) * 4 + 2 + i) * 5632 + gcol; gr[i] = *(const u32x4*)p; vr[i] = *(const u32x4*)(p + 128); }
            else { gr[i] = (u32x4){0u, 0u, 0u, 0u}; vr[i] = (u32x4){0u, 0u, 0u, 0u}; } }
        f32x4 wg[3][2], wv[3][2], bg[2], bv[2];
#pragma unroll
        for (int jx = 0; jx < 3; ++jx)
#pragma unroll
            for (int e = 0; e < 2; ++e) { wg[jx][e] = *(const f32x4*)(cw + jx * NUP + ch0 + 4 * e); wv[jx][e] = *(const f32x4*)(cw + jx * NUP + DFF + ch0 + 4 * e); }
#pragma unroll
        for (int e = 0; e < 2; ++e) { bg[e] = *(const f32x4*)(cbias + ch0 + 4 * e); bv[e] = *(const f32x4*)(cbias + DFF + ch0 + 4 * e); }
#pragma unroll
        for (int i = 0; i < 2; ++i) {
            u32x4 w;
#pragma unroll
            for (int e = 0; e < 4; ++e) {
                const int q4 = e >> 1, c0 = 2 * (e & 1);
                const float yg0 = bg[q4][c0] + wg[0][q4][c0] * bflo(gr[i][e]) + wg[1][q4][c0] * bflo(gr[i + 1][e]) + wg[2][q4][c0] * bflo(gr[i + 2][e]);
                const float yg1 = bg[q4][c0 + 1] + wg[0][q4][c0 + 1] * bfhi(gr[i][e]) + wg[1][q4][c0 + 1] * bfhi(gr[i + 1][e]) + wg[2][q4][c0 + 1] * bfhi(gr[i + 2][e]);
                const float yv0 = bv[q4][c0] + wv[0][q4][c0] * bflo(vr[i][e]) + wv[1][q4][c0] * bflo(vr[i + 1][e]) + wv[2][q4][c0] * bflo(vr[i + 2][e]);
                const float yv1 = bv[q4][c0 + 1] + wv[0][q4][c0 + 1] * bfhi(vr[i][e]) + wv[1][q4][c0 + 1] * bfhi(vr[i + 1][e]) + wv[2][q4][c0 + 1] * bfhi(vr[i + 2][e]);
                w[e] = pk2(yg0 * sigmoidf_(yg0) * yv0, yg1 * sigmoidf_(yg1) * yv1);
            }
            *(u32x4*)(act + (size_t)(st * 64 + i) * DFF + ch0) = w;
        }
    }
}

#define XB_TMO      128
#define XB_XCNT(j)  (256  + 64 * (j))
#define XB_XSUB(j)  (1280 + 64 * (j))
#define XB_XGEN(j)  (2304 + 64 * (j))
#define XB_TOP      3328
#define XB_TOPGEN   3392
#define XCD_BAR_WORDS 3456
#define XB_SPIN_CAP (1u << 18)

__device__ __forceinline__ unsigned xb_ld(unsigned* p)              { return __hip_atomic_load(p, __ATOMIC_RELAXED, __HIP_MEMORY_SCOPE_AGENT); }
__device__ __forceinline__ unsigned xb_add(unsigned* p, unsigned v) { return __hip_atomic_fetch_add(p, v, __ATOMIC_RELAXED, __HIP_MEMORY_SCOPE_AGENT); }
__device__ __forceinline__ unsigned xb_xcc_id() { return (unsigned)__builtin_amdgcn_s_getreg((3 << 11) | 20) & 0xFu; }
#define XB_SPIN(cond, bar) do { unsigned _sp = 0; while (cond) { __builtin_amdgcn_s_sleep(1); \
    if ((++_sp & 255u) == 0u) { if (xb_ld(&(bar)[XB_TMO])) break; if (_sp > XB_SPIN_CAP) { atomicAdd(&(bar)[XB_TMO], 1u); break; } } } } while (0)

struct XcdBarrier {
    unsigned* bar; unsigned x;
    volatile LAS unsigned* st;
};

__device__ __forceinline__ XcdBarrier xcd_barrier_post(unsigned* bar, volatile LAS unsigned* st) {
    XcdBarrier b; b.bar = bar; b.x = xb_xcc_id(); b.st = st;
    if (threadIdx.x == 0) (void)xb_add(&bar[XB_XCNT(b.x)], 1u);
    return b;
}
__device__ __forceinline__ void xcd_barrier_complete(unsigned* bar, unsigned x, unsigned& nloc, unsigned& nx) {
    const unsigned G = gridDim.x * gridDim.y * gridDim.z;
    unsigned sum, cnt, mine, sp = 0u;
    for (;;) {
        sum = 0u; cnt = 0u; mine = 0u;
#pragma unroll
        for (unsigned j = 0; j < 16; ++j) { const unsigned c = xb_ld(&bar[XB_XCNT(j)]); sum += c; cnt += (c > 0u) ? 1u : 0u; mine = (j == x) ? c : mine; }
        if (sum == G) break;
        __builtin_amdgcn_s_sleep(1);
        if ((++sp & 255u) == 0u) { if (xb_ld(&bar[XB_TMO])) break; if (sp > XB_SPIN_CAP) { atomicAdd(&bar[XB_TMO], 1u); break; } }
    }
    nloc = mine > 0u ? mine : 1u; nx = cnt > 0u ? cnt : 1u;
}

__device__ __forceinline__ void xcd_barrier(const XcdBarrier& b) {
    asm volatile("s_waitcnt vmcnt(0)" ::: "memory");
    __syncthreads();
    if (threadIdx.x == 0) {
        unsigned* bar = b.bar;
        __builtin_amdgcn_s_waitcnt(0);
        unsigned nloc = b.st[0], nx = b.st[1];
        if (nloc == 0u) { xcd_barrier_complete(bar, b.x, nloc, nx); b.st[0] = nloc; b.st[1] = nx; }
        const unsigned old = xb_add(&bar[XB_XSUB(b.x)], 1u);
        const unsigned gen = old / nloc;
        if (old + 1u == (gen + 1u) * nloc) {
            __builtin_amdgcn_fence(__ATOMIC_RELEASE, "agent");
            asm volatile("s_waitcnt vmcnt(0)" ::: "memory");
            const unsigned og = xb_add(&bar[XB_TOP], 1u);
            const unsigned tg = og / nx;
            if (og + 1u == (tg + 1u) * nx) xb_add(&bar[XB_TOPGEN], 1u);
            else XB_SPIN(xb_ld(&bar[XB_TOPGEN]) == tg, bar);
            __builtin_amdgcn_fence(__ATOMIC_ACQUIRE, "agent");
            xb_add(&bar[XB_XGEN(b.x)], 1u);
            asm volatile("s_waitcnt vmcnt(0)" ::: "memory");
        } else {
            XB_SPIN(xb_ld(&bar[XB_XGEN(b.x)]) == gen, bar);
            __builtin_amdgcn_fence(__ATOMIC_ACQUIRE, "agent");
            asm volatile("s_waitcnt vmcnt(0)" ::: "memory");
        }
    }
    __syncthreads();
}


__global__ void __launch_bounds__(NTHR) mk_fwd(Args a) {
    extern __shared__ __attribute__((aligned(16))) unsigned char lds_raw[];
    LAS unsigned char* lds = (LAS unsigned char*)lds_raw;
    cg::grid_group grid = cg::this_grid();
    const int bid = blockIdx.x, G = gridDim.x;
    volatile LAS unsigned* xst = (volatile LAS unsigned*)(lds + LDS_BYTES - 64);
    if (threadIdx.x < 16) xst[threadIdx.x] = 0u;
    __syncthreads();
    XcdBarrier xbar = xcd_barrier_post((unsigned*)(a.ws + WS_BAR), xst);
    unsigned char* ws = a.ws;
    const float* mod = (const float*)(ws + WS_MOD);
#define WSB(off) ((bf16_t*)(ws + (off)))
#ifndef MK_PHMASK
#define MK_PHMASK 0x1ffff
#endif
#define PHON(n) (((MK_PHMASK) >> (n)) & 1)
    const int lo = a.ph_lo, hi = a.ph_hi;
#define IN(k) (PHON(k) && lo <= (k) && (k) < hi)
#define SEAM(k) do { if ((k) + 1 < hi) xcd_barrier(xbar); } while (0)
    if (a.ph_lo < 0) grid.sync();
#ifndef MK_DUP
#define MK_DUP 0
#endif
#ifndef MK_XSYNC
#define MK_XSYNC 0
#endif
#define DUPON(n) (((MK_DUP) >> (n)) & 1)
#define PHASE(k, ...) if (IN(k)) { { __VA_ARGS__ } if (DUPON(k)) { __VA_ARGS__ } SEAM(k); }
    for (int xs_ = 0; xs_ < MK_XSYNC; ++xs_) grid.sync();
    PHASE(0,  p0_phase(a, lds, bid, G); )
    PHASE(1,  adaln_phase<false>(a.in[0], a.in[5], mod, 0, 1024, WSB(SL(2)), bid, G); )
    PHASE(2,  pg8::Gemm g{WSB(SL(2)), WSB(WS_WIN), T, NPROJ, 1024}; pg8::StaticOrder S; S.init(T, NPROJ, G, bid);
                 pg8::EpiProj E{WSB(SL(4)), SLAB_EL, (float*)(ws + WS_RSQ), (float*)(ws + WS_RSKV)};
                 pg8::gemm_phase<pg8::EpiProj, pg8::StaticOrder, true, true>(lds, g, S, E); )
    PHASE(3,
                 h1_phase(WSB(SL(6)), WSB(SL(7)), WSB(SL(8)), WSB(SL(6)), WSB(SL(7)), (const float*)(ws + WS_LB), WSB(SL(14)), (float*)(ws + WS_G), lds, bid, G);
                 if (DUPON(21)) h1_phase(WSB(SL(6)), WSB(SL(7)), WSB(SL(8)), (bf16_t*)a.out, (bf16_t*)a.out + SLAB_EL, (const float*)(ws + WS_LB), (bf16_t*)a.out + 2 * SLAB_EL, (float*)(ws + 40 * MiB), lds, bid, G); )
    PHASE(4,  { pg8::Gemm g{WSB(SL(4)), WSB(WS_WUQ), T, 768, 512}; pg8::StaticOrder S; S.init(T, 768, G, bid);
                 pg8::EpiRowScale E{(bf16_t*)a.out, 768, (const float*)(ws + WS_RSQ), 1.f / 512.f};
                 pg8::gemm_phase<pg8::EpiRowScale, pg8::StaticOrder, true, true>(lds, g, S, E); }
               { pg8::Gemm g{WSB(SL(5)), WSB(WS_WUKV), T, 512, 256, 512}; pg8::StaticOrder S; S.init(T, 512, G, bid);
                 pg8::EpiRowScale E{WSB(SL(2)), 512, (const float*)(ws + WS_RSKV), 1.f / 256.f};
                 pg8::gemm_phase<pg8::EpiRowScale, pg8::StaticOrder, true, true>(lds, g, S, E); }
               { pg8::Gemm g{WSB(WS_WUKV + 512 * 1024), WSB(SL(5)), 512, T, 256, 512}; pg8::StaticOrder S; S.init(512, T, G, bid);
                 pg8::EpiColScale E{WSB(SL(8)), T, (const float*)(ws + WS_RSKV), 1.f / 256.f};
                 pg8::gemm_phase<pg8::EpiColScale, pg8::StaticOrder, true, true>(lds, g, S, E); } )
    PHASE(6,  qk_prep_phase(a, bid, G); if (DUPON(18)) qk_prep_phase(a, bid, G);
                 h2_phase(WSB(SL(14)), (const float*)(ws + WS_G), bid, G); )
    PHASE(7,  const bf16_t* Q = WSB(SL(3)); const bf16_t* K = (const bf16_t*)((unsigned char*)a.out + 64 * MiB); const bf16_t* Vt = WSB(SL(8)); bf16_t* O = (bf16_t*)a.out;
                 float mfix; { const int ln = threadIdx.x & 63; float gqm = fmaxf(fabsf(a.in[11][ln]), fabsf(a.in[11][64 + (ln & 31)])), gkm = fmaxf(fabsf(a.in[12][ln]), fabsf(a.in[12][64 + (ln & 31)]));
                     for (int o = 1; o < 64; o <<= 1) { gqm = fmaxf(gqm, __shfl_xor(gqm, o)); gkm = fmaxf(gkm, __shfl_xor(gkm, o)); }
                     mfix = 14.135f * 1.02f * gqm * gkm; }
                 const bool fix = mfix <= 40.f;
                 for (int rep = 0; rep < (DUPON(19) ? 2 : 1); ++rep) {
                 if (fix) { if (G == 256) { const int bh = bid >> 2, s = bid & 3; attn_unit64(Q, K, Vt, O, bh, 7 - s, mfix, lds); attn_unit64(Q, K, Vt, O, bh, s, mfix, lds); }
                            else { for (int j = bid; j < 512; j += G) attn_unit64(Q, K, Vt, O, j >> 3, 7 - (j & 7), mfix, lds); } }
                 else if (G == 256) { const int bh = bid >> 2, s = bid & 3;
                     for (int i = 0; i < 4; ++i) { const int qb = (i == 0) ? (15 - s) : (i == 1) ? (8 + s) : (i == 2) ? (7 - s) : s; attn_unit<false>(Q, K, Vt, O, bh, qb, mfix, lds); } }
                 else { for (int j = bid; j < 1024; j += G) attn_unit<false>(Q, K, Vt, O, j >> 4, 15 - (j & 15), mfix, lds); }
                 }
                 for (int j = bid; j < 512; j += G) h3_unit(j, WSB(SL(6)), WSB(SL(7)), WSB(SL(14)), WSB(SL(9)), a.in[14], (bf16_t*)a.out);
                 if (DUPON(20)) { for (int j = bid; j < 512; j += G) h3_unit(j, WSB(SL(6)), WSB(SL(7)), WSB(SL(14)), WSB(SL(9)), a.in[14], (bf16_t*)a.out); } )
    PHASE(8,  pg8::Gemm g{(const bf16_t*)a.out, WSB(WS_WA), T, 1024, 512, 1024}; pg8::PairOrder S; S.init(T, 1024, G, bid);
                 pg8::EpiBranchPair E{WSB(SL(10)), WSB(SL(12)), WSB(SL(2)), SLAB_EL};
                 pg8::gemm_phase<pg8::EpiBranchPair, pg8::PairOrder, true, true>(lds, g, S, E); )
    PHASE(10,  pg8::Gemm g{WSB(SL(2)), WSB(WS_WOUT), T, 1024, 1024}; pg8::StaticOrder S; S.init(T, 1024, G, bid);
                  pg8::EpiResGate<false, true> E{a.in[0], WSB(SL(14)), mod + 2048};
                  pg8::gemm_phase<pg8::EpiResGate<false, true>, pg8::StaticOrder, true, true>(lds, g, S, E); )
    PHASE(11,  adaln_phase<true>(WSB(SL(14)), a.in[18], mod, 3072, 4096, (bf16_t*)a.out, bid, G); )
    PHASE(12,  pg8::Gemm g{(const bf16_t*)a.out, WSB(WS_WUP), T, NUP, 1024}; pg8::StaticOrder S; S.init(T, NUP, G, bid);
                  pg8::EpiConvAct E{WSB(WS_ACT), WSB(WS_UH), a.in[20], a.in[21]};
                  pg8::gemm_phase<pg8::EpiConvAct, pg8::StaticOrder, true, true>(lds, g, S, E); )
    PHASE(13,  conv_fix_phase(a, bid, G); )
    PHASE(16,  pg8::Gemm g{WSB(WS_ACT), WSB(WS_WDOWN), T, 1024, DFF}; pg8::StaticOrder S; S.init(T, 1024, G, bid);
                  pg8::EpiResGate<true, false> E{WSB(SL(14)), a.out, mod + 5120};
                  pg8::gemm_phase<pg8::EpiResGate<true, false>, pg8::StaticOrder, true, true>(lds, g, S, E); )
#undef IN
#undef SEAM
#undef PHASE
#undef WSB
}

#ifndef MK_MULTI
#define MK_MULTI 0
#endif
extern "C" void kernel_launch(void* const* d_in, const int* in_sizes, int n_in, void* d_out, int out_size, void* d_ws, size_t ws_size, hipStream_t stream) {
    static int grid = 0;
    if (grid == 0) {
        if (n_in != 23 || out_size != T * DM || ws_size < WS_NEED) { fprintf(stderr, "kernel_launch: unexpected shapes (n_in %d out %d ws %zu)\n", n_in, out_size, ws_size); grid = -1; return; }
        int dev = 0, cus = 0, per_cu = 0;
        hipGetDevice(&dev); hipDeviceGetAttribute(&cus, hipDeviceAttributeMultiprocessorCount, dev);
        hipFuncSetAttribute((const void*)mk_fwd, hipFuncAttributeMaxDynamicSharedMemorySize, LDS_BYTES);
        hipOccupancyMaxActiveBlocksPerMultiprocessor(&per_cu, (const void*)mk_fwd, NTHR, LDS_BYTES);
        if (per_cu < 1) { fprintf(stderr, "kernel_launch: occupancy query says %d blocks per CU\n", per_cu); per_cu = 1; }
        (void)hipGetLastError();
        grid = cus * per_cu;
    }
    if (grid < 0) return;
    if (hipMemsetAsync((char*)d_ws + WS_BAR, 0, XCD_BAR_WORDS * 4, stream) != hipSuccess) { fprintf(stderr, "kernel_launch: memset failed\n"); return; }
    Args a{};
    for (int i = 0; i < 23; ++i) a.in[i] = (const float*)d_in[i];
    a.out = (float*)d_out; a.ws = (unsigned char*)d_ws;
    for (int i = 0; i < 16; ++i) a.invf[i] = powf(10000.0f, -(float)(2 * i) / 32.0f);
#if MK_MULTI
    for (int ph = 0; ph < NPHASE; ++ph) { a.ph_lo = ph; a.ph_hi = ph + 1; hipLaunchKernelGGL(mk_fwd, dim3(grid), dim3(NTHR), LDS_BYTES, stream, a); }
#else
    a.ph_lo = 0; a.ph_hi = NPHASE;
    void* args[] = {&a};
    hipError_t e = hipLaunchCooperativeKernel((const void*)mk_fwd, dim3(grid), dim3(NTHR), args, LDS_BYTES, stream);
    if (e != hipSuccess) fprintf(stderr, "cooperative launch failed: %s (grid %d)\n", hipGetErrorString(e), grid);
#endif
}
```

```cpp
#include <hip/hip_runtime.h>
#include <hip/hip_cooperative_groups.h>
#include <cstdio>
#include <cstdint>
#include <cmath>
namespace cg = cooperative_groups;
namespace pg8 {
#define PG8_LAS __attribute__((address_space(3)))
typedef unsigned short bf16_t;
typedef short bf16x8 __attribute__((ext_vector_type(8)));
typedef float f32x4 __attribute__((ext_vector_type(4)));
typedef unsigned u32x4 __attribute__((ext_vector_type(4)));
constexpr int BM = 256, BK = 64, HALF = 128, HTB = HALF * BK * 2  , STAGE_BYTES = 8 * HTB, NXCD = 8, WGM = 8;

__host__ __device__ __forceinline__ int lds_byte(int r, int c) { const int st = (r >> 4) * 2 + (c >> 5), rr = r & 15, cc = c & 31, ob = rr * 64 + cc * 2; return st * 1024 + (ob ^ (((ob >> 9) & 1) << 5)); }
__host__ __device__ __forceinline__ void stage_rc(int b, int& R, int& C) { const int st = b / 1024, sb = b % 1024, swz = sb ^ (((sb >> 9) & 1) << 5); R = (st >> 1) * 16 + swz / 64; C = (st & 1) * 32 + (swz % 64) / 2; }
__host__ __device__ __forceinline__ int perm32(int rho) { const int n = rho >> 4, i = rho & 15; return 8 * (i >> 2) + 4 * n + (i & 3); }

struct Unit { int pm, pn, kh; };
struct Gemm { const bf16_t* A; const bf16_t* Bt; int M, N, K, ldk; };

struct StaticOrder {
    int nM, nN, nwg, G, c;
    __host__ __device__ void init(int M, int N, int G_, int c_) { nM = M / BM; nN = N / BM; nwg = nM * nN; G = G_; c = c_; }
    __host__ __device__ bool next(int i, Unit& u) const {
        const long L = (long)i * G + c; if (L >= nwg) return false;
        int wgid = (int)L; { const int q = nwg / NXCD, r = nwg % NXCD, xcd = wgid % NXCD, off = wgid / NXCD; wgid = (xcd < r ? xcd * (q + 1) : r * (q + 1) + (xcd - r) * q) + off; }
        const int nig = WGM * nN, gid = wgid / nig, fm = gid * WGM, gsz = (nM - fm) < WGM ? (nM - fm) : WGM;
        u.pm = fm + ((wgid % nig) % gsz); u.pn = (wgid % nig) / gsz; u.kh = 0; return true;
    }
    __device__ __forceinline__ void a_ready(const Unit&) const {}
    __device__ __forceinline__ void done(const Unit&) const {}
};

struct PairOrder {
    StaticOrder base;
    __host__ __device__ void init(int M, int N, int G_, int c_) { base.init(M, N, G_, c_); }
    __host__ __device__ bool next(int i, Unit& u) const { if (!base.next(i >> 1, u)) return false; u.kh = i & 1; return true; }
    __device__ __forceinline__ void a_ready(const Unit&) const {}
    __device__ __forceinline__ void done(const Unit&) const {}
};

__device__ __forceinline__ unsigned cvt_pk_bf16(float lo, float hi) { unsigned r; asm volatile("v_cvt_pk_bf16_f32 %0, %1, %2" : "=v"(r) : "v"(lo), "v"(hi)); return r; }
typedef float f32x2 __attribute__((ext_vector_type(2)));
__device__ __forceinline__ f32x2 gelu_pk(f32x2 v) {
    const f32x2 av = __builtin_elementwise_abs(v), d = av * 0.2316418882f + 1.0f;
    f32x2 t; t.x = __builtin_amdgcn_rcpf(d.x); t.y = __builtin_amdgcn_rcpf(d.y);
    f32x2 q = t * 0.5307027145f + (-0.7265760135f); q = q * t + 0.7107068705f; q = q * t + (-0.142248368f); q = q * t + 0.127414796f; q = q * t;
    const f32x2 s = (v * v) * (-0.72134752044f);
    f32x2 e; e.x = __builtin_amdgcn_exp2f(s.x); e.y = __builtin_amdgcn_exp2f(s.y);
    const f32x2 m = v * (q * e), r = v - m;
    f32x2 o; o.x = v.x < 0.f ? m.x : r.x; o.y = v.y < 0.f ? m.y : r.y; return o;
}

template <int ACT  > struct EpiBf16 {
    static constexpr bool PERM = true, AFTER_DRAIN = false, ROWPERM = false; static_assert(ACT == 0 || ACT == 1, "EpiBf16: ACT is 0 (none) or 1 (gelu_pk)");
    bf16_t* O; int ldc; const float* bias; int split_cols; size_t split_stride; float scale0;
    __device__ __forceinline__ void operator()(const f32x4 (&acc)[2][2][4][2], const Unit& u, int wr, int wc, int fr, int fq) const {
        const int row0 = u.pm * BM + wr * 64 + fr; int colt = u.pn * BM; bf16_t* base = O;
        float sc = 1.f; if (split_cols) { const int t = colt / split_cols; base += (size_t)t * split_stride; colt -= t * split_cols; if (t == 0) sc = scale0; }
        const int col0 = colt + wc * 32 + 8 * fq, bcol0 = u.pn * BM + wc * 32 + 8 * fq;
        f32x4 bv[2][2];
#pragma unroll
        for (int bj = 0; bj < 2; ++bj)
#pragma unroll
            for (int n = 0; n < 2; ++n) bv[bj][n] = bias ? *(const f32x4*)(bias + bcol0 + bj * HALF + 4 * n) : (f32x4){0.f, 0.f, 0.f, 0.f};
#pragma unroll
        for (int ai = 0; ai < 2; ++ai)
#pragma unroll
            for (int m = 0; m < 4; ++m) { bf16_t* rowp = base + (size_t)(row0 + ai * HALF + m * 16) * ldc + col0;
#pragma unroll
                for (int bj = 0; bj < 2; ++bj) { f32x4 v0 = acc[ai][bj][m][0] + bv[bj][0], v1 = acc[ai][bj][m][1] + bv[bj][1];
                    if (ACT == 1) { f32x2 a = gelu_pk((f32x2){v0[0], v0[1]}), b = gelu_pk((f32x2){v0[2], v0[3]}), c = gelu_pk((f32x2){v1[0], v1[1]}), d = gelu_pk((f32x2){v1[2], v1[3]});
                        v0 = (f32x4){a.x, a.y, b.x, b.y}; v1 = (f32x4){c.x, c.y, d.x, d.y}; }
                    v0 = v0 * sc; v1 = v1 * sc; u32x4 w; w.x = cvt_pk_bf16(v0[0], v0[1]); w.y = cvt_pk_bf16(v0[2], v0[3]); w.z = cvt_pk_bf16(v1[0], v1[1]); w.w = cvt_pk_bf16(v1[2], v1[3]);
                    *(u32x4*)(rowp + bj * HALF) = w; } }
    }
};


template <bool BASE_BF16, bool OUT_BF16> struct EpiResGate {
    static constexpr bool PERM = false, AFTER_DRAIN = false, ROWPERM = false;
    const void* base; void* out; const float* gate;
    __device__ __forceinline__ void operator()(const f32x4 (&acc)[2][2][4][2], const Unit& u, int wr, int wc, int fr, int fq) const {
        const int row0 = u.pm * BM + wr * 64 + fr, col0 = u.pn * BM + wc * 32 + 4 * fq;
        const float* gp = gate + ((u.pm * BM) >> 12) * 6144 + col0;
        f32x4 gv[2][2];
#pragma unroll
        for (int bj = 0; bj < 2; ++bj)
#pragma unroll
            for (int n = 0; n < 2; ++n) gv[bj][n] = *(const f32x4*)(gp + bj * HALF + 16 * n);
#pragma unroll
        for (int ai = 0; ai < 2; ++ai) {
            f32x4 bv[4][2][2]; unsigned long long bw[4][2][2];
#pragma unroll
            for (int m = 0; m < 4; ++m) { const size_t off = (size_t)(row0 + ai * HALF + m * 16) * 1024 + col0;
#pragma unroll
                for (int bj = 0; bj < 2; ++bj)
#pragma unroll
                    for (int n = 0; n < 2; ++n) {
                        if (BASE_BF16) bw[m][bj][n] = *(const unsigned long long*)((const bf16_t*)base + off + bj * HALF + 16 * n);
                        else bv[m][bj][n] = __builtin_nontemporal_load((const f32x4*)((const float*)base + off + bj * HALF + 16 * n)); } }
            asm volatile("" ::: "memory");
#pragma unroll
            for (int m = 0; m < 4; ++m) { const size_t off = (size_t)(row0 + ai * HALF + m * 16) * 1024 + col0;
#pragma unroll
                for (int bj = 0; bj < 2; ++bj)
#pragma unroll
                    for (int n = 0; n < 2; ++n) {
                        f32x4 b4;
                        if (BASE_BF16) { const unsigned long long w = bw[m][bj][n];
                            b4 = (f32x4){__uint_as_float((unsigned)(w & 0xffffull) << 16), __uint_as_float((unsigned)((w >> 16) & 0xffffull) << 16),
                                         __uint_as_float((unsigned)((w >> 32) & 0xffffull) << 16), __uint_as_float((unsigned)((w >> 48) & 0xffffull) << 16)}; }
                        else b4 = bv[m][bj][n];
                        const f32x4 o = b4 + gv[bj][n] * acc[ai][bj][m][n];
                        if (OUT_BF16) *(unsigned long long*)((bf16_t*)out + off + bj * HALF + 16 * n) = (unsigned long long)cvt_pk_bf16(o[0], o[1]) | ((unsigned long long)cvt_pk_bf16(o[2], o[3]) << 32);
                        else *(f32x4*)((float*)out + off + bj * HALF + 16 * n) = o; } }
        }
    }
};
template <int MODE> struct EpiBranch {
    static constexpr bool PERM = false, AFTER_DRAIN = false, ROWPERM = false;
    const bf16_t* gsl; float* tmp; bf16_t* merged; size_t slab_elems;
    __device__ __forceinline__ void operator()(const f32x4 (&acc)[2][2][4][2], const Unit& u, int wr, int wc, int fr, int fq) const {
        const int row0 = u.pm * BM + wr * 64 + fr, cin = wc * 32 + 4 * fq, col0 = u.pn * BM + cin;
        const bf16_t* gb = gsl + (size_t)(u.pn >> 1) * slab_elems + (u.pn & 1) * 256 + cin;
#pragma unroll
        for (int ai = 0; ai < 2; ++ai)
#pragma unroll
            for (int m = 0; m < 4; ++m) { const int row = row0 + ai * HALF + m * 16; const size_t off = (size_t)row * 1024 + col0; const bf16_t* gr = gb + (size_t)row * 512;
#pragma unroll
                for (int bj = 0; bj < 2; ++bj)
#pragma unroll
                    for (int n = 0; n < 2; ++n) {
                        const unsigned long long gw = *(const unsigned long long*)(gr + bj * HALF + 16 * n);
                        f32x4 g; g[0] = __uint_as_float((unsigned)(gw & 0xffffull) << 16); g[1] = __uint_as_float((unsigned)((gw >> 16) & 0xffffull) << 16);
                        g[2] = __uint_as_float((unsigned)((gw >> 32) & 0xffffull) << 16); g[3] = __uint_as_float((unsigned)((gw >> 48) & 0xffffull) << 16);
                        f32x4 v;
#pragma unroll
                        for (int e = 0; e < 4; ++e) v[e] = acc[ai][bj][m][n][e] * __builtin_amdgcn_rcpf(1.0f + __expf(-g[e]));
                        unsigned long long* mp = (unsigned long long*)(merged + off + bj * HALF + 16 * n);
                        if (MODE == 0) { *mp = (unsigned long long)cvt_pk_bf16(v[0], v[1]) | ((unsigned long long)cvt_pk_bf16(v[2], v[3]) << 32); }
                        else { const unsigned long long tw = *mp;
                            const f32x4 o = {v[0] + __uint_as_float((unsigned)(tw & 0xffffull) << 16), v[1] + __uint_as_float((unsigned)((tw >> 16) & 0xffffull) << 16),
                                             v[2] + __uint_as_float((unsigned)((tw >> 32) & 0xffffull) << 16), v[3] + __uint_as_float((unsigned)((tw >> 48) & 0xffffull) << 16)};
                            *mp = (unsigned long long)cvt_pk_bf16(o[0], o[1]) | ((unsigned long long)cvt_pk_bf16(o[2], o[3]) << 32); } } }
    }
};

struct EpiBranchPair {
    static constexpr bool PERM = false, AFTER_DRAIN = false, ROWPERM = false;
    const bf16_t* ga; const bf16_t* gb; bf16_t* merged; size_t slab_elems;
    __device__ __forceinline__ void operator()(f32x4 (&acc)[2][2][4][2], const Unit& u, int wr, int wc, int fr, int fq) const {
        const int row0 = u.pm * BM + wr * 64 + fr, cin = wc * 32 + 4 * fq, col0 = u.pn * BM + cin;
        const size_t gofs = (size_t)(u.pn >> 1) * slab_elems + (u.pn & 1) * 256 + cin;
#pragma unroll
        for (int ai = 0; ai < 2; ++ai) {
            unsigned long long wbv[4][2][2], wav[4][2][2];
#pragma unroll
            for (int m = 0; m < 4; ++m) { const size_t gro = gofs + (size_t)(row0 + ai * HALF + m * 16) * 512;
#pragma unroll
                for (int bj = 0; bj < 2; ++bj)
#pragma unroll
                    for (int n = 0; n < 2; ++n) { wbv[m][bj][n] = *(const unsigned long long*)(gb + gro + bj * HALF + 16 * n);
                        if (u.kh == 0) wav[m][bj][n] = __builtin_nontemporal_load((const unsigned long long*)(ga + gro + bj * HALF + 16 * n)); else wav[m][bj][n] = 0ull; } }
            asm volatile("" ::: "memory");
#pragma unroll
            for (int m = 0; m < 4; ++m) { const size_t off = (size_t)(row0 + ai * HALF + m * 16) * 1024 + col0;
#pragma unroll
                for (int bj = 0; bj < 2; ++bj)
#pragma unroll
                    for (int n = 0; n < 2; ++n) {
                        const unsigned long long wb = wbv[m][bj][n];
                        f32x4 eb;
                        eb[0] = __expf(-fmaxf(__uint_as_float((unsigned)(wb & 0xffffull) << 16), -60.f)); eb[1] = __expf(-fmaxf(__uint_as_float((unsigned)((wb >> 16) & 0xffffull) << 16), -60.f));
                        eb[2] = __expf(-fmaxf(__uint_as_float((unsigned)((wb >> 32) & 0xffffull) << 16), -60.f)); eb[3] = __expf(-fmaxf(__uint_as_float((unsigned)((wb >> 48) & 0xffffull) << 16), -60.f));
                        if (u.kh == 0) {
                            const unsigned long long wa = wav[m][bj][n];
                            f32x4 ea;
                            ea[0] = __expf(-__uint_as_float((unsigned)(wa & 0xffffull) << 16)); ea[1] = __expf(-__uint_as_float((unsigned)((wa >> 16) & 0xffffull) << 16));
                            ea[2] = __expf(-__uint_as_float((unsigned)((wa >> 32) & 0xffffull) << 16)); ea[3] = __expf(-__uint_as_float((unsigned)((wa >> 48) & 0xffffull) << 16));
#pragma unroll
                            for (int e_ = 0; e_ < 4; ++e_) acc[ai][bj][m][n][e_] *= (1.0f + eb[e_]) * __builtin_amdgcn_rcpf(1.0f + ea[e_]);
                        } else {
                            f32x4 o;
#pragma unroll
                            for (int e_ = 0; e_ < 4; ++e_) o[e_] = acc[ai][bj][m][n][e_] * __builtin_amdgcn_rcpf(1.0f + eb[e_]);
                            *(unsigned long long*)(merged + off + bj * HALF + 16 * n) = (unsigned long long)cvt_pk_bf16(o[0], o[1]) | ((unsigned long long)cvt_pk_bf16(o[2], o[3]) << 32);
                        } } }
        }
    }
};

__device__ __forceinline__ float dpp_shr1(float v) { return __builtin_bit_cast(float, __builtin_amdgcn_update_dpp(0, __builtin_bit_cast(int, v), 0x111, 0xf, 0xf, true)); }
struct EpiConvAct {
    static constexpr bool PERM = true, AFTER_DRAIN = false, ROWPERM = true;
    bf16_t* act; bf16_t* edge; const float* cw; const float* cb;
    __device__ __forceinline__ void operator()(const f32x4 (&acc)[2][2][4][2], const Unit& u, int wr, int wc, int fr, int fq) const {
        const int chl = wc * 32 + 8 * fq, ch0 = u.pn * 128 + chl, ucol = u.pn * 256 + chl;
#pragma unroll
        for (int n = 0; n < 2; ++n) {
            const f32x4 wg0 = *(const f32x4*)(cw + ch0 + 4 * n), wg1 = *(const f32x4*)(cw + 5632 + ch0 + 4 * n), wg2 = *(const f32x4*)(cw + 2 * 5632 + ch0 + 4 * n), bg = *(const f32x4*)(cb + ch0 + 4 * n);
            const f32x4 wv0 = *(const f32x4*)(cw + 2816 + ch0 + 4 * n), wv1 = *(const f32x4*)(cw + 5632 + 2816 + ch0 + 4 * n), wv2 = *(const f32x4*)(cw + 2 * 5632 + 2816 + ch0 + 4 * n), bv = *(const f32x4*)(cb + 2816 + ch0 + 4 * n);
#pragma unroll
            for (int ai = 0; ai < 2; ++ai) {
                const int stripe = u.pm * 4 + ai * 2 + wr;
                f32x4 pg1, pg2, pv1, pv2;
#pragma unroll
                for (int e = 0; e < 4; ++e) { pg1[e] = dpp_shr1(acc[ai][0][3][n][e]); pg2[e] = dpp_shr1(acc[ai][0][2][n][e]); pv1[e] = dpp_shr1(acc[ai][1][3][n][e]); pv2[e] = dpp_shr1(acc[ai][1][2][n][e]); }
                f32x4 yg[4], yv[4];
                yg[0] = bg + wg0 * pg2 + wg1 * pg1 + wg2 * acc[ai][0][0][n];
                yg[1] = bg + wg0 * pg1 + wg1 * acc[ai][0][0][n] + wg2 * acc[ai][0][1][n];
                yg[2] = bg + wg0 * acc[ai][0][0][n] + wg1 * acc[ai][0][1][n] + wg2 * acc[ai][0][2][n];
                yg[3] = bg + wg0 * acc[ai][0][1][n] + wg1 * acc[ai][0][2][n] + wg2 * acc[ai][0][3][n];
                yv[0] = bv + wv0 * pv2 + wv1 * pv1 + wv2 * acc[ai][1][0][n];
                yv[1] = bv + wv0 * pv1 + wv1 * acc[ai][1][0][n] + wv2 * acc[ai][1][1][n];
                yv[2] = bv + wv0 * acc[ai][1][0][n] + wv1 * acc[ai][1][1][n] + wv2 * acc[ai][1][2][n];
                yv[3] = bv + wv0 * acc[ai][1][1][n] + wv1 * acc[ai][1][2][n] + wv2 * acc[ai][1][3][n];
                bf16_t* arow = act + (size_t)(stripe * 64 + 4 * fr) * 2816 + ch0 + 4 * n;
#pragma unroll
                for (int m = 0; m < 4; ++m) { f32x4 o;
#pragma unroll
                    for (int e = 0; e < 4; ++e) o[e] = yg[m][e] * __builtin_amdgcn_rcpf(1.0f + __expf(-yg[m][e])) * yv[m][e];
                    *(unsigned long long*)(arow + (size_t)m * 2816) = (unsigned long long)cvt_pk_bf16(o[0], o[1]) | ((unsigned long long)cvt_pk_bf16(o[2], o[3]) << 32); }
                if (fr == 0 || fr == 15) {
                    const int m0 = (fr == 0) ? 0 : 2;
#pragma unroll
                    for (int mm = 0; mm < 2; ++mm)
#pragma unroll
                        for (int bj = 0; bj < 2; ++bj) { const f32x4 x = (fr == 0) ? acc[ai][bj][mm][n] : acc[ai][bj][2 + mm][n];
                            *(unsigned long long*)(edge + ((size_t)stripe * 4 + m0 + mm) * 5632 + ucol + bj * HALF + 4 * n) = (unsigned long long)cvt_pk_bf16(x[0], x[1]) | ((unsigned long long)cvt_pk_bf16(x[2], x[3]) << 32); }
                }
            }
        }
    }
};

struct EpiRowScale {
    static constexpr bool PERM = true, AFTER_DRAIN = false, ROWPERM = false;
    bf16_t* O; int ldc; const float* rs; float inv_n;
    __device__ __forceinline__ void operator()(const f32x4 (&acc)[2][2][4][2], const Unit& u, int wr, int wc, int fr, int fq) const {
        const int row0 = u.pm * BM + wr * 64 + fr, col0 = u.pn * BM + wc * 32 + 8 * fq;
#pragma unroll
        for (int ai = 0; ai < 2; ++ai)
#pragma unroll
            for (int m = 0; m < 4; ++m) { const int row = row0 + ai * HALF + m * 16; const float sc = rsqrtf(rs[row] * inv_n + 1e-6f); bf16_t* rowp = O + (size_t)row * ldc + col0;
#pragma unroll
                for (int bj = 0; bj < 2; ++bj) { const f32x4 v0 = acc[ai][bj][m][0] * sc, v1 = acc[ai][bj][m][1] * sc;
                    u32x4 w; w.x = cvt_pk_bf16(v0[0], v0[1]); w.y = cvt_pk_bf16(v0[2], v0[3]); w.z = cvt_pk_bf16(v1[0], v1[1]); w.w = cvt_pk_bf16(v1[2], v1[3]);
                    *(u32x4*)(rowp + bj * HALF) = w; } }
    }
};
struct EpiColScale {
    static constexpr bool PERM = true, AFTER_DRAIN = false, ROWPERM = false;
    bf16_t* O; int ldc; const float* cs; float inv_n;
    __device__ __forceinline__ void operator()(const f32x4 (&acc)[2][2][4][2], const Unit& u, int wr, int wc, int fr, int fq) const {
        const int row0 = u.pm * BM + wr * 64 + fr, col0 = u.pn * BM + wc * 32 + 8 * fq;
#pragma unroll
        for (int bj = 0; bj < 2; ++bj) {
            f32x4 s0 = *(const f32x4*)(cs + col0 + bj * HALF), s1 = *(const f32x4*)(cs + col0 + bj * HALF + 4);
#pragma unroll
            for (int e_ = 0; e_ < 4; ++e_) { s0[e_] = rsqrtf(s0[e_] * inv_n + 1e-6f); s1[e_] = rsqrtf(s1[e_] * inv_n + 1e-6f); }
#pragma unroll
            for (int ai = 0; ai < 2; ++ai)
#pragma unroll
                for (int m = 0; m < 4; ++m) { const f32x4 v0 = acc[ai][bj][m][0] * s0, v1 = acc[ai][bj][m][1] * s1;
                    u32x4 w; w.x = cvt_pk_bf16(v0[0], v0[1]); w.y = cvt_pk_bf16(v0[2], v0[3]); w.z = cvt_pk_bf16(v1[0], v1[1]); w.w = cvt_pk_bf16(v1[2], v1[3]);
                    *(u32x4*)(O + (size_t)(row0 + ai * HALF + m * 16) * ldc + col0 + bj * HALF) = w; }
        }
    }
};

struct EpiProj {
    static constexpr bool PERM = true, AFTER_DRAIN = false, ROWPERM = false;
    bf16_t* O; size_t slab_elems; float* ssq_q; float* ssq_kv;
    __device__ __forceinline__ void operator()(const f32x4 (&acc)[2][2][4][2], const Unit& u, int wr, int wc, int fr, int fq) const {
        const int row0 = u.pm * BM + wr * 64 + fr, col0 = (u.pn & 1) * 256 + wc * 32 + 8 * fq;
        bf16_t* base = O + (size_t)(u.pn >> 1) * slab_elems;
#pragma unroll
        for (int ai = 0; ai < 2; ++ai)
#pragma unroll
            for (int m = 0; m < 4; ++m) { bf16_t* rowp = base + (size_t)(row0 + ai * HALF + m * 16) * 512 + col0;
#pragma unroll
                for (int bj = 0; bj < 2; ++bj) { const f32x4 v0 = acc[ai][bj][m][0], v1 = acc[ai][bj][m][1];
                    u32x4 w; w.x = cvt_pk_bf16(v0[0], v0[1]); w.y = cvt_pk_bf16(v0[2], v0[3]); w.z = cvt_pk_bf16(v1[0], v1[1]); w.w = cvt_pk_bf16(v1[2], v1[3]);
                    *(u32x4*)(rowp + bj * HALF) = w; } }
        if (u.pn <= 2) {
            float* dst = (u.pn < 2) ? ssq_q : ssq_kv;
#pragma unroll
            for (int ai = 0; ai < 2; ++ai)
#pragma unroll
                for (int m = 0; m < 4; ++m) { float s = 0.f;
#pragma unroll
                    for (int bj = 0; bj < 2; ++bj)
#pragma unroll
                        for (int n = 0; n < 2; ++n) { const f32x4 x = acc[ai][bj][m][n]; s += (x[0] * x[0] + x[1] * x[1]) + (x[2] * x[2] + x[3] * x[3]); }
                    s += __shfl_xor(s, 16); s += __shfl_xor(s, 32);
                    if (fq == 0) __hip_atomic_fetch_add(dst + row0 + ai * HALF + m * 16, s, __ATOMIC_RELAXED, __HIP_MEMORY_SCOPE_AGENT); }
        }
    }
};
template <class Epi, class Sched, bool ALIGN_EPI = false, bool SP2 = false>
__device__ __forceinline__ void gemm_phase(PG8_LAS unsigned char* lds, const Gemm g, const Sched& S, const Epi& E) {
    const int tid = threadIdx.x, wid = __builtin_amdgcn_readfirstlane(tid >> 6), lane = tid & 63, wr = wid >> 2, wc = wid & 3, fr = lane & 15, fq = lane >> 4;
    const int K = g.K, nt = K / BK, ldk = g.ldk ? g.ldk : g.K;
    unsigned voffA[2], voffB[2];
#pragma unroll
    for (int i = 0; i < 2; ++i) { int R, C; stage_rc(tid * 16 + i * 8192, R, C); const int Rb = Epi::PERM ? ((R & ~31) + perm32(R & 31)) : R;
        const int Ra = Epi::ROWPERM ? ((R & 64) | ((R & 15) << 2) | ((R >> 4) & 3)) : R;
        voffA[i] = (unsigned)(Ra * ldk + C) * 2u; voffB[i] = (unsigned)(Rb * ldk + C) * 2u; }
    const size_t kstep = (size_t)(BK * 2);
    const size_t hstep = (size_t)HALF * ldk * 2;
    const size_t tstep = 2 * hstep;
    const unsigned ldsw = (unsigned)wid * 1024u;
    const int aoff = lds_byte(wr * 64 + fr, fq * 8), boff = lds_byte(wc * 32 + fr, fq * 8);
#define PG8_SA(b, h) (((b) * 2 + (h)) * HTB)
#define PG8_SB(b, h) ((4 + (b) * 2 + (h)) * HTB)
#define PG8_STAGE(bufoff, gbase, voff) do { _Pragma("unroll") for (int _i = 0; _i < 2; ++_i) \
        __builtin_amdgcn_global_load_lds((const unsigned*)((const char*)(gbase) + (voff)[_i]), (PG8_LAS unsigned*)(lds + (bufoff) + ldsw + _i * 8192), 16, 0, 0); } while (0)
#define PG8_LDA(dst, b, h) do { _Pragma("unroll") for (int m = 0; m < 4; ++m) _Pragma("unroll") for (int k = 0; k < 2; ++k) dst[m][k] = *(const PG8_LAS bf16x8*)(lds + PG8_SA(b, h) + aoff + m * 2048 + k * 1024); } while (0)
#define PG8_LDB(dst, b, h) do { _Pragma("unroll") for (int n = 0; n < 2; ++n) _Pragma("unroll") for (int k = 0; k < 2; ++k) dst[n][k] = *(const PG8_LAS bf16x8*)(lds + PG8_SB(b, h) + boff + n * 2048 + k * 1024); } while (0)
#define PG8_MMA(ai, bj, At, Bt) do { __builtin_amdgcn_s_setprio(1); _Pragma("unroll") for (int m = 0; m < 4; ++m) _Pragma("unroll") for (int n = 0; n < 2; ++n) _Pragma("unroll") for (int k = 0; k < 2; ++k) \
        acc[ai][bj][m][n] = __builtin_amdgcn_mfma_f32_16x16x32_bf16(Bt[n][k], At[m][k], acc[ai][bj][m][n], 0, 0, 0); __builtin_amdgcn_s_setprio(0); } while (0)
#define PG8_WAIT_V(n) asm volatile("s_waitcnt vmcnt(" #n ")" ::: "memory")
#define PG8_WAIT_L(n) asm volatile("s_waitcnt lgkmcnt(" #n ")" ::: "memory")
#define PG8_BAR __builtin_amdgcn_s_barrier()
#define PG8_SCHED __builtin_amdgcn_sched_barrier(0)
    Unit cur, nxt; int ui = 0;
    if (!S.next(0, cur)) return;
    f32x4 acc[2][2][4][2];
#pragma unroll
    for (int a = 0; a < 2; ++a)
#pragma unroll
        for (int b = 0; b < 2; ++b)
#pragma unroll
            for (int m = 0; m < 4; ++m)
#pragma unroll
                for (int n = 0; n < 2; ++n) acc[a][b][m][n] = (f32x4){0.f, 0.f, 0.f, 0.f};
    bf16x8 At[4][2], B0[2][2], B1[2][2];
    const size_t khstep = (size_t)K * 2;
    const char* cA = (const char*)g.A + (size_t)cur.pm * tstep + cur.kh * khstep; const char* cB = (const char*)g.Bt + (size_t)cur.pn * tstep + cur.kh * khstep;
    S.a_ready(cur);
    if constexpr (SP2) {
        PG8_STAGE(PG8_SB(0, 0), cB, voffB); PG8_STAGE(PG8_SB(0, 1), cB + hstep, voffB); PG8_STAGE(PG8_SA(0, 0), cA, voffA); PG8_STAGE(PG8_SA(0, 1), cA + hstep, voffA);
        if (wr == 1) PG8_BAR;
        PG8_WAIT_V(2); PG8_BAR;
        PG8_STAGE(PG8_SB(1, 0), cB + kstep, voffB); PG8_STAGE(PG8_SA(1, 0), cA + kstep, voffA); PG8_STAGE(PG8_SB(1, 1), cB + hstep + kstep, voffB);
        PG8_WAIT_V(6); PG8_BAR;
    } else {
        PG8_STAGE(PG8_SB(0, 0), cB, voffB); PG8_STAGE(PG8_SA(0, 0), cA, voffA); PG8_STAGE(PG8_SB(0, 1), cB + hstep, voffB); PG8_STAGE(PG8_SA(0, 1), cA + hstep, voffA);
        if (wr == 1) PG8_BAR;
        PG8_WAIT_V(4); PG8_BAR;
        PG8_STAGE(PG8_SB(1, 0), cB + kstep, voffB); PG8_STAGE(PG8_SA(1, 0), cA + kstep, voffA); PG8_STAGE(PG8_SB(1, 1), cB + hstep + kstep, voffB);
        PG8_WAIT_V(6); PG8_BAR;
    }
    for (;;) {
        const bool has_next = S.next(ui + 1, nxt);
        const char* nA = has_next ? (const char*)g.A + (size_t)nxt.pm * tstep + nxt.kh * khstep : cA; const char* nB = has_next ? (const char*)g.Bt + (size_t)nxt.pn * tstep + nxt.kh * khstep : cB;
        for (int t = 0; t < nt; t += 2) {
            const bool last = (t == nt - 2);
            const char* a1 = cA + (size_t)(t + 1) * kstep;
            const char* a2 = last ? nA : cA + (size_t)(t + 2) * kstep; const char* b2 = last ? nB : cB + (size_t)(t + 2) * kstep;
            const char* a3 = a2 + kstep; const char* b3 = b2 + kstep;
            if (last && has_next) S.a_ready(nxt);
            if constexpr (SP2) {
            PG8_LDB(B0, 0, 0); PG8_LDB(B1, 0, 1); PG8_SCHED; PG8_LDA(At, 0, 0); PG8_STAGE(PG8_SA(1, 1), a1 + hstep, voffA);
            PG8_WAIT_V(8); PG8_WAIT_L(0); PG8_BAR; PG8_MMA(0, 0, At, B0); PG8_MMA(0, 1, At, B1); PG8_BAR; PG8_SCHED;
            PG8_LDA(At, 0, 1); PG8_STAGE(PG8_SB(0, 0), b2, voffB); PG8_STAGE(PG8_SB(0, 1), b2 + hstep, voffB); PG8_STAGE(PG8_SA(0, 0), a2, voffA);
            PG8_WAIT_V(8); PG8_WAIT_L(0); PG8_BAR; PG8_MMA(1, 0, At, B0); PG8_MMA(1, 1, At, B1); PG8_BAR; PG8_SCHED;
            PG8_LDB(B0, 1, 0); PG8_LDB(B1, 1, 1); PG8_SCHED; PG8_LDA(At, 1, 0); PG8_STAGE(PG8_SA(0, 1), a2 + hstep, voffA);
            PG8_WAIT_V(8); PG8_WAIT_L(0); PG8_BAR; PG8_MMA(0, 0, At, B0); PG8_MMA(0, 1, At, B1); PG8_BAR; PG8_SCHED;
            PG8_LDA(At, 1, 1); PG8_STAGE(PG8_SB(1, 0), b3, voffB); PG8_STAGE(PG8_SB(1, 1), b3 + hstep, voffB); PG8_STAGE(PG8_SA(1, 0), a3, voffA);
            PG8_WAIT_V(8); PG8_WAIT_L(0); PG8_BAR; PG8_MMA(1, 0, At, B0); PG8_MMA(1, 1, At, B1); PG8_BAR; PG8_SCHED;
            } else {
            PG8_LDB(B0, 0, 0); PG8_SCHED; PG8_LDA(At, 0, 0); PG8_STAGE(PG8_SA(1, 1), a1 + hstep, voffA);
            PG8_WAIT_L(8); PG8_BAR; PG8_WAIT_L(0); PG8_MMA(0, 0, At, B0); PG8_BAR; PG8_SCHED;
            PG8_LDB(B1, 0, 1); PG8_STAGE(PG8_SB(0, 0), b2, voffB);
            PG8_BAR; PG8_WAIT_L(0); PG8_MMA(0, 1, At, B1); PG8_BAR;
            PG8_LDA(At, 0, 1); PG8_STAGE(PG8_SA(0, 0), a2, voffA);
            PG8_BAR; PG8_WAIT_L(0); PG8_MMA(1, 0, At, B0); PG8_BAR; PG8_SCHED;
            PG8_STAGE(PG8_SB(0, 1), b2 + hstep, voffB);
            PG8_WAIT_V(6); PG8_BAR; PG8_MMA(1, 1, At, B1); PG8_BAR;
            PG8_LDB(B0, 1, 0); PG8_SCHED; PG8_LDA(At, 1, 0); PG8_STAGE(PG8_SA(0, 1), a2 + hstep, voffA);
            PG8_WAIT_L(8); PG8_BAR; PG8_WAIT_L(0); PG8_MMA(0, 0, At, B0); PG8_BAR; PG8_SCHED;
            PG8_LDB(B1, 1, 1); PG8_STAGE(PG8_SB(1, 0), b3, voffB);
            PG8_BAR; PG8_WAIT_L(0); PG8_MMA(0, 1, At, B1); PG8_BAR;
            PG8_LDA(At, 1, 1); PG8_STAGE(PG8_SA(1, 0), a3, voffA);
            PG8_BAR; PG8_WAIT_L(0); PG8_MMA(1, 0, At, B0); PG8_BAR; PG8_SCHED;
            PG8_STAGE(PG8_SB(1, 1), b3 + hstep, voffB);
            PG8_WAIT_V(6); PG8_BAR; PG8_MMA(1, 1, At, B1); PG8_BAR;
            }
        }
        if constexpr (ALIGN_EPI) { if (wr == 0) PG8_BAR; }
        if constexpr (!Epi::AFTER_DRAIN) { E(acc, cur, wr, wc, fr, fq); S.done(cur); }
        if (!has_next) break;
        if (nxt.kh == 0)
#pragma unroll
        for (int a = 0; a < 2; ++a)
#pragma unroll
            for (int b = 0; b < 2; ++b)
#pragma unroll
                for (int m = 0; m < 4; ++m)
#pragma unroll
                    for (int n = 0; n < 2; ++n) acc[a][b][m][n] = (f32x4){0.f, 0.f, 0.f, 0.f};
        cur = nxt; cA = nA; cB = nB; ++ui;
        if constexpr (ALIGN_EPI) { if (wr == 1) PG8_BAR; }
    }
    PG8_WAIT_V(0);
    if constexpr (!ALIGN_EPI) { if (wr == 0) PG8_BAR; }
    PG8_BAR;
    if constexpr (Epi::AFTER_DRAIN) { E.fused(acc, cur, wr, wc, fr, fq, lds, wid, lane); S.done(cur); }
#undef PG8_SA
#undef PG8_SB
#undef PG8_STAGE
#undef PG8_LDA
#undef PG8_LDB
#undef PG8_MMA
#undef PG8_WAIT_V
#undef PG8_WAIT_L
#undef PG8_BAR
#undef PG8_SCHED
}
}

#define LAS __attribute__((address_space(3)))
typedef unsigned short bf16_t;
typedef short bf16x8 __attribute__((ext_vector_type(8)));
typedef float f32x4 __attribute__((ext_vector_type(4)));
typedef float f32x16 __attribute__((ext_vector_type(16)));
typedef unsigned u32x4 __attribute__((ext_vector_type(4)));
typedef unsigned u32x2 __attribute__((ext_vector_type(2)));

constexpr int T = 32768, DM = 1024, SEQ = 4096;
constexpr int NMOD = 6144, NPROJ = 5120, DFF = 2816, NUP = 5632;
constexpr int NTHR = 512;
constexpr size_t MiB = 1u << 20;
constexpr size_t SLAB = 32 * MiB;
constexpr size_t SLAB_EL = (size_t)T * 512;
constexpr size_t WS_BAR = 512 * 1024;
constexpr size_t WS_MOD = 0, WS_LB = 256 * 1024, WS_G = 1 * MiB, WS_RSQ = 2 * MiB, WS_RSKV = 3 * MiB;
constexpr size_t WS_WIN = 4 * MiB, WS_WUQ = 14 * MiB, WS_WUKV = 15 * MiB, WS_WA = 16 * MiB, WS_WB = 17 * MiB, WS_WOUT = 18 * MiB, WS_WUP = 20 * MiB, WS_WDOWN = 31 * MiB;
__host__ __device__ constexpr size_t SL(int i) { return (size_t)i * SLAB; }
constexpr size_t WS_UH = SL(2);
constexpr size_t WS_ACT = SL(2) + 192 * MiB;
constexpr size_t WS_NEED = 512 * MiB;
constexpr int LDS_BYTES = 147456;
constexpr int NPHASE = 17;

__device__ __forceinline__ float bf2f(unsigned short v) { return __uint_as_float((unsigned)v << 16); }
__device__ __forceinline__ float bflo(unsigned w) { return __uint_as_float(w << 16); }
__device__ __forceinline__ float bfhi(unsigned w) { return __uint_as_float(w & 0xffff0000u); }
typedef float f32x2_t __attribute__((ext_vector_type(2))); typedef __bf16 bf16x2_t __attribute__((ext_vector_type(2)));
__device__ __forceinline__ unsigned pk2(float lo, float hi) { f32x2_t v = {lo, hi}; bf16x2_t b = __builtin_convertvector(v, bf16x2_t); return __builtin_bit_cast(unsigned, b); }
__device__ __forceinline__ unsigned short f2bf(float f) { return (unsigned short)(pk2(f, 0.f) & 0xffffu); }
__device__ __forceinline__ float wave_sum(float v) {
#pragma unroll
    for (int o = 1; o < 64; o <<= 1) v += __shfl_xor(v, o);
    return v;
}
__device__ __forceinline__ float sigmoidf_(float x) { return __builtin_amdgcn_rcpf(1.0f + __expf(-x)); }
#define MFMA16(a, b, c) __builtin_amdgcn_mfma_f32_16x16x32_bf16((a), (b), (c), 0, 0, 0)
#define MFMA32(a, b, c) __builtin_amdgcn_mfma_f32_32x32x16_bf16((a), (b), (c), 0, 0, 0)

struct Args { const float* in[23]; float* out; unsigned char* ws; float invf[16]; int ph_lo, ph_hi; };

__device__ __forceinline__ int srccol(int mapid, int nd) {
    if (mapid == 0) return nd;
    if (mapid == 1) { if (nd < 800) return nd; if (nd < 1024) return -1; return nd - 224; }
    if (mapid == 3) return (nd >> 6) * 128 + (nd & 63);
    if (mapid == 4) return (nd >> 6) * 128 + 64 + (nd & 63);
    const int pn = nd >> 8, j = nd & 255; return (j < 128) ? (128 * pn + j) : (DFF + 128 * pn + (j - 128));
}
__device__ __forceinline__ void wt_item(const float* W, int K, int Nsrc, bf16_t* WT, int mapid, int item, int nblk, LAS unsigned short* tile, int ldk = 0, int kofs = 0, const float* kgain = nullptr) {
    if (ldk == 0) ldk = K;
    const int kb = item / nblk, nb = item % nblk, k0 = kb * 64, n0 = nb * 64;
    const int tid = threadIdx.x, n = tid & 63, kq = tid >> 6;
    const int sc = srccol(mapid, n0 + n);
#pragma unroll
    for (int i = 0; i < 8; ++i) { const int k = i * 8 + kq; float v = (sc >= 0) ? W[(size_t)(k0 + k) * Nsrc + sc] : 0.f; if (kgain) v *= kgain[k0 + k]; tile[n * 66 + k] = f2bf(v); }
    __syncthreads();
    { const int nn = tid >> 3, kc = tid & 7; const LAS unsigned* tp = (const LAS unsigned*)(tile + nn * 66 + kc * 8);
      u32x4 w; w[0] = tp[0]; w[1] = tp[1]; w[2] = tp[2]; w[3] = tp[3];
      *(u32x4*)(WT + (size_t)(n0 + nn) * ldk + kofs + k0 + kc * 8) = w; }
    __syncthreads();
}
__device__ __forceinline__ void p0_phase(const Args& a, LAS unsigned char* lds, int bid, int G) {
    unsigned char* ws = a.ws;
    const int tid = threadIdx.x, lane = tid & 63, wid = tid >> 6;
    for (int cgp = bid; cgp < 96; cgp += G) {
        LAS float* red = (LAS float*)lds;
        const float* c = a.in[1]; const float* w = a.in[3]; const int n = cgp * 64 + lane;
        float acc[8];
#pragma unroll
        for (int b = 0; b < 8; ++b) acc[b] = 0.f;
        for (int k = wid * 128; k < wid * 128 + 128; ++k) { const float wv = w[(size_t)k * NMOD + n];
#pragma unroll
            for (int b = 0; b < 8; ++b) acc[b] += c[b * DM + k] * wv; }
#pragma unroll
        for (int b = 0; b < 8; ++b) red[(wid * 8 + b) * 64 + lane] = acc[b];
        __syncthreads();
        { const int b = wid; float s = 0.f;
#pragma unroll
          for (int w8 = 0; w8 < 8; ++w8) s += red[(w8 * 8 + b) * 64 + lane];
          ((float*)(ws + WS_MOD))[b * NMOD + n] = s + a.in[4][n]; }
        __syncthreads();
    }
    for (int i = bid * NTHR + tid; i < T; i += G * NTHR) { ((float*)(ws + WS_RSQ))[i] = 0.f; ((float*)(ws + WS_RSKV))[i] = 0.f; }
    if (bid == (96 % G)) { const float* t = a.in[13]; ((float*)(ws + WS_LB))[tid] = 1.0f / (1.0f + expf(t[tid] - t[512 + tid])); }
    LAS unsigned short* tile = (LAS unsigned short*)lds;
    constexpr int I0 = 16 * 80, I1 = 8 * 12, I2 = 4 * 8, I2b = 4 * 8, I3 = 8 * 16, I4 = 8 * 16, I5 = 16 * 16, I6 = 16 * 88, I7 = 44 * 16;
    constexpr int NIT = I0 + I1 + I2 + I2b + I3 + I4 + I5 + I6 + I7;
    for (int it = bid; it < NIT; it += G) {
        int r = it;
        if (r < I0) { wt_item(a.in[6], 1024, 4896, (bf16_t*)(ws + WS_WIN), 1, r, 80, tile); continue; } r -= I0;
        if (r < I1) { wt_item(a.in[8], 512, 768, (bf16_t*)(ws + WS_WUQ), 0, r, 12, tile, 0, 0, a.in[7]); continue; } r -= I1;
        if (r < I2) { wt_item(a.in[10], 256, 1024, (bf16_t*)(ws + WS_WUKV), 3, r, 8, tile, 512, 0, a.in[9]); continue; } r -= I2;
        if (r < I2b) { wt_item(a.in[10], 256, 1024, (bf16_t*)(ws + WS_WUKV + 512 * 1024), 4, r, 8, tile, 512, 0, a.in[9]); continue; } r -= I2b;
        if (r < I3) { wt_item(a.in[15], 512, 1024, (bf16_t*)(ws + WS_WA), 0, r, 16, tile, 1024, 0); continue; } r -= I3;
        if (r < I4) { wt_item(a.in[16], 512, 1024, (bf16_t*)(ws + WS_WA), 0, r, 16, tile, 1024, 512); continue; } r -= I4;
        if (r < I5) { wt_item(a.in[17], 1024, 1024, (bf16_t*)(ws + WS_WOUT), 0, r, 16, tile); continue; } r -= I5;
        if (r < I6) { wt_item(a.in[19], 1024, NUP, (bf16_t*)(ws + WS_WUP), 2, r, 88, tile); continue; } r -= I6;
        wt_item(a.in[22], DFF, 1024, (bf16_t*)(ws + WS_WDOWN), 0, r, 16, tile);
    }
}

template <bool IN_BF16> __device__ __forceinline__ void adaln_phase(const void* xin_, const float* g, const float* mod, int shift_off, int scale_off, bf16_t* out, int bid, int G) {
    const int lane = threadIdx.x & 63, wid = threadIdx.x >> 6;
    const int gw = bid * 8 + wid, NGW = G * 8;
    for (int m0 = 2 * gw; m0 < T; m0 += 2 * NGW) {
        f32x4 v[2][4]; float s[2] = {0.f, 0.f};
#pragma unroll
        for (int r = 0; r < 2; ++r) {
            if (IN_BF16) { const u32x2* xr = (const u32x2*)((const bf16_t*)xin_ + (size_t)(m0 + r) * DM) + lane;
#pragma unroll
                for (int j = 0; j < 4; ++j) { const u32x2 w = xr[64 * j]; v[r][j] = (f32x4){bflo(w[0]), bfhi(w[0]), bflo(w[1]), bfhi(w[1])}; } }
            else { const f32x4* xr = (const f32x4*)((const float*)xin_ + (size_t)(m0 + r) * DM) + lane;
#pragma unroll
                for (int j = 0; j < 4; ++j) v[r][j] = __builtin_nontemporal_load(&xr[64 * j]); } }
        const float* mb = mod + (m0 >> 12) * NMOD;
        f32x4 ga[4], sh[4];
#pragma unroll
        for (int j = 0; j < 4; ++j) { const int col = 4 * lane + 256 * j; const f32x4 gg = *(const f32x4*)(g + col), sc = *(const f32x4*)(mb + scale_off + col); sh[j] = *(const f32x4*)(mb + shift_off + col);
#pragma unroll
            for (int e = 0; e < 4; ++e) ga[j][e] = gg[e] * (1.0f + sc[e]); }
#pragma unroll
        for (int r = 0; r < 2; ++r)
#pragma unroll
            for (int j = 0; j < 4; ++j) s[r] += (v[r][j][0] * v[r][j][0] + v[r][j][1] * v[r][j][1]) + (v[r][j][2] * v[r][j][2] + v[r][j][3] * v[r][j][3]);
#pragma unroll
        for (int o = 1; o < 64; o <<= 1) { s[0] += __shfl_xor(s[0], o); s[1] += __shfl_xor(s[1], o); }
#pragma unroll
        for (int r = 0; r < 2; ++r) { const float rstd = rsqrtf(s[r] * (1.f / DM) + 1e-6f);
            u32x2* o8 = (u32x2*)(out + (size_t)(m0 + r) * DM) + lane;
#pragma unroll
            for (int j = 0; j < 4; ++j) { f32x4 h;
#pragma unroll
                for (int e = 0; e < 4; ++e) h[e] = v[r][j][e] * rstd * ga[j][e] + sh[j][e];
                u32x2 w; w[0] = pk2(h[0], h[1]); w[1] = pk2(h[2], h[3]); o8[64 * j] = w; } }
    }
}

__device__ __forceinline__ void lora_norm_phase(const Args& a, int bid, int G) {
    unsigned char* ws = a.ws;
    const bf16_t* cq = (const bf16_t*)(ws + SL(4)); const bf16_t* ckv = (const bf16_t*)(ws + SL(5));
    float* rsq = (float*)(ws + WS_RSQ); float* rskv = (float*)(ws + WS_RSKV);
    const int lane = threadIdx.x & 63, wid = threadIdx.x >> 6;
    const int gw = bid * 8 + wid, NGW = G * 8;
#pragma unroll 4
    for (int m = gw; m < T; m += NGW) {
        const u32x4 w = *(const u32x4*)(cq + (size_t)m * 512 + 8 * lane);
        u32x4 w2 = {0u, 0u, 0u, 0u};
        if (lane < 32) w2 = *(const u32x4*)(ckv + (size_t)m * 512 + 8 * lane);
        float s = 0.f, s2 = 0.f;
#pragma unroll
        for (int e = 0; e < 4; ++e) { const float v0 = bflo(w[e]), v1 = bfhi(w[e]), u0 = bflo(w2[e]), u1 = bfhi(w2[e]); s += v0 * v0 + v1 * v1; s2 += u0 * u0 + u1 * u1; }
#pragma unroll
        for (int o = 1; o < 64; o <<= 1) { s += __shfl_xor(s, o); s2 += __shfl_xor(s2, o); }
        if (lane == 0) { rsq[m] = rsqrtf(s * (1.f / 512.f) + 1e-6f); rskv[m] = rsqrtf(s2 * (1.f / 256.f) + 1e-6f); }
    }
}

__device__ __forceinline__ void h1_phase(const bf16_t* hq, const bf16_t* hf, const bf16_t* hi, bf16_t* qe_out, bf16_t* intra_out, const float* lb, bf16_t* Ub, float* G, LAS unsigned char* lds, int bid, int Gn) {
    LAS bf16_t* QA = (LAS bf16_t*)lds;
    LAS bf16_t* KD = QA + 4 * 64 * 136;
    LAS bf16_t* KET = KD + 64 * 136;
    LAS bf16_t* VT = KET + 128 * 72;
    LAS bf16_t* AT = VT + 128 * 72;
    LAS float* TOT = (LAS float*)(AT + 64 * 72);
    LAS bf16_t* ST = QA;
    const int tid = threadIdx.x, lane = tid & 63, wid = __builtin_amdgcn_readfirstlane(tid >> 6);
    const int k = tid & 127, I = __builtin_amdgcn_readfirstlane(tid >> 7);
    u32x4 pf[2][3];
#define H1_LOAD(uu) do { const int b_ = (uu) >> 8, h_ = ((uu) >> 6) & 3, c_ = (uu) & 63; _Pragma("unroll") for (int i = 0; i < 2; ++i) { const int id = tid + NTHR * i, row = id >> 4, cc = id & 15; \
        const size_t go = (size_t)(b_ * SEQ + c_ * 64 + row) * 512 + h_ * 128 + cc * 8; pf[i][0] = *(const u32x4*)(hq + go); pf[i][1] = *(const u32x4*)(hf + go); pf[i][2] = *(const u32x4*)(hi + go); } } while (0)
    if (bid < 2048) H1_LOAD(bid);
    for (int u = bid; u < 2048; u += Gn) {
    const int b = u >> 8, h = (u >> 6) & 3, c = u & 63, t0 = b * SEQ + c * 64, cb = h * 128;
#pragma unroll
    for (int i = 0; i < 2; ++i) { const int id = tid + NTHR * i, row = id >> 4, cc = id & 15;
        *(LAS u32x4*)(ST + row * 128 + cc * 8) = pf[i][0]; *(LAS u32x4*)(ST + 8192 + row * 128 + cc * 8) = pf[i][1]; *(LAS u32x4*)(ST + 16384 + row * 128 + cc * 8) = pf[i][2]; }
    __syncthreads();
    if (u + Gn < 2048) H1_LOAD(u + Gn);
    float q[16], kk[16], pc[16]; unsigned short vv[16];
    const float lbk = lb[cb + k]; float run = 1.0f;
#pragma unroll
    for (int i = 0; i < 16; ++i) {
        const float xq = bf2f(ST[(16 * I + i) * 128 + k]), xf = bf2f(ST[8192 + (16 * I + i) * 128 + k]); vv[i] = ST[16384 + (16 * I + i) * 128 + k];
        const float f = lbk + (1.0f - lbk) * sigmoidf_(xf);
        run *= f; pc[i] = run; kk[i] = 1.0f - f; q[i] = xq * sigmoidf_(xq);
    }
    TOT[I * 128 + k] = run;
    for (int j = tid; j < 64 * 72 / 2; j += NTHR) ((LAS unsigned*)AT)[j] = 0u;
    __syncthreads();
    const float tp0 = TOT[k], tp1 = TOT[128 + k], tp2 = TOT[256 + k], tp3 = TOT[384 + k];
    const float ej2 = (I > 2 ? tp2 : 1.f), ej1 = (I > 1 ? tp1 : 1.f) * ej2, ej0 = (I > 0 ? tp0 : 1.f) * ej1;
    const float suf = (I <= 0 ? tp0 : 1.f) * (I <= 1 ? tp1 : 1.f) * (I <= 2 ? tp2 : 1.f) * tp3;
    unsigned kw[8], vw[8];
#pragma unroll
    for (int i = 0; i < 16; ++i) {
        const int s = 16 * I + i;
        const float rp = __builtin_amdgcn_rcpf(pc[i]), qp = q[i] * pc[i];
        KD[s * 136 + k] = f2bf(kk[i] * rp);
        QA[(0 * 64 + s) * 136 + k] = f2bf(qp * ej0);
        if (I >= 1) QA[(1 * 64 + s) * 136 + k] = f2bf(qp * ej1);
        if (I >= 2) QA[(2 * 64 + s) * 136 + k] = f2bf(qp * ej2);
        if (I >= 3) QA[(3 * 64 + s) * 136 + k] = f2bf(qp);
        const float ke = kk[i] * (suf * rp);
        if (i & 1) { kw[i >> 1] |= (unsigned)f2bf(ke) << 16; vw[i >> 1] |= (unsigned)vv[i] << 16; } else { kw[i >> 1] = f2bf(ke); vw[i >> 1] = vv[i]; }
    }
    { LAS u32x4* kp = (LAS u32x4*)(KET + k * 72 + 16 * I); kp[0] = (u32x4){kw[0], kw[1], kw[2], kw[3]}; kp[1] = (u32x4){kw[4], kw[5], kw[6], kw[7]};
      LAS u32x4* vp = (LAS u32x4*)(VT + k * 72 + 16 * I); vp[0] = (u32x4){vw[0], vw[1], vw[2], vw[3]}; vp[1] = (u32x4){vw[4], vw[5], vw[6], vw[7]}; }
    if (I == 0) G[(size_t)u * 128 + k] = (tp0 * tp1) * (tp2 * tp3);
    __syncthreads();
    const int l15 = lane & 15, l4 = lane >> 4;
#pragma unroll
    for (int i = 0; i < 2; ++i) { const int id = tid + NTHR * i, row = id >> 4, cc = id & 15;
        *(u32x4*)(qe_out + (size_t)(t0 + row) * 512 + cb + cc * 8) = *(const LAS u32x4*)(QA + row * 136 + cc * 8); }
    for (int blk = wid; blk < 10; blk += 8) {
        const int Ip = (blk >= 6) ? 3 : (blk >= 3) ? 2 : (blk >= 1) ? 1 : 0, J = blk - Ip * (Ip + 1) / 2;
        f32x4 acc = {0.f, 0.f, 0.f, 0.f};
#pragma unroll
        for (int ks = 0; ks < 4; ++ks) {
            const bf16x8 x = *(const LAS bf16x8*)(QA + (J * 64 + 16 * Ip + l15) * 136 + 32 * ks + 8 * l4);
            const bf16x8 y = *(const LAS bf16x8*)(KD + (16 * J + l15) * 136 + 32 * ks + 8 * l4);
            acc = MFMA16(x, y, acc);
        }
#pragma unroll
        for (int ii = 0; ii < 4; ++ii) { const int tl = 4 * l4 + ii; const float val = (Ip == J && l15 > tl) ? 0.f : acc[ii]; AT[(16 * Ip + tl) * 72 + 16 * J + l15] = f2bf(val); }
    }
    __syncthreads();
    { const int tb = wid & 3, vb0 = (wid >> 2) * 4;
      const bf16x8 x0 = *(const LAS bf16x8*)(AT + (16 * tb + l15) * 72 + 8 * l4), x1 = *(const LAS bf16x8*)(AT + (16 * tb + l15) * 72 + 32 + 8 * l4);
#pragma unroll
      for (int j = 0; j < 4; ++j) { const int vb = vb0 + j;
          const bf16x8 y0 = *(const LAS bf16x8*)(VT + (16 * vb + l15) * 72 + 8 * l4), y1 = *(const LAS bf16x8*)(VT + (16 * vb + l15) * 72 + 32 + 8 * l4);
          f32x4 acc = {0.f, 0.f, 0.f, 0.f}; acc = MFMA16(y0, x0, acc); acc = MFMA16(y1, x1, acc);
          u32x2 w; w[0] = pk2(acc[0], acc[1]); w[1] = pk2(acc[2], acc[3]);
          *(u32x2*)(intra_out + (size_t)(t0 + 16 * tb + l15) * 512 + cb + 16 * vb + 4 * l4) = w; } }
    { const int kb = wid;
      const bf16x8 x0 = *(const LAS bf16x8*)(KET + (16 * kb + l15) * 72 + 8 * l4), x1 = *(const LAS bf16x8*)(KET + (16 * kb + l15) * 72 + 32 + 8 * l4);
#pragma unroll
      for (int vb = 0; vb < 8; ++vb) {
          const bf16x8 y0 = *(const LAS bf16x8*)(VT + (16 * vb + l15) * 72 + 8 * l4), y1 = *(const LAS bf16x8*)(VT + (16 * vb + l15) * 72 + 32 + 8 * l4);
          f32x4 acc = {0.f, 0.f, 0.f, 0.f}; acc = MFMA16(x0, y0, acc); acc = MFMA16(x1, y1, acc);
          u32x2 w; w[0] = pk2(acc[0], acc[1]); w[1] = pk2(acc[2], acc[3]);
          *(u32x2*)(Ub + (size_t)u * 16384 + (16 * vb + l15) * 128 + 16 * kb + 4 * l4) = w; } }
    __syncthreads();
    }
#undef H1_LOAD
}

__device__ __forceinline__ void h2_phase(bf16_t* Ub, const float* __restrict__ G, int bid, int Gn) {
    const int gt = bid * NTHR + threadIdx.x, NT_ = Gn * NTHR;
    for (int e4 = gt; e4 < 131072; e4 += NT_) {
        const int bh = e4 >> 12, e = (e4 & 4095) * 4, k = e & 127;
        bf16_t* p = Ub + (size_t)bh * 64 * 16384 + e; const float* gp = G + (size_t)bh * 64 * 128 + k;
        float s0 = 0.f, s1 = 0.f, s2 = 0.f, s3 = 0.f;
#pragma unroll 1
        for (int c0 = 0; c0 < 64; c0 += 16) {
            u32x2 uv[16]; f32x4 g[16];
#pragma unroll
            for (int j = 0; j < 16; ++j) { uv[j] = *(const u32x2*)(p + (size_t)(c0 + j) * 16384); g[j] = *(const f32x4*)(gp + (c0 + j) * 128); }
#pragma unroll
            for (int j = 0; j < 16; ++j) {
                u32x2 w; w[0] = pk2(s0, s1); w[1] = pk2(s2, s3); *(u32x2*)(p + (size_t)(c0 + j) * 16384) = w;
                s0 = g[j][0] * s0 + bflo(uv[j][0]); s1 = g[j][1] * s1 + bfhi(uv[j][0]); s2 = g[j][2] * s2 + bflo(uv[j][1]); s3 = g[j][3] * s3 + bfhi(uv[j][1]);
            }
        }
    }
}

__device__ __forceinline__ void h3_unit(int j, const bf16_t* qe, const bf16_t* intra, const bf16_t* Ub, const bf16_t* hg, const float* gn, bf16_t* out) {
    const int tid = threadIdx.x, lane = tid & 63, wid = __builtin_amdgcn_readfirstlane(tid >> 6), l15 = lane & 15, l4 = lane >> 4;
    const int b = j >> 6, c = j & 63, t0 = b * SEQ + c * 64;
#pragma unroll 1
    for (int cc = 0; cc < 2; ++cc) {
        const int combo = 2 * wid + cc, head = combo >> 2, tb = combo & 3, u = (b * 4 + head) * 64 + c;
        const size_t rbase = (size_t)(t0 + 16 * tb + l15) * 512 + head * 128;
        bf16x8 x[4];
#pragma unroll
        for (int ks = 0; ks < 4; ++ks) x[ks] = *(const bf16x8*)(qe + rbase + 8 * l4 + 32 * ks);
        u32x2 iv[8], gv[8];
#pragma unroll
        for (int vb = 0; vb < 8; ++vb) { iv[vb] = *(const u32x2*)(intra + rbase + 16 * vb + 4 * l4); gv[vb] = *(const u32x2*)(hg + rbase + 16 * vb + 4 * l4); }
        const bf16_t* ub = Ub + (size_t)u * 16384 + l15 * 128 + 8 * l4;
        f32x4 acc[8];
#pragma unroll
        for (int vb = 0; vb < 8; ++vb) { acc[vb] = (f32x4){0.f, 0.f, 0.f, 0.f};
#pragma unroll
            for (int ks = 0; ks < 4; ++ks) { const bf16x8 y = *(const bf16x8*)(ub + vb * 2048 + 32 * ks); acc[vb] = MFMA16(y, x[ks], acc[vb]); } }
        float ss = 0.f;
#pragma unroll
        for (int vb = 0; vb < 8; ++vb) { acc[vb][0] += bflo(iv[vb][0]); acc[vb][1] += bfhi(iv[vb][0]); acc[vb][2] += bflo(iv[vb][1]); acc[vb][3] += bfhi(iv[vb][1]);
            ss += (acc[vb][0] * acc[vb][0] + acc[vb][1] * acc[vb][1]) + (acc[vb][2] * acc[vb][2] + acc[vb][3] * acc[vb][3]); }
        ss += __shfl_xor(ss, 16); ss += __shfl_xor(ss, 32);
        const float rstd = rsqrtf(ss * (1.f / 128.f) + 1e-6f);
#pragma unroll
        for (int vb = 0; vb < 8; ++vb) { const f32x4 gnv = *(const f32x4*)(gn + 16 * vb + 4 * l4);
            const float g0 = bflo(gv[vb][0]), g1 = bfhi(gv[vb][0]), g2 = bflo(gv[vb][1]), g3 = bfhi(gv[vb][1]);
            u32x2 w; w[0] = pk2(acc[vb][0] * rstd * gnv[0] * (g0 * sigmoidf_(g0)), acc[vb][1] * rstd * gnv[1] * (g1 * sigmoidf_(g1)));
            w[1] = pk2(acc[vb][2] * rstd * gnv[2] * (g2 * sigmoidf_(g2)), acc[vb][3] * rstd * gnv[3] * (g3 * sigmoidf_(g3)));
            *(u32x2*)(out + (size_t)(t0 + 16 * tb + l15) * 1024 + 512 + head * 128 + 16 * vb + 4 * l4) = w; }
    }
}

__device__ __forceinline__ void qk_prep_phase(const Args& a, int bid, int G) {
    unsigned char* ws = a.ws;
    const bf16_t* qraw = (const bf16_t*)a.out; const bf16_t* knope = (const bf16_t*)(ws + SL(2)); const bf16_t* krope = (const bf16_t*)(ws + SL(5)) + 256;
    bf16_t* Q = (bf16_t*)(ws + SL(3)); bf16_t* K = (bf16_t*)((unsigned char*)a.out + 64 * MiB);
    const int* positions = (const int*)a.in[2]; const float* gq = a.in[11]; const float* gk = a.in[12];
    const int lane = threadIdx.x & 63, wid = threadIdx.x >> 6, h = lane >> 3, c = lane & 7, c3 = c & 3;
    const float QS = 0.10206207261596577f * 1.4426950408889634f;
    float gqn[8], gkn[8], gqr[4], gkr[4], invf[4];
#pragma unroll
    for (int j = 0; j < 8; ++j) { gqn[j] = gq[8 * c + j] * QS; gkn[j] = gk[8 * c + j]; }
#pragma unroll
    for (int j = 0; j < 4; ++j) { gqr[j] = gq[64 + 4 * c + j] * QS; gkr[j] = gk[64 + 4 * c + j];
        invf[j] = (c3 == 0) ? a.invf[j] : (c3 == 1) ? a.invf[4 + j] : (c3 == 2) ? a.invf[8 + j] : a.invf[12 + j]; }
    const int gw = bid * 8 + wid, NGW = G * 8;
#pragma unroll 2
    for (int m = gw; m < T; m += NGW) {
        const int b = m >> 12, s = m & 4095;
        const u32x4 qn = *(const u32x4*)(qraw + (size_t)m * 768 + h * 96 + 8 * c); const u32x2 qr = *(const u32x2*)(qraw + (size_t)m * 768 + h * 96 + 64 + 4 * c);
        const u32x4 kn = *(const u32x4*)(knope + (size_t)m * 512 + h * 64 + 8 * c); const u32x2 kr = *(const u32x2*)(krope + (size_t)m * 512 + 4 * c);
        const float posf = (float)positions[m];
        float cs[4], sn[4];
#pragma unroll
        for (int j = 0; j < 4; ++j) { const float ang = posf * invf[j]; double rv = (double)ang * 0.15915494309189535; rv -= __builtin_rint(rv);
            const float fr = (float)rv; sn[j] = __builtin_amdgcn_sinf(fr); cs[j] = __builtin_amdgcn_cosf(fr); }
        size_t ob = ((size_t)(b * 8 + h) * SEQ + s) * 96;
        { float v[8], w[4]; float ss = 0.f;
#pragma unroll
          for (int e = 0; e < 4; ++e) { v[2 * e] = bflo(qn[e]); v[2 * e + 1] = bfhi(qn[e]); ss += v[2 * e] * v[2 * e] + v[2 * e + 1] * v[2 * e + 1]; }
          w[0] = bflo(qr[0]); w[1] = bfhi(qr[0]); w[2] = bflo(qr[1]); w[3] = bfhi(qr[1]); ss += (w[0] * w[0] + w[1] * w[1]) + (w[2] * w[2] + w[3] * w[3]);
          ss += __shfl_xor(ss, 1); ss += __shfl_xor(ss, 2); ss += __shfl_xor(ss, 4);
          const float rstd = rsqrtf(ss * (1.f / 96.f) + 1e-6f);
          u32x4 o; o[0] = pk2(v[0] * rstd * gqn[0], v[1] * rstd * gqn[1]); o[1] = pk2(v[2] * rstd * gqn[2], v[3] * rstd * gqn[3]);
          o[2] = pk2(v[4] * rstd * gqn[4], v[5] * rstd * gqn[5]); o[3] = pk2(v[6] * rstd * gqn[6], v[7] * rstd * gqn[7]);
          float rot[4];
#pragma unroll
          for (int j = 0; j < 4; ++j) { const float n1 = w[j] * rstd * gqr[j], pr = __shfl_xor(n1, 4); rot[j] = (c & 4) ? (n1 * cs[j] + pr * sn[j]) : (n1 * cs[j] - pr * sn[j]); }
          u32x2 o2; o2[0] = pk2(rot[0], rot[1]); o2[1] = pk2(rot[2], rot[3]);
          *(u32x4*)(Q + ob + 8 * c) = o; *(u32x2*)(Q + ob + 64 + 4 * c) = o2; }
        { float v[8], w[4]; float ss = 0.f;
#pragma unroll
          for (int e = 0; e < 4; ++e) { v[2 * e] = bflo(kn[e]); v[2 * e + 1] = bfhi(kn[e]); ss += v[2 * e] * v[2 * e] + v[2 * e + 1] * v[2 * e + 1]; }
          w[0] = bflo(kr[0]); w[1] = bfhi(kr[0]); w[2] = bflo(kr[1]); w[3] = bfhi(kr[1]); ss += (w[0] * w[0] + w[1] * w[1]) + (w[2] * w[2] + w[3] * w[3]);
          ss += __shfl_xor(ss, 1); ss += __shfl_xor(ss, 2); ss += __shfl_xor(ss, 4);
          const float rstd = rsqrtf(ss * (1.f / 96.f) + 1e-6f);
          u32x4 o; o[0] = pk2(v[0] * rstd * gkn[0], v[1] * rstd * gkn[1]); o[1] = pk2(v[2] * rstd * gkn[2], v[3] * rstd * gkn[3]);
          o[2] = pk2(v[4] * rstd * gkn[4], v[5] * rstd * gkn[5]); o[3] = pk2(v[6] * rstd * gkn[6], v[7] * rstd * gkn[7]);
          float rot[4];
#pragma unroll
          for (int j = 0; j < 4; ++j) { const float n1 = w[j] * rstd * gkr[j], pr = __shfl_xor(n1, 4); rot[j] = (c & 4) ? (n1 * cs[j] + pr * sn[j]) : (n1 * cs[j] - pr * sn[j]); }
          u32x2 o2; o2[0] = pk2(rot[0], rot[1]); o2[1] = pk2(rot[2], rot[3]);
          *(u32x4*)(K + ob + 8 * c) = o; *(u32x2*)(K + ob + 64 + 4 * c) = o2; }
    }
}

__device__ __forceinline__ int crow(int r, int hi) { return (r & 3) + 8 * (r >> 2) + 4 * hi; }
template <bool FIX> __device__ __forceinline__ void attn_unit(const bf16_t* Q, const bf16_t* K, const bf16_t* Vt, bf16_t* O, int bh, int qb, float mfix, LAS unsigned char* lds) {
    const int tid = threadIdx.x, lane = tid & 63, wid = __builtin_amdgcn_readfirstlane(tid >> 6), r = lane & 31, hh = lane >> 5;
    LAS bf16_t* Kb = (LAS bf16_t*)lds;
    LAS bf16_t* Vb = (LAS bf16_t*)(lds + 2 * 64 * 104 * 2);
    const bf16_t* Qh = Q + (size_t)bh * SEQ * 96; const bf16_t* Kh = K + (size_t)bh * SEQ * 96; const bf16_t* Vh = Vt + (size_t)(bh & 7) * 64 * T + (size_t)(bh >> 3) * SEQ;
    const int q0 = qb * 256, qw = q0 + wid * 32, NTL = 4 * (qb + 1);
    bf16x8 qf[6];
#pragma unroll
    for (int d0 = 0; d0 < 6; ++d0) qf[d0] = *(const bf16x8*)(Qh + (size_t)(qw + r) * 96 + 16 * d0 + 8 * hh);
    f32x16 o0, o1;
#pragma unroll
    for (int i = 0; i < 16; ++i) { o0[i] = 0.f; o1[i] = 0.f; }
    float mrun = -1e30f, lrun = 0.f;
    f32x16 cinit;
#pragma unroll
    for (int i = 0; i < 16; ++i) cinit[i] = FIX ? -mfix : 0.f;
    asm volatile("" : "+v"(cinit));
    const int c2 = 512 + tid, kr1 = tid / 12, kc1 = tid % 12, kr2 = c2 / 12, kc2 = c2 % 12, vr = tid >> 3, vc = tid & 7;
    u32x4 kA, kB = {0u, 0u, 0u, 0u}, vA;
#define ATT_LOADG(t) do { kA = *(const u32x4*)(Kh + (size_t)(t) * 6144 + tid * 8); if (tid < 256) kB = *(const u32x4*)(Kh + (size_t)(t) * 6144 + c2 * 8); \
        vA = *(const u32x4*)(Vh + (size_t)vr * T + 64 * (t) + vc * 8); } while (0)
#define ATT_STORE(buf) do { *(LAS u32x4*)(Kb + (buf) * 6656 + kr1 * 104 + kc1 * 8) = kA; if (tid < 256) *(LAS u32x4*)(Kb + (buf) * 6656 + kr2 * 104 + kc2 * 8) = kB; \
        *(LAS u32x2*)(Vb + (buf) * 4352 + vr * 68 + vc * 8) = (u32x2){vA[0], vA[1]}; *(LAS u32x2*)(Vb + (buf) * 4352 + vr * 68 + vc * 8 + 4) = (u32x2){vA[2], vA[3]}; } while (0)
    ATT_LOADG(0); ATT_STORE(0); __syncthreads();
    for (int t = 0; t < NTL; ++t) {
        const int buf = t & 1;
        if (t + 1 < NTL) ATT_LOADG(t + 1);
        if (64 * t <= qw + 31) {
            f32x16 s0, s1;
            const LAS bf16_t* kp = Kb + buf * 6656 + r * 104 + 8 * hh;
#pragma unroll
            for (int d0 = 0; d0 < 6; ++d0) {
                const bf16x8 a0 = *(const LAS bf16x8*)(kp + 16 * d0), a1 = *(const LAS bf16x8*)(kp + 32 * 104 + 16 * d0);
                if (d0 == 0) { s0 = MFMA32(a0, qf[0], cinit); s1 = MFMA32(a1, qf[0], cinit); }
                else { s0 = MFMA32(a0, qf[d0], s0); s1 = MFMA32(a1, qf[d0], s1); }
            }
            if (64 * t + 63 > qw) {
                const int qrow = qw + r;
#pragma unroll
                for (int i = 0; i < 16; ++i) { const int kv = 64 * t + crow(i, hh); if (kv > qrow) s0[i] = -1e30f; if (kv + 32 > qrow) s1[i] = -1e30f; }
            }
            if constexpr (FIX) {
                f32x2_t l2 = {0.f, 0.f};
#pragma unroll
                for (int i = 0; i < 16; i += 2) { s0[i] = __builtin_amdgcn_exp2f(s0[i]); s0[i + 1] = __builtin_amdgcn_exp2f(s0[i + 1]); s1[i] = __builtin_amdgcn_exp2f(s1[i]); s1[i + 1] = __builtin_amdgcn_exp2f(s1[i + 1]);
                    l2 += (f32x2_t){s0[i], s0[i + 1]}; l2 += (f32x2_t){s1[i], s1[i + 1]}; }
                lrun += l2[0] + l2[1];
            } else {
            float mx = s0[0];
#pragma unroll
            for (int i = 1; i < 16; ++i) mx = fmaxf(mx, s0[i]);
#pragma unroll
            for (int i = 0; i < 16; ++i) mx = fmaxf(mx, s1[i]);
            mx = fmaxf(mx, __shfl_xor(mx, 32));
            const float mnew = fmaxf(mrun, mx), alpha = __builtin_amdgcn_exp2f(mrun - mnew);
            mrun = mnew;
            float ls = 0.f;
#pragma unroll
            for (int i = 0; i < 16; ++i) { s0[i] = __builtin_amdgcn_exp2f(s0[i] - mnew); s1[i] = __builtin_amdgcn_exp2f(s1[i] - mnew); ls += s0[i] + s1[i]; }
            lrun = lrun * alpha + ls;
            if (__any(alpha != 1.0f)) {
#pragma unroll
                for (int i = 0; i < 16; ++i) { const float ai = __shfl(alpha, crow(i, hh)); o0[i] *= ai; o1[i] *= ai; } }
            }
            u32x4 pw[4];
#pragma unroll
            for (int e = 0; e < 4; ++e) { pw[0][e] = pk2(s0[2 * e], s0[2 * e + 1]); pw[1][e] = pk2(s0[8 + 2 * e], s0[8 + 2 * e + 1]); pw[2][e] = pk2(s1[2 * e], s1[2 * e + 1]); pw[3][e] = pk2(s1[8 + 2 * e], s1[8 + 2 * e + 1]); }
            const LAS bf16_t* vp = Vb + buf * 4352 + r * 68 + 4 * hh;
#pragma unroll
            for (int ks = 0; ks < 4; ++ks) {
                const u32x2 va0 = *(const LAS u32x2*)(vp + 16 * ks), va1 = *(const LAS u32x2*)(vp + 16 * ks + 8), vb0 = *(const LAS u32x2*)(vp + 32 * 68 + 16 * ks), vb1 = *(const LAS u32x2*)(vp + 32 * 68 + 16 * ks + 8);
                const bf16x8 v0 = __builtin_bit_cast(bf16x8, (u32x4){va0[0], va0[1], va1[0], va1[1]}), v1 = __builtin_bit_cast(bf16x8, (u32x4){vb0[0], vb0[1], vb1[0], vb1[1]});
                const bf16x8 pf = __builtin_bit_cast(bf16x8, pw[ks]);
                o0 = MFMA32(pf, v0, o0); o1 = MFMA32(pf, v1, o1);
            }
        }
        if (t + 1 < NTL) ATT_STORE(buf ^ 1);
        __syncthreads();
    }
#undef ATT_LOADG
#undef ATT_STORE
    const float ltot = lrun + __shfl_xor(lrun, 32), inv = 1.0f / ltot;
    const int b = bh >> 3, head = bh & 7;
#pragma unroll
    for (int i = 0; i < 16; ++i) { const int qr = crow(i, hh); const float f = __shfl(inv, qr);
        bf16_t* op = O + (size_t)(b * SEQ + qw + qr) * 1024 + head * 64 + r;
        op[0] = f2bf(o0[i] * f); op[32] = f2bf(o1[i] * f); }
}

__device__ __forceinline__ void attn_unit64(const bf16_t* Q, const bf16_t* K, const bf16_t* Vt, bf16_t* O, int bh, int qb8, float mfix, LAS unsigned char* lds) {
    const int tid = threadIdx.x, lane = tid & 63, wid = __builtin_amdgcn_readfirstlane(tid >> 6), r = lane & 31, hh = lane >> 5;
    LAS bf16_t* Kb = (LAS bf16_t*)lds;
    LAS bf16_t* Vb = (LAS bf16_t*)(lds + 2 * 64 * 104 * 2);
    const bf16_t* Qh = Q + (size_t)bh * SEQ * 96; const bf16_t* Kh = K + (size_t)bh * SEQ * 96; const bf16_t* Vh = Vt + (size_t)(bh & 7) * 64 * T + (size_t)(bh >> 3) * SEQ;
    const int q0 = qb8 * 512, qw = q0 + wid * 64, NTL = 8 * (qb8 + 1), tmaxw = 8 * qb8 + wid;
    LAS bf16x8* Qs = (LAS bf16x8*)(lds + 2 * 64 * 104 * 2 + 2 * 64 * 68 * 2) + tid;
#pragma unroll
    for (int d0 = 0; d0 < 6; ++d0) { Qs[512 * d0] = *(const bf16x8*)(Qh + (size_t)(qw + r) * 96 + 16 * d0 + 8 * hh); Qs[512 * (6 + d0)] = *(const bf16x8*)(Qh + (size_t)(qw + 32 + r) * 96 + 16 * d0 + 8 * hh); }
    f32x16 oA0, oA1, oB0, oB1;
#pragma unroll
    for (int i = 0; i < 16; ++i) { oA0[i] = 0.f; oA1[i] = 0.f; oB0[i] = 0.f; oB1[i] = 0.f; }
    float lA = 0.f, lB = 0.f;
    const int c2 = 512 + tid, kr1 = tid / 12, kc1 = tid % 12, kr2 = c2 / 12, kc2 = c2 % 12, vr = tid >> 3, vc = tid & 7;
    u32x4 kA, kB = {0u, 0u, 0u, 0u}, vA;
#define ATT_LOADG(t) do { kA = *(const u32x4*)(Kh + (size_t)(t) * 6144 + tid * 8); if (tid < 256) kB = *(const u32x4*)(Kh + (size_t)(t) * 6144 + c2 * 8); \
        vA = *(const u32x4*)(Vh + (size_t)vr * T + 64 * (t) + vc * 8); } while (0)
#define ATT_STORE(buf) do { *(LAS u32x4*)(Kb + (buf) * 6656 + kr1 * 104 + kc1 * 8) = kA; if (tid < 256) *(LAS u32x4*)(Kb + (buf) * 6656 + kr2 * 104 + kc2 * 8) = kB; \
        *(LAS u32x2*)(Vb + (buf) * 4352 + vr * 68 + vc * 8) = (u32x2){vA[0], vA[1]}; *(LAS u32x2*)(Vb + (buf) * 4352 + vr * 68 + vc * 8 + 4) = (u32x2){vA[2], vA[3]}; } while (0)
    ATT_LOADG(0); ATT_STORE(0); __syncthreads();
    for (int t = 0; t < NTL; ++t) {
        const int buf = t & 1;
        if (t + 1 < NTL) ATT_LOADG(t + 1);
        if (t <= tmaxw) {
            const LAS bf16_t* kp = Kb + buf * 6656 + r * 104 + 8 * hh;
            const LAS bf16_t* vp = Vb + buf * 4352 + r * 68 + 4 * hh;
#pragma unroll
            for (int half = 0; half < 2; ++half) {
                f32x16 sA, sB;
#pragma unroll
                for (int i = 0; i < 16; ++i) { sA[i] = -mfix; sB[i] = -mfix; }
#pragma unroll
                for (int d0 = 0; d0 < 6; ++d0) { const bf16x8 a = *(const LAS bf16x8*)(kp + half * 32 * 104 + 16 * d0); const bf16x8 qa_ = Qs[512 * d0], qb_ = Qs[512 * (6 + d0)]; sA = MFMA32(a, qa_, sA); sB = MFMA32(a, qb_, sB); }
                if (t == tmaxw) {
                    const int rowA = qw + r, rowB = qw + 32 + r;
#pragma unroll
                    for (int i = 0; i < 16; ++i) { const int kv = 64 * t + 32 * half + crow(i, hh); if (kv > rowA) sA[i] = -1e30f; if (kv > rowB) sB[i] = -1e30f; }
                }
                float la = 0.f, lb_ = 0.f;
#pragma unroll
                for (int i = 0; i < 16; ++i) { sA[i] = __builtin_amdgcn_exp2f(sA[i]); sB[i] = __builtin_amdgcn_exp2f(sB[i]); la += sA[i]; lb_ += sB[i]; }
                lA += la; lB += lb_;
                u32x4 pwA[2], pwB[2];
#pragma unroll
                for (int e = 0; e < 4; ++e) { pwA[0][e] = pk2(sA[2 * e], sA[2 * e + 1]); pwA[1][e] = pk2(sA[8 + 2 * e], sA[8 + 2 * e + 1]); pwB[0][e] = pk2(sB[2 * e], sB[2 * e + 1]); pwB[1][e] = pk2(sB[8 + 2 * e], sB[8 + 2 * e + 1]); }
#pragma unroll
                for (int k2 = 0; k2 < 2; ++k2) { const int ks = 2 * half + k2;
                    const u32x2 va0 = *(const LAS u32x2*)(vp + 16 * ks), va1 = *(const LAS u32x2*)(vp + 16 * ks + 8), vb0 = *(const LAS u32x2*)(vp + 32 * 68 + 16 * ks), vb1 = *(const LAS u32x2*)(vp + 32 * 68 + 16 * ks + 8);
                    const bf16x8 v0 = __builtin_bit_cast(bf16x8, (u32x4){va0[0], va0[1], va1[0], va1[1]}), v1 = __builtin_bit_cast(bf16x8, (u32x4){vb0[0], vb0[1], vb1[0], vb1[1]});
                    const bf16x8 pfA = __builtin_bit_cast(bf16x8, pwA[k2]), pfB = __builtin_bit_cast(bf16x8, pwB[k2]);
                    oA0 = MFMA32(v0, pfA, oA0); oA1 = MFMA32(v1, pfA, oA1); oB0 = MFMA32(v0, pfB, oB0); oB1 = MFMA32(v1, pfB, oB1); }
                __builtin_amdgcn_sched_barrier(0);
            }
        }
        if (t + 1 < NTL) ATT_STORE(buf ^ 1);
        __syncthreads();
    }
#undef ATT_LOADG
#undef ATT_STORE
    const float ltA = lA + __shfl_xor(lA, 32), ltB = lB + __shfl_xor(lB, 32), invA = 1.0f / ltA, invB = 1.0f / ltB;
    const int b = bh >> 3, head = bh & 7;
#define ATT_OSTORE(o0_, o1_, inv_, rowp_) do { \
        _Pragma("unroll") for (int blk_ = 0; blk_ < 2; ++blk_) { \
            _Pragma("unroll") for (int p_ = 0; p_ < 2; ++p_) { const int g_ = 2 * p_; \
                unsigned ax, ay, bx, by; \
                if (blk_ == 0) { ax = pk2(o0_[4 * g_] * inv_, o0_[4 * g_ + 1] * inv_); ay = pk2(o0_[4 * g_ + 2] * inv_, o0_[4 * g_ + 3] * inv_); bx = pk2(o0_[4 * g_ + 4] * inv_, o0_[4 * g_ + 5] * inv_); by = pk2(o0_[4 * g_ + 6] * inv_, o0_[4 * g_ + 7] * inv_); } \
                else { ax = pk2(o1_[4 * g_] * inv_, o1_[4 * g_ + 1] * inv_); ay = pk2(o1_[4 * g_ + 2] * inv_, o1_[4 * g_ + 3] * inv_); bx = pk2(o1_[4 * g_ + 4] * inv_, o1_[4 * g_ + 5] * inv_); by = pk2(o1_[4 * g_ + 6] * inv_, o1_[4 * g_ + 7] * inv_); } \
                { auto r_ = __builtin_amdgcn_permlane32_swap(ax, bx, false, false); ax = r_[0]; bx = r_[1]; } \
                { auto r_ = __builtin_amdgcn_permlane32_swap(ay, by, false, false); ay = r_[0]; by = r_[1]; } \
                *(u32x4*)((rowp_) + 32 * blk_ + 16 * p_ + 8 * hh) = (u32x4){ax, ay, bx, by}; } } } while (0)
    { bf16_t* rowA = O + (size_t)(b * SEQ + qw + r) * 1024 + head * 64; ATT_OSTORE(oA0, oA1, invA, rowA); ATT_OSTORE(oB0, oB1, invB, rowA + (size_t)32 * 1024); }
#undef ATT_OSTORE
}

__device__ __forceinline__ void conv_phase(const Args& a, int tile0, int ntile, int bid, int G) {
    const bf16_t* UH = (const bf16_t*)(a.ws + WS_UH); bf16_t* act = (bf16_t*)(a.ws + WS_ACT);
    const float* cw = a.in[20]; const float* cbias = a.in[21];
    const int gt = bid * NTHR + threadIdx.x, NT_ = G * NTHR;
    const int nit = ntile * 4096 * 16;
    for (int it = gt; it < nit; it += NT_) {
        const int jj = it & 15, tblk = (it >> 4) & 4095, pn = it >> 16;
        const int ch0 = 128 * (tile0 + pn) + 8 * jj, t0 = tblk * 8;
        const bf16_t* up = UH + (size_t)pn * T * 256 + 8 * jj;
        u32x4 gr[10], vr[10];
        const bool first = (t0 & 4095) == 0;
#pragma unroll
        for (int i = 0; i < 10; ++i) { const int t = t0 - 2 + i;
            if (i >= 2 || !first) { gr[i] = *(const u32x4*)(up + (size_t)t * 256); vr[i] = *(const u32x4*)(up + (size_t)t * 256 + 128); }
            else { gr[i] = (u32x4){0u, 0u, 0u, 0u}; vr[i] = (u32x4){0u, 0u, 0u, 0u}; } }
        f32x4 wg[3][2], wv[3][2], bg[2], bv[2];
#pragma unroll
        for (int j = 0; j < 3; ++j)
#pragma unroll
            for (int e = 0; e < 2; ++e) { wg[j][e] = *(const f32x4*)(cw + j * NUP + ch0 + 4 * e); wv[j][e] = *(const f32x4*)(cw + j * NUP + DFF + ch0 + 4 * e); }
#pragma unroll
        for (int e = 0; e < 2; ++e) { bg[e] = *(const f32x4*)(cbias + ch0 + 4 * e); bv[e] = *(const f32x4*)(cbias + DFF + ch0 + 4 * e); }
#pragma unroll
        for (int i = 0; i < 8; ++i) {
            u32x4 w;
#pragma unroll
            for (int e = 0; e < 4; ++e) {
                const int q4 = e >> 1, c0 = 2 * (e & 1);
                const float yg0 = bg[q4][c0] + wg[0][q4][c0] * bflo(gr[i][e]) + wg[1][q4][c0] * bflo(gr[i + 1][e]) + wg[2][q4][c0] * bflo(gr[i + 2][e]);
                const float yg1 = bg[q4][c0 + 1] + wg[0][q4][c0 + 1] * bfhi(gr[i][e]) + wg[1][q4][c0 + 1] * bfhi(gr[i + 1][e]) + wg[2][q4][c0 + 1] * bfhi(gr[i + 2][e]);
                const float yv0 = bv[q4][c0] + wv[0][q4][c0] * bflo(vr[i][e]) + wv[1][q4][c0] * bflo(vr[i + 1][e]) + wv[2][q4][c0] * bflo(vr[i + 2][e]);
                const float yv1 = bv[q4][c0 + 1] + wv[0][q4][c0 + 1] * bfhi(vr[i][e]) + wv[1][q4][c0 + 1] * bfhi(vr[i + 1][e]) + wv[2][q4][c0 + 1] * bfhi(vr[i + 2][e]);
                w[e] = pk2(yg0 * sigmoidf_(yg0) * yv0, yg1 * sigmoidf_(yg1) * yv1);
            }
            *(u32x4*)(act + (size_t)(t0 + i) * DFF + ch0) = w;
        }
    }
}

__device__ __forceinline__ void conv_fix_phase(const Args& a, int bid, int G) {
    const bf16_t* edge = (const bf16_t*)(a.ws + WS_UH); bf16_t* act = (bf16_t*)(a.ws + WS_ACT);
    const float* cw = a.in[20]; const float* cbias = a.in[21];
    const int gt = bid * NTHR + threadIdx.x, NT_ = G * NTHR;
    for (int it = gt; it < 512 * 352; it += NT_) {
        const int cg8 = it % 352, st = it / 352, ch0 = cg8 * 8, pn = ch0 >> 7, j = ch0 & 127, gcol = 256 * pn + j;
        u32x4 gr[4], vr[4];
        const bool first = (st & 63) == 0;
#pragma unroll
        for (int i = 0; i < 4; ++i) {
            if (i >= 2) { const bf16_t* p = edge + ((size_t)st * 4 + (i - 2)) * 5632 + gcol; gr[i] = *(const u32x4*)p; vr[i] = *(const u32x4*)(p + 128); }
            else if (!first) { const bf16_t* p = edge + ((size_t)(st - 1) * 4 + 2 + i) * 5632 + gcol; gr[i] = *(const u32x4*)p; vr[i] = *(const u32x4*)(p + 128); }
            else { gr[i] = (u32x4){0u, 0u, 0u, 0u}; vr[i] = (u32x4){0u, 0u, 0u, 0u}; } }
        f32x4 wg[3][2], wv[3][2], bg[2], bv[2];
#pragma unroll
        for (int jx = 0; jx < 3; ++jx)
#pragma unroll
            for (int e = 0; e < 2; ++e) { wg[jx][e] = *(const f32x4*)(cw + jx * NUP + ch0 + 4 * e); wv[jx][e] = *(const f32x4*)(cw + jx * NUP + DFF + ch0 + 4 * e); }
#pragma unroll
        for (int e = 0; e < 2; ++e) { bg[e] = *(const f32x4*)(cbias + ch0 + 4 * e); bv[e] = *(const f32x4*)(cbias + DFF + ch0 + 4 * e); }
#pragma unroll
        for (int i = 0; i < 2; ++i) {
            u32x4 w;
#pragma unroll
            for (int e = 0; e < 4; ++e) {
                const int q4 = e >> 1, c0 = 2 * (e & 1);
                const float yg0 = bg[q4][c0] + wg[0][q4][c0] * bflo(gr[i][e]) + wg[1][q4][c0] * bflo(gr[i + 1][e]) + wg[2][q4][c0] * bflo(gr[i + 2][e]);
                const float yg1 = bg[q4][c0 + 1] + wg[0][q4][c0 + 1] * bfhi(gr[i][e]) + wg[1][q4][c0 + 1] * bfhi(gr[i + 1][e]) + wg[2][q4][c0 + 1] * bfhi(gr[i + 2][e]);
                const float yv0 = bv[q4][c0] + wv[0][q4][c0] * bflo(vr[i][e]) + wv[1][q4][c0] * bflo(vr[i + 1][e]) + wv[2][q4][c0] * bflo(vr[i + 2][e]);
                const float yv1 = bv[q4][c0 + 1] + wv[0][q4][c0 + 1] * bfhi(vr[i][e]) + wv[1][q4][c0 + 1] * bfhi(vr[i + 1][e]) + wv[2][q4][c0 + 1] * bfhi(vr[i + 2][e]);
                w[e] = pk2(yg0 * sigmoidf_(yg0) * yv0, yg1 * sigmoidf_(yg1) * yv1);
            }
            *(u32x4*)(act + (size_t)(st * 64 + i) * DFF + ch0) = w;
        }
    }
}

#define XB_TMO      128
#define XB_XCNT(j)  (256  + 64 * (j))
#define XB_XSUB(j)  (1280 + 64 * (j))
#define XB_XGEN(j)  (2304 + 64 * (j))
#define XB_TOP      3328
#define XB_TOPGEN   3392
#define XCD_BAR_WORDS 3456
#define XB_SPIN_CAP (1u << 18)

__device__ __forceinline__ unsigned xb_ld(unsigned* p)              { return __hip_atomic_load(p, __ATOMIC_RELAXED, __HIP_MEMORY_SCOPE_AGENT); }
__device__ __forceinline__ unsigned xb_add(unsigned* p, unsigned v) { return __hip_atomic_fetch_add(p, v, __ATOMIC_RELAXED, __HIP_MEMORY_SCOPE_AGENT); }
__device__ __forceinline__ unsigned xb_xcc_id() { return (unsigned)__builtin_amdgcn_s_getreg((3 << 11) | 20) & 0xFu; }
#define XB_SPIN(cond, bar) do { unsigned _sp = 0; while (cond) { __builtin_amdgcn_s_sleep(1); \
    if ((++_sp & 255u) == 0u) { if (xb_ld(&(bar)[XB_TMO])) break; if (_sp > XB_SPIN_CAP) { atomicAdd(&(bar)[XB_TMO], 1u); break; } } } } while (0)

struct XcdBarrier {
    unsigned* bar; unsigned x;
    volatile LAS unsigned* st;
};

__device__ __forceinline__ XcdBarrier xcd_barrier_post(unsigned* bar, volatile LAS unsigned* st) {
    XcdBarrier b; b.bar = bar; b.x = xb_xcc_id(); b.st = st;
    if (threadIdx.x == 0) (void)xb_add(&bar[XB_XCNT(b.x)], 1u);
    return b;
}
__device__ __forceinline__ void xcd_barrier_complete(unsigned* bar, unsigned x, unsigned& nloc, unsigned& nx) {
    const unsigned G = gridDim.x * gridDim.y * gridDim.z;
    unsigned sum, cnt, mine, sp = 0u;
    for (;;) {
        sum = 0u; cnt = 0u; mine = 0u;
#pragma unroll
        for (unsigned j = 0; j < 16; ++j) { const unsigned c = xb_ld(&bar[XB_XCNT(j)]); sum += c; cnt += (c > 0u) ? 1u : 0u; mine = (j == x) ? c : mine; }
        if (sum == G) break;
        __builtin_amdgcn_s_sleep(1);
        if ((++sp & 255u) == 0u) { if (xb_ld(&bar[XB_TMO])) break; if (sp > XB_SPIN_CAP) { atomicAdd(&bar[XB_TMO], 1u); break; } }
    }
    nloc = mine > 0u ? mine : 1u; nx = cnt > 0u ? cnt : 1u;
}

__device__ __forceinline__ void xcd_barrier(const XcdBarrier& b) {
    asm volatile("s_waitcnt vmcnt(0)" ::: "memory");
    __syncthreads();
    if (threadIdx.x == 0) {
        unsigned* bar = b.bar;
        __builtin_amdgcn_s_waitcnt(0);
        unsigned nloc = b.st[0], nx = b.st[1];
        if (nloc == 0u) { xcd_barrier_complete(bar, b.x, nloc, nx); b.st[0] = nloc; b.st[1] = nx; }
        const unsigned old = xb_add(&bar[XB_XSUB(b.x)], 1u);
        const unsigned gen = old / nloc;
        if (old + 1u == (gen + 1u) * nloc) {
            __builtin_amdgcn_fence(__ATOMIC_RELEASE, "agent");
            asm volatile("s_waitcnt vmcnt(0)" ::: "memory");
            const unsigned og = xb_add(&bar[XB_TOP], 1u);
            const unsigned tg = og / nx;
            if (og + 1u == (tg + 1u) * nx) xb_add(&bar[XB_TOPGEN], 1u);
            else XB_SPIN(xb_ld(&bar[XB_TOPGEN]) == tg, bar);
            __builtin_amdgcn_fence(__ATOMIC_ACQUIRE, "agent");
            xb_add(&bar[XB_XGEN(b.x)], 1u);
            asm volatile("s_waitcnt vmcnt(0)" ::: "memory");
        } else {
            XB_SPIN(xb_ld(&bar[XB_XGEN(b.x)]) == gen, bar);
            __builtin_amdgcn_fence(__ATOMIC_ACQUIRE, "agent");
            asm volatile("s_waitcnt vmcnt(0)" ::: "memory");
        }
    }
    __syncthreads();
}


__global__ void __launch_bounds__(NTHR) mk_fwd(Args a) {
    extern __shared__ __attribute__((aligned(16))) unsigned char lds_raw[];
    LAS unsigned char* lds = (LAS unsigned char*)lds_raw;
    cg::grid_group grid = cg::this_grid();
    const int bid = blockIdx.x, G = gridDim.x;
    volatile LAS unsigned* xst = (volatile LAS unsigned*)(lds + LDS_BYTES - 64);
    if (threadIdx.x < 16) xst[threadIdx.x] = 0u;
    __syncthreads();
    XcdBarrier xbar = xcd_barrier_post((unsigned*)(a.ws + WS_BAR), xst);
    unsigned char* ws = a.ws;
    const float* mod = (const float*)(ws + WS_MOD);
#define WSB(off) ((bf16_t*)(ws + (off)))
#ifndef MK_PHMASK
#define MK_PHMASK 0x1ffff
#endif
#define PHON(n) (((MK_PHMASK) >> (n)) & 1)
    const int lo = a.ph_lo, hi = a.ph_hi;
#define IN(k) (PHON(k) && lo <= (k) && (k) < hi)
#define SEAM(k) do { if ((k) + 1 < hi) xcd_barrier(xbar); } while (0)
    if (a.ph_lo < 0) grid.sync();
#ifndef MK_DUP
#define MK_DUP 0
#endif
#ifndef MK_XSYNC
#define MK_XSYNC 0
#endif
#define DUPON(n) (((MK_DUP) >> (n)) & 1)
#define PHASE(k, ...) if (IN(k)) { { __VA_ARGS__ } if (DUPON(k)) { __VA_ARGS__ } SEAM(k); }
    for (int xs_ = 0; xs_ < MK_XSYNC; ++xs_) grid.sync();
    PHASE(0,  p0_phase(a, lds, bid, G); )
    PHASE(1,  adaln_phase<false>(a.in[0], a.in[5], mod, 0, 1024, WSB(SL(2)), bid, G); )
    PHASE(2,  pg8::Gemm g{WSB(SL(2)), WSB(WS_WIN), T, NPROJ, 1024}; pg8::StaticOrder S; S.init(T, NPROJ, G, bid);
                 pg8::EpiProj E{WSB(SL(4)), SLAB_EL, (float*)(ws + WS_RSQ), (float*)(ws + WS_RSKV)};
                 pg8::gemm_phase<pg8::EpiProj, pg8::StaticOrder, true, true>(lds, g, S, E); )
    PHASE(3,
                 h1_phase(WSB(SL(6)), WSB(SL(7)), WSB(SL(8)), WSB(SL(6)), WSB(SL(7)), (const float*)(ws + WS_LB), WSB(SL(14)), (float*)(ws + WS_G), lds, bid, G);
                 if (DUPON(21)) h1_phase(WSB(SL(6)), WSB(SL(7)), WSB(SL(8)), (bf16_t*)a.out, (bf16_t*)a.out + SLAB_EL, (const float*)(ws + WS_LB), (bf16_t*)a.out + 2 * SLAB_EL, (float*)(ws + 40 * MiB), lds, bid, G); )
    PHASE(4,  { pg8::Gemm g{WSB(SL(4)), WSB(WS_WUQ), T, 768, 512}; pg8::StaticOrder S; S.init(T, 768, G, bid);
                 pg8::EpiRowScale E{(bf16_t*)a.out, 768, (const float*)(ws + WS_RSQ), 1.f / 512.f};
                 pg8::gemm_phase<pg8::EpiRowScale, pg8::StaticOrder, true, true>(lds, g, S, E); }
               { pg8::Gemm g{WSB(SL(5)), WSB(WS_WUKV), T, 512, 256, 512}; pg8::StaticOrder S; S.init(T, 512, G, bid);
                 pg8::EpiRowScale E{WSB(SL(2)), 512, (const float*)(ws + WS_RSKV), 1.f / 256.f};
                 pg8::gemm_phase<pg8::EpiRowScale, pg8::StaticOrder, true, true>(lds, g, S, E); }
               { pg8::Gemm g{WSB(WS_WUKV + 512 * 1024), WSB(SL(5)), 512, T, 256, 512}; pg8::StaticOrder S; S.init(512, T, G, bid);
                 pg8::EpiColScale E{WSB(SL(8)), T, (const float*)(ws + WS_RSKV), 1.f / 256.f};
                 pg8::gemm_phase<pg8::EpiColScale, pg8::StaticOrder, true, true>(lds, g, S, E); } )
    PHASE(6,  qk_prep_phase(a, bid, G); if (DUPON(18)) qk_prep_phase(a, bid, G);
                 h2_phase(WSB(SL(14)), (const float*)(ws + WS_G), bid, G); )
    PHASE(7,  const bf16_t* Q = WSB(SL(3)); const bf16_t* K = (const bf16_t*)((unsigned char*)a.out + 64 * MiB); const bf16_t* Vt = WSB(SL(8)); bf16_t* O = (bf16_t*)a.out;
                 float mfix; { const int ln = threadIdx.x & 63; float gqm = fmaxf(fabsf(a.in[11][ln]), fabsf(a.in[11][64 + (ln & 31)])), gkm = fmaxf(fabsf(a.in[12][ln]), fabsf(a.in[12][64 + (ln & 31)]));
                     for (int o = 1; o < 64; o <<= 1) { gqm = fmaxf(gqm, __shfl_xor(gqm, o)); gkm = fmaxf(gkm, __shfl_xor(gkm, o)); }
                     mfix = 14.135f * 1.02f * gqm * gkm; }
                 const bool fix = mfix <= 40.f;
                 for (int rep = 0; rep < (DUPON(19) ? 2 : 1); ++rep) {
                 if (fix) { if (G == 256) { const int bh = bid >> 2, s = bid & 3; attn_unit64(Q, K, Vt, O, bh, 7 - s, mfix, lds); attn_unit64(Q, K, Vt, O, bh, s, mfix, lds); }
                            else { for (int j = bid; j < 512; j += G) attn_unit64(Q, K, Vt, O, j >> 3, 7 - (j & 7), mfix, lds); } }
                 else if (G == 256) { const int bh = bid >> 2, s = bid & 3;
                     for (int i = 0; i < 4; ++i) { const int qb = (i == 0) ? (15 - s) : (i == 1) ? (8 + s) : (i == 2) ? (7 - s) : s; attn_unit<false>(Q, K, Vt, O, bh, qb, mfix, lds); } }
                 else { for (int j = bid; j < 1024; j += G) attn_unit<false>(Q, K, Vt, O, j >> 4, 15 - (j & 15), mfix, lds); }
                 }
                 for (int j = bid; j < 512; j += G) h3_unit(j, WSB(SL(6)), WSB(SL(7)), WSB(SL(14)), WSB(SL(9)), a.in[14], (bf16_t*)a.out);
                 if (DUPON(20)) { for (int j = bid; j < 512; j += G) h3_unit(j, WSB(SL(6)), WSB(SL(7)), WSB(SL(14)), WSB(SL(9)), a.in[14], (bf16_t*)a.out); } )
    PHASE(8,  pg8::Gemm g{(const bf16_t*)a.out, WSB(WS_WA), T, 1024, 512, 1024}; pg8::PairOrder S; S.init(T, 1024, G, bid);
                 pg8::EpiBranchPair E{WSB(SL(10)), WSB(SL(12)), WSB(SL(2)), SLAB_EL};
                 pg8::gemm_phase<pg8::EpiBranchPair, pg8::PairOrder, true, true>(lds, g, S, E); )
    PHASE(10,  pg8::Gemm g{WSB(SL(2)), WSB(WS_WOUT), T, 1024, 1024}; pg8::StaticOrder S; S.init(T, 1024, G, bid);
                  pg8::EpiResGate<false, true> E{a.in[0], WSB(SL(14)), mod + 2048};
                  pg8::gemm_phase<pg8::EpiResGate<false, true>, pg8::StaticOrder, true, true>(lds, g, S, E); )
    PHASE(11,  adaln_phase<true>(WSB(SL(14)), a.in[18], mod, 3072, 4096, (bf16_t*)a.out, bid, G); )
    PHASE(12,  pg8::Gemm g{(const bf16_t*)a.out, WSB(WS_WUP), T, NUP, 1024}; pg8::StaticOrder S; S.init(T, NUP, G, bid);
                  pg8::EpiConvAct E{WSB(WS_ACT), WSB(WS_UH), a.in[20], a.in[21]};
                  pg8::gemm_phase<pg8::EpiConvAct, pg8::StaticOrder, true, true>(lds, g, S, E); )
    PHASE(13,  conv_fix_phase(a, bid, G); )
    PHASE(16,  pg8::Gemm g{WSB(WS_ACT), WSB(WS_WDOWN), T, 1024, DFF}; pg8::StaticOrder S; S.init(T, 1024, G, bid);
                  pg8::EpiResGate<true, false> E{WSB(SL(14)), a.out, mod + 5120};
                  pg8::gemm_phase<pg8::EpiResGate<true, false>, pg8::StaticOrder, true, true>(lds, g, S, E); )
#undef IN
#undef SEAM
#undef PHASE
#undef WSB
}

#ifndef MK_MULTI
#define MK_MULTI 0
#endif
extern "C" void kernel_launch(void* const* d_in, const int* in_sizes, int n_in, void* d_out, int out_size, void* d_ws, size_t ws_size, hipStream_t stream) {
    static int grid = 0;
    if (grid == 0) {
        if (n_in != 23 || out_size != T * DM || ws_size < WS_NEED) { fprintf(stderr, "kernel_launch: unexpected shapes (n_in %d out %d ws %zu)\n", n_in, out_size, ws_size); grid = -1; return; }
        int dev = 0, cus = 0, per_cu = 0;
        hipGetDevice(&dev); hipDeviceGetAttribute(&cus, hipDeviceAttributeMultiprocessorCount, dev);
        hipFuncSetAttribute((const void*)mk_fwd, hipFuncAttributeMaxDynamicSharedMemorySize, LDS_BYTES);
        hipOccupancyMaxActiveBlocksPerMultiprocessor(&per_cu, (const void*)mk_fwd, NTHR, LDS_BYTES);
        if (per_cu < 1) { fprintf(stderr, "kernel_launch: occupancy query says %d blocks per CU\n", per_cu); per_cu = 1; }
        (void)hipGetLastError();
        grid = cus * per_cu;
    }
    if (grid < 0) return;
    if (hipMemsetAsync((char*)d_ws + WS_BAR, 0, XCD_BAR_WORDS * 4, stream) != hipSuccess) { fprintf(stderr, "kernel_launch: memset failed\n"); return; }
    Args a{};
    for (int i = 0; i < 23; ++i) a.in[i] = (const float*)d_in[i];
    a.out = (float*)d_out; a.ws = (unsigned char*)d_ws;
    for (int i = 0; i < 16; ++i) a.invf[i] = powf(10000.0f, -(float)(2 * i) / 32.0f);
#if MK_MULTI
    for (int ph = 0; ph < NPHASE; ++ph) { a.ph_lo = ph; a.ph_hi = ph + 1; hipLaunchKernelGGL(mk_fwd, dim3(grid), dim3(NTHR), LDS_BYTES, stream, a); }
#else
    a.ph_lo = 0; a.ph_hi = NPHASE;
    void* args[] = {&a};
    hipError_t e = hipLaunchCooperativeKernel((const void*)mk_fwd, dim3(grid), dim3(NTHR), args, LDS_BYTES, stream);
    if (e != hipSuccess) fprintf(stderr, "cooperative launch failed: %s (grid %d)\n", hipGetErrorString(e), grid);
#endif
}
```

```cpp
#include <hip/hip_runtime.h>
#include <hip/hip_cooperative_groups.h>
#include <cstdio>
#include <cstdint>
#include <cmath>
namespace cg = cooperative_groups;
namespace pg8 {
#define PG8_LAS __attribute__((address_space(3)))
typedef unsigned short bf16_t;
typedef short bf16x8 __attribute__((ext_vector_type(8)));
typedef float f32x4 __attribute__((ext_vector_type(4)));
typedef unsigned u32x4 __attribute__((ext_vector_type(4)));
constexpr int BM = 256, BK = 64, HALF = 128, HTB = HALF * BK * 2  , STAGE_BYTES = 8 * HTB, NXCD = 8, WGM = 8;

__host__ __device__ __forceinline__ int lds_byte(int r, int c) { const int st = (r >> 4) * 2 + (c >> 5), rr = r & 15, cc = c & 31, ob = rr * 64 + cc * 2; return st * 1024 + (ob ^ (((ob >> 9) & 1) << 5)); }
__host__ __device__ __forceinline__ void stage_rc(int b, int& R, int& C) { const int st = b / 1024, sb = b % 1024, swz = sb ^ (((sb >> 9) & 1) << 5); R = (st >> 1) * 16 + swz / 64; C = (st & 1) * 32 + (swz % 64) / 2; }
__host__ __device__ __forceinline__ int perm32(int rho) { const int n = rho >> 4, i = rho & 15; return 8 * (i >> 2) + 4 * n + (i & 3); }

struct Unit { int pm, pn, kh; };
struct Gemm { const bf16_t* A; const bf16_t* Bt; int M, N, K, ldk; };

struct StaticOrder {
    int nM, nN, nwg, G, c;
    __host__ __device__ void init(int M, int N, int G_, int c_) { nM = M / BM; nN = N / BM; nwg = nM * nN; G = G_; c = c_; }
    __host__ __device__ bool next(int i, Unit& u) const {
        const long L = (long)i * G + c; if (L >= nwg) return false;
        int wgid = (int)L; { const int q = nwg / NXCD, r = nwg % NXCD, xcd = wgid % NXCD, off = wgid / NXCD; wgid = (xcd < r ? xcd * (q + 1) : r * (q + 1) + (xcd - r) * q) + off; }
        const int nig = WGM * nN, gid = wgid / nig, fm = gid * WGM, gsz = (nM - fm) < WGM ? (nM - fm) : WGM;
        u.pm = fm + ((wgid % nig) % gsz); u.pn = (wgid % nig) / gsz; u.kh = 0; return true;
    }
    __device__ __forceinline__ void a_ready(const Unit&) const {}
    __device__ __forceinline__ void done(const Unit&) const {}
};

struct PairOrder {
    StaticOrder base;
    __host__ __device__ void init(int M, int N, int G_, int c_) { base.init(M, N, G_, c_); }
    __host__ __device__ bool next(int i, Unit& u) const { if (!base.next(i >> 1, u)) return false; u.kh = i & 1; return true; }
    __device__ __forceinline__ void a_ready(const Unit&) const {}
    __device__ __forceinline__ void done(const Unit&) const {}
};

__device__ __forceinline__ unsigned cvt_pk_bf16(float lo, float hi) { unsigned r; asm volatile("v_cvt_pk_bf16_f32 %0, %1, %2" : "=v"(r) : "v"(lo), "v"(hi)); return r; }
typedef float f32x2 __attribute__((ext_vector_type(2)));
__device__ __forceinline__ f32x2 gelu_pk(f32x2 v) {
    const f32x2 av = __builtin_elementwise_abs(v), d = av * 0.2316418882f + 1.0f;
    f32x2 t; t.x = __builtin_amdgcn_rcpf(d.x); t.y = __builtin_amdgcn_rcpf(d.y);
    f32x2 q = t * 0.5307027145f + (-0.7265760135f); q = q * t + 0.7107068705f; q = q * t + (-0.142248368f); q = q * t + 0.127414796f; q = q * t;
    const f32x2 s = (v * v) * (-0.72134752044f);
    f32x2 e; e.x = __builtin_amdgcn_exp2f(s.x); e.y = __builtin_amdgcn_exp2f(s.y);
    const f32x2 m = v * (q * e), r = v - m;
    f32x2 o; o.x = v.x < 0.f ? m.x : r.x; o.y = v.y < 0.f ? m.y : r.y; return o;
}

template <int ACT  > struct EpiBf16 {
    static constexpr bool PERM = true, AFTER_DRAIN = false, ROWPERM = false; static_assert(ACT == 0 || ACT == 1, "EpiBf16: ACT is 0 (none) or 1 (gelu_pk)");
    bf16_t* O; int ldc; const float* bias; int split_cols; size_t split_stride; float scale0;
    __device__ __forceinline__ void operator()(const f32x4 (&acc)[2][2][4][2], const Unit& u, int wr, int wc, int fr, int fq) const {
        const int row0 = u.pm * BM + wr * 64 + fr; int colt = u.pn * BM; bf16_t* base = O;
        float sc = 1.f; if (split_cols) { const int t = colt / split_cols; base += (size_t)t * split_stride; colt -= t * split_cols; if (t == 0) sc = scale0; }
        const int col0 = colt + wc * 32 + 8 * fq, bcol0 = u.pn * BM + wc * 32 + 8 * fq;
        f32x4 bv[2][2];
#pragma unroll
        for (int bj = 0; bj < 2; ++bj)
#pragma unroll
            for (int n = 0; n < 2; ++n) bv[bj][n] = bias ? *(const f32x4*)(bias + bcol0 + bj * HALF + 4 * n) : (f32x4){0.f, 0.f, 0.f, 0.f};
#pragma unroll
        for (int ai = 0; ai < 2; ++ai)
#pragma unroll
            for (int m = 0; m < 4; ++m) { bf16_t* rowp = base + (size_t)(row0 + ai * HALF + m * 16) * ldc + col0;
#pragma unroll
                for (int bj = 0; bj < 2; ++bj) { f32x4 v0 = acc[ai][bj][m][0] + bv[bj][0], v1 = acc[ai][bj][m][1] + bv[bj][1];
                    if (ACT == 1) { f32x2 a = gelu_pk((f32x2){v0[0], v0[1]}), b = gelu_pk((f32x2){v0[2], v0[3]}), c = gelu_pk((f32x2){v1[0], v1[1]}), d = gelu_pk((f32x2){v1[2], v1[3]});
                        v0 = (f32x4){a.x, a.y, b.x, b.y}; v1 = (f32x4){c.x, c.y, d.x, d.y}; }
                    v0 = v0 * sc; v1 = v1 * sc; u32x4 w; w.x = cvt_pk_bf16(v0[0], v0[1]); w.y = cvt_pk_bf16(v0[2], v0[3]); w.z = cvt_pk_bf16(v1[0], v1[1]); w.w = cvt_pk_bf16(v1[2], v1[3]);
                    *(u32x4*)(rowp + bj * HALF) = w; } }
    }
};


template <bool BASE_BF16, bool OUT_BF16> struct EpiResGate {
    static constexpr bool PERM = false, AFTER_DRAIN = false, ROWPERM = false;
    const void* base; void* out; const float* gate;
    __device__ __forceinline__ void operator()(const f32x4 (&acc)[2][2][4][2], const Unit& u, int wr, int wc, int fr, int fq) const {
        const int row0 = u.pm * BM + wr * 64 + fr, col0 = u.pn * BM + wc * 32 + 4 * fq;
        const float* gp = gate + ((u.pm * BM) >> 12) * 6144 + col0;
        f32x4 gv[2][2];
#pragma unroll
        for (int bj = 0; bj < 2; ++bj)
#pragma unroll
            for (int n = 0; n < 2; ++n) gv[bj][n] = *(const f32x4*)(gp + bj * HALF + 16 * n);
#pragma unroll
        for (int ai = 0; ai < 2; ++ai) {
            f32x4 bv[4][2][2]; unsigned long long bw[4][2][2];
#pragma unroll
            for (int m = 0; m < 4; ++m) { const size_t off = (size_t)(row0 + ai * HALF + m * 16) * 1024 + col0;
#pragma unroll
                for (int bj = 0; bj < 2; ++bj)
#pragma unroll
                    for (int n = 0; n < 2; ++n) {
                        if (BASE_BF16) bw[m][bj][n] = __builtin_nontemporal_load((const unsigned long long*)((const bf16_t*)base + off + bj * HALF + 16 * n));
                        else bv[m][bj][n] = __builtin_nontemporal_load((const f32x4*)((const float*)base + off + bj * HALF + 16 * n)); } }
            asm volatile("" ::: "memory");
#pragma unroll
            for (int m = 0; m < 4; ++m) { const size_t off = (size_t)(row0 + ai * HALF + m * 16) * 1024 + col0;
#pragma unroll
                for (int bj = 0; bj < 2; ++bj)
#pragma unroll
                    for (int n = 0; n < 2; ++n) {
                        f32x4 b4;
                        if (BASE_BF16) { const unsigned long long w = bw[m][bj][n];
                            b4 = (f32x4){__uint_as_float((unsigned)(w & 0xffffull) << 16), __uint_as_float((unsigned)((w >> 16) & 0xffffull) << 16),
                                         __uint_as_float((unsigned)((w >> 32) & 0xffffull) << 16), __uint_as_float((unsigned)((w >> 48) & 0xffffull) << 16)}; }
                        else b4 = bv[m][bj][n];
                        const f32x4 o = b4 + gv[bj][n] * acc[ai][bj][m][n];
                        if (OUT_BF16) *(unsigned long long*)((bf16_t*)out + off + bj * HALF + 16 * n) = (unsigned long long)cvt_pk_bf16(o[0], o[1]) | ((unsigned long long)cvt_pk_bf16(o[2], o[3]) << 32);
                        else *(f32x4*)((float*)out + off + bj * HALF + 16 * n) = o; } }
        }
    }
};
template <int MODE> struct EpiBranch {
    static constexpr bool PERM = false, AFTER_DRAIN = false, ROWPERM = false;
    const bf16_t* gsl; float* tmp; bf16_t* merged; size_t slab_elems;
    __device__ __forceinline__ void operator()(const f32x4 (&acc)[2][2][4][2], const Unit& u, int wr, int wc, int fr, int fq) const {
        const int row0 = u.pm * BM + wr * 64 + fr, cin = wc * 32 + 4 * fq, col0 = u.pn * BM + cin;
        const bf16_t* gb = gsl + (size_t)(u.pn >> 1) * slab_elems + (u.pn & 1) * 256 + cin;
#pragma unroll
        for (int ai = 0; ai < 2; ++ai)
#pragma unroll
            for (int m = 0; m < 4; ++m) { const int row = row0 + ai * HALF + m * 16; const size_t off = (size_t)row * 1024 + col0; const bf16_t* gr = gb + (size_t)row * 512;
#pragma unroll
                for (int bj = 0; bj < 2; ++bj)
#pragma unroll
                    for (int n = 0; n < 2; ++n) {
                        const unsigned long long gw = *(const unsigned long long*)(gr + bj * HALF + 16 * n);
                        f32x4 g; g[0] = __uint_as_float((unsigned)(gw & 0xffffull) << 16); g[1] = __uint_as_float((unsigned)((gw >> 16) & 0xffffull) << 16);
                        g[2] = __uint_as_float((unsigned)((gw >> 32) & 0xffffull) << 16); g[3] = __uint_as_float((unsigned)((gw >> 48) & 0xffffull) << 16);
                        f32x4 v;
#pragma unroll
                        for (int e = 0; e < 4; ++e) v[e] = acc[ai][bj][m][n][e] * __builtin_amdgcn_rcpf(1.0f + __expf(-g[e]));
                        unsigned long long* mp = (unsigned long long*)(merged + off + bj * HALF + 16 * n);
                        if (MODE == 0) { *mp = (unsigned long long)cvt_pk_bf16(v[0], v[1]) | ((unsigned long long)cvt_pk_bf16(v[2], v[3]) << 32); }
                        else { const unsigned long long tw = *mp;
                            const f32x4 o = {v[0] + __uint_as_float((unsigned)(tw & 0xffffull) << 16), v[1] + __uint_as_float((unsigned)((tw >> 16) & 0xffffull) << 16),
                                             v[2] + __uint_as_float((unsigned)((tw >> 32) & 0xffffull) << 16), v[3] + __uint_as_float((unsigned)((tw >> 48) & 0xffffull) << 16)};
                            *mp = (unsigned long long)cvt_pk_bf16(o[0], o[1]) | ((unsigned long long)cvt_pk_bf16(o[2], o[3]) << 32); } } }
    }
};

struct EpiBranchPair {
    static constexpr bool PERM = false, AFTER_DRAIN = false, ROWPERM = false;
    const bf16_t* ga; const bf16_t* gb; bf16_t* merged; size_t slab_elems;
    __device__ __forceinline__ void operator()(f32x4 (&acc)[2][2][4][2], const Unit& u, int wr, int wc, int fr, int fq) const {
        const int row0 = u.pm * BM + wr * 64 + fr, cin = wc * 32 + 4 * fq, col0 = u.pn * BM + cin;
        const size_t gofs = (size_t)(u.pn >> 1) * slab_elems + (u.pn & 1) * 256 + cin;
#pragma unroll
        for (int ai = 0; ai < 2; ++ai) {
            unsigned long long wbv[4][2][2], wav[4][2][2];
#pragma unroll
            for (int m = 0; m < 4; ++m) { const size_t gro = gofs + (size_t)(row0 + ai * HALF + m * 16) * 512;
#pragma unroll
                for (int bj = 0; bj < 2; ++bj)
#pragma unroll
                    for (int n = 0; n < 2; ++n) { wbv[m][bj][n] = *(const unsigned long long*)(gb + gro + bj * HALF + 16 * n);
                        if (u.kh == 0) wav[m][bj][n] = __builtin_nontemporal_load((const unsigned long long*)(ga + gro + bj * HALF + 16 * n)); else wav[m][bj][n] = 0ull; } }
            asm volatile("" ::: "memory");
#pragma unroll
            for (int m = 0; m < 4; ++m) { const size_t off = (size_t)(row0 + ai * HALF + m * 16) * 1024 + col0;
#pragma unroll
                for (int bj = 0; bj < 2; ++bj)
#pragma unroll
                    for (int n = 0; n < 2; ++n) {
                        const unsigned long long wb = wbv[m][bj][n];
                        f32x4 eb;
                        eb[0] = __expf(-fmaxf(__uint_as_float((unsigned)(wb & 0xffffull) << 16), -60.f)); eb[1] = __expf(-fmaxf(__uint_as_float((unsigned)((wb >> 16) & 0xffffull) << 16), -60.f));
                        eb[2] = __expf(-fmaxf(__uint_as_float((unsigned)((wb >> 32) & 0xffffull) << 16), -60.f)); eb[3] = __expf(-fmaxf(__uint_as_float((unsigned)((wb >> 48) & 0xffffull) << 16), -60.f));
                        if (u.kh == 0) {
                            const unsigned long long wa = wav[m][bj][n];
                            f32x4 ea;
                            ea[0] = __expf(-__uint_as_float((unsigned)(wa & 0xffffull) << 16)); ea[1] = __expf(-__uint_as_float((unsigned)((wa >> 16) & 0xffffull) << 16));
                            ea[2] = __expf(-__uint_as_float((unsigned)((wa >> 32) & 0xffffull) << 16)); ea[3] = __expf(-__uint_as_float((unsigned)((wa >> 48) & 0xffffull) << 16));
#pragma unroll
                            for (int e_ = 0; e_ < 4; ++e_) acc[ai][bj][m][n][e_] *= (1.0f + eb[e_]) * __builtin_amdgcn_rcpf(1.0f + ea[e_]);
                        } else {
                            f32x4 o;
#pragma unroll
                            for (int e_ = 0; e_ < 4; ++e_) o[e_] = acc[ai][bj][m][n][e_] * __builtin_amdgcn_rcpf(1.0f + eb[e_]);
                            *(unsigned long long*)(merged + off + bj * HALF + 16 * n) = (unsigned long long)cvt_pk_bf16(o[0], o[1]) | ((unsigned long long)cvt_pk_bf16(o[2], o[3]) << 32);
                        } } }
        }
    }
};

__device__ __forceinline__ float dpp_shr1(float v) { return __builtin_bit_cast(float, __builtin_amdgcn_update_dpp(0, __builtin_bit_cast(int, v), 0x111, 0xf, 0xf, true)); }
struct EpiConvAct {
    static constexpr bool PERM = true, AFTER_DRAIN = false, ROWPERM = true;
    bf16_t* act; bf16_t* edge; const float* cw; const float* cb;
    __device__ __forceinline__ void operator()(const f32x4 (&acc)[2][2][4][2], const Unit& u, int wr, int wc, int fr, int fq) const {
        const int chl = wc * 32 + 8 * fq, ch0 = u.pn * 128 + chl, ucol = u.pn * 256 + chl;
#pragma unroll
        for (int n = 0; n < 2; ++n) {
            const f32x4 wg0 = *(const f32x4*)(cw + ch0 + 4 * n), wg1 = *(const f32x4*)(cw + 5632 + ch0 + 4 * n), wg2 = *(const f32x4*)(cw + 2 * 5632 + ch0 + 4 * n), bg = *(const f32x4*)(cb + ch0 + 4 * n);
            const f32x4 wv0 = *(const f32x4*)(cw + 2816 + ch0 + 4 * n), wv1 = *(const f32x4*)(cw + 5632 + 2816 + ch0 + 4 * n), wv2 = *(const f32x4*)(cw + 2 * 5632 + 2816 + ch0 + 4 * n), bv = *(const f32x4*)(cb + 2816 + ch0 + 4 * n);
#pragma unroll
            for (int ai = 0; ai < 2; ++ai) {
                const int stripe = u.pm * 4 + ai * 2 + wr;
                f32x4 pg1, pg2, pv1, pv2;
#pragma unroll
                for (int e = 0; e < 4; ++e) { pg1[e] = dpp_shr1(acc[ai][0][3][n][e]); pg2[e] = dpp_shr1(acc[ai][0][2][n][e]); pv1[e] = dpp_shr1(acc[ai][1][3][n][e]); pv2[e] = dpp_shr1(acc[ai][1][2][n][e]); }
                f32x4 yg[4], yv[4];
                yg[0] = bg + wg0 * pg2 + wg1 * pg1 + wg2 * acc[ai][0][0][n];
                yg[1] = bg + wg0 * pg1 + wg1 * acc[ai][0][0][n] + wg2 * acc[ai][0][1][n];
                yg[2] = bg + wg0 * acc[ai][0][0][n] + wg1 * acc[ai][0][1][n] + wg2 * acc[ai][0][2][n];
                yg[3] = bg + wg0 * acc[ai][0][1][n] + wg1 * acc[ai][0][2][n] + wg2 * acc[ai][0][3][n];
                yv[0] = bv + wv0 * pv2 + wv1 * pv1 + wv2 * acc[ai][1][0][n];
                yv[1] = bv + wv0 * pv1 + wv1 * acc[ai][1][0][n] + wv2 * acc[ai][1][1][n];
                yv[2] = bv + wv0 * acc[ai][1][0][n] + wv1 * acc[ai][1][1][n] + wv2 * acc[ai][1][2][n];
                yv[3] = bv + wv0 * acc[ai][1][1][n] + wv1 * acc[ai][1][2][n] + wv2 * acc[ai][1][3][n];
                bf16_t* arow = act + (size_t)(stripe * 64 + 4 * fr) * 2816 + ch0 + 4 * n;
#pragma unroll
                for (int m = 0; m < 4; ++m) { f32x4 o;
#pragma unroll
                    for (int e = 0; e < 4; ++e) o[e] = yg[m][e] * __builtin_amdgcn_rcpf(1.0f + __expf(-yg[m][e])) * yv[m][e];
                    *(unsigned long long*)(arow + (size_t)m * 2816) = (unsigned long long)cvt_pk_bf16(o[0], o[1]) | ((unsigned long long)cvt_pk_bf16(o[2], o[3]) << 32); }
                if (fr == 0 || fr == 15) {
                    const int m0 = (fr == 0) ? 0 : 2;
#pragma unroll
                    for (int mm = 0; mm < 2; ++mm)
#pragma unroll
                        for (int bj = 0; bj < 2; ++bj) { const f32x4 x = (fr == 0) ? acc[ai][bj][mm][n] : acc[ai][bj][2 + mm][n];
                            *(unsigned long long*)(edge + ((size_t)stripe * 4 + m0 + mm) * 5632 + ucol + bj * HALF + 4 * n) = (unsigned long long)cvt_pk_bf16(x[0], x[1]) | ((unsigned long long)cvt_pk_bf16(x[2], x[3]) << 32); }
                }
            }
        }
    }
};

struct EpiRowScale {
    static constexpr bool PERM = true, AFTER_DRAIN = false, ROWPERM = false;
    bf16_t* O; int ldc; const float* rs; float inv_n;
    __device__ __forceinline__ void operator()(const f32x4 (&acc)[2][2][4][2], const Unit& u, int wr, int wc, int fr, int fq) const {
        const int row0 = u.pm * BM + wr * 64 + fr, col0 = u.pn * BM + wc * 32 + 8 * fq;
#pragma unroll
        for (int ai = 0; ai < 2; ++ai)
#pragma unroll
            for (int m = 0; m < 4; ++m) { const int row = row0 + ai * HALF + m * 16; const float sc = rsqrtf(rs[row] * inv_n + 1e-6f); bf16_t* rowp = O + (size_t)row * ldc + col0;
#pragma unroll
                for (int bj = 0; bj < 2; ++bj) { const f32x4 v0 = acc[ai][bj][m][0] * sc, v1 = acc[ai][bj][m][1] * sc;
                    u32x4 w; w.x = cvt_pk_bf16(v0[0], v0[1]); w.y = cvt_pk_bf16(v0[2], v0[3]); w.z = cvt_pk_bf16(v1[0], v1[1]); w.w = cvt_pk_bf16(v1[2], v1[3]);
                    *(u32x4*)(rowp + bj * HALF) = w; } }
    }
};
struct EpiColScale {
    static constexpr bool PERM = true, AFTER_DRAIN = false, ROWPERM = false;
    bf16_t* O; int ldc; const float* cs; float inv_n;
    __device__ __forceinline__ void operator()(const f32x4 (&acc)[2][2][4][2], const Unit& u, int wr, int wc, int fr, int fq) const {
        const int row0 = u.pm * BM + wr * 64 + fr, col0 = u.pn * BM + wc * 32 + 8 * fq;
#pragma unroll
        for (int bj = 0; bj < 2; ++bj) {
            f32x4 s0 = *(const f32x4*)(cs + col0 + bj * HALF), s1 = *(const f32x4*)(cs + col0 + bj * HALF + 4);
#pragma unroll
            for (int e_ = 0; e_ < 4; ++e_) { s0[e_] = rsqrtf(s0[e_] * inv_n + 1e-6f); s1[e_] = rsqrtf(s1[e_] * inv_n + 1e-6f); }
#pragma unroll
            for (int ai = 0; ai < 2; ++ai)
#pragma unroll
                for (int m = 0; m < 4; ++m) { const f32x4 v0 = acc[ai][bj][m][0] * s0, v1 = acc[ai][bj][m][1] * s1;
                    u32x4 w; w.x = cvt_pk_bf16(v0[0], v0[1]); w.y = cvt_pk_bf16(v0[2], v0[3]); w.z = cvt_pk_bf16(v1[0], v1[1]); w.w = cvt_pk_bf16(v1[2], v1[3]);
                    *(u32x4*)(O + (size_t)(row0 + ai * HALF + m * 16) * ldc + col0 + bj * HALF) = w; }
        }
    }
};

struct EpiProj {
    static constexpr bool PERM = true, AFTER_DRAIN = false, ROWPERM = false;
    bf16_t* O; size_t slab_elems; float* ssq_q; float* ssq_kv;
    __device__ __forceinline__ void operator()(const f32x4 (&acc)[2][2][4][2], const Unit& u, int wr, int wc, int fr, int fq) const {
        const int row0 = u.pm * BM + wr * 64 + fr, col0 = (u.pn & 1) * 256 + wc * 32 + 8 * fq;
        bf16_t* base = O + (size_t)(u.pn >> 1) * slab_elems;
#pragma unroll
        for (int ai = 0; ai < 2; ++ai)
#pragma unroll
            for (int m = 0; m < 4; ++m) { bf16_t* rowp = base + (size_t)(row0 + ai * HALF + m * 16) * 512 + col0;
#pragma unroll
                for (int bj = 0; bj < 2; ++bj) { const f32x4 v0 = acc[ai][bj][m][0], v1 = acc[ai][bj][m][1];
                    u32x4 w; w.x = cvt_pk_bf16(v0[0], v0[1]); w.y = cvt_pk_bf16(v0[2], v0[3]); w.z = cvt_pk_bf16(v1[0], v1[1]); w.w = cvt_pk_bf16(v1[2], v1[3]);
                    *(u32x4*)(rowp + bj * HALF) = w; } }
        if (u.pn <= 2) {
            float* dst = (u.pn < 2) ? ssq_q : ssq_kv;
#pragma unroll
            for (int ai = 0; ai < 2; ++ai)
#pragma unroll
                for (int m = 0; m < 4; ++m) { float s = 0.f;
#pragma unroll
                    for (int bj = 0; bj < 2; ++bj)
#pragma unroll
                        for (int n = 0; n < 2; ++n) { const f32x4 x = acc[ai][bj][m][n]; s += (x[0] * x[0] + x[1] * x[1]) + (x[2] * x[2] + x[3] * x[3]); }
                    s += __shfl_xor(s, 16); s += __shfl_xor(s, 32);
                    if (fq == 0) __hip_atomic_fetch_add(dst + row0 + ai * HALF + m * 16, s, __ATOMIC_RELAXED, __HIP_MEMORY_SCOPE_AGENT); }
        }
    }
};
template <class Epi, class Sched, bool ALIGN_EPI = false, bool SP2 = false>
__device__ __forceinline__ void gemm_phase(PG8_LAS unsigned char* lds, const Gemm g, const Sched& S, const Epi& E) {
    const int tid = threadIdx.x, wid = __builtin_amdgcn_readfirstlane(tid >> 6), lane = tid & 63, wr = wid >> 2, wc = wid & 3, fr = lane & 15, fq = lane >> 4;
    const int K = g.K, nt = K / BK, ldk = g.ldk ? g.ldk : g.K;
    unsigned voffA[2], voffB[2];
#pragma unroll
    for (int i = 0; i < 2; ++i) { int R, C; stage_rc(tid * 16 + i * 8192, R, C); const int Rb = Epi::PERM ? ((R & ~31) + perm32(R & 31)) : R;
        const int Ra = Epi::ROWPERM ? ((R & 64) | ((R & 15) << 2) | ((R >> 4) & 3)) : R;
        voffA[i] = (unsigned)(Ra * ldk + C) * 2u; voffB[i] = (unsigned)(Rb * ldk + C) * 2u; }
    const size_t kstep = (size_t)(BK * 2);
    const size_t hstep = (size_t)HALF * ldk * 2;
    const size_t tstep = 2 * hstep;
    const unsigned ldsw = (unsigned)wid * 1024u;
    const int aoff = lds_byte(wr * 64 + fr, fq * 8), boff = lds_byte(wc * 32 + fr, fq * 8);
#define PG8_SA(b, h) (((b) * 2 + (h)) * HTB)
#define PG8_SB(b, h) ((4 + (b) * 2 + (h)) * HTB)
#define PG8_STAGE(bufoff, gbase, voff) do { _Pragma("unroll") for (int _i = 0; _i < 2; ++_i) \
        __builtin_amdgcn_global_load_lds((const unsigned*)((const char*)(gbase) + (voff)[_i]), (PG8_LAS unsigned*)(lds + (bufoff) + ldsw + _i * 8192), 16, 0, 0); } while (0)
#define PG8_LDA(dst, b, h) do { _Pragma("unroll") for (int m = 0; m < 4; ++m) _Pragma("unroll") for (int k = 0; k < 2; ++k) dst[m][k] = *(const PG8_LAS bf16x8*)(lds + PG8_SA(b, h) + aoff + m * 2048 + k * 1024); } while (0)
#define PG8_LDB(dst, b, h) do { _Pragma("unroll") for (int n = 0; n < 2; ++n) _Pragma("unroll") for (int k = 0; k < 2; ++k) dst[n][k] = *(const PG8_LAS bf16x8*)(lds + PG8_SB(b, h) + boff + n * 2048 + k * 1024); } while (0)
#define PG8_MMA(ai, bj, At, Bt) do { __builtin_amdgcn_s_setprio(1); _Pragma("unroll") for (int m = 0; m < 4; ++m) _Pragma("unroll") for (int n = 0; n < 2; ++n) _Pragma("unroll") for (int k = 0; k < 2; ++k) \
        acc[ai][bj][m][n] = __builtin_amdgcn_mfma_f32_16x16x32_bf16(Bt[n][k], At[m][k], acc[ai][bj][m][n], 0, 0, 0); __builtin_amdgcn_s_setprio(0); } while (0)
#define PG8_WAIT_V(n) asm volatile("s_waitcnt vmcnt(" #n ")" ::: "memory")
#define PG8_WAIT_L(n) asm volatile("s_waitcnt lgkmcnt(" #n ")" ::: "memory")
#define PG8_BAR __builtin_amdgcn_s_barrier()
#define PG8_SCHED __builtin_amdgcn_sched_barrier(0)
    Unit cur, nxt; int ui = 0;
    if (!S.next(0, cur)) return;
    f32x4 acc[2][2][4][2];
#pragma unroll
    for (int a = 0; a < 2; ++a)
#pragma unroll
        for (int b = 0; b < 2; ++b)
#pragma unroll
            for (int m = 0; m < 4; ++m)
#pragma unroll
                for (int n = 0; n < 2; ++n) acc[a][b][m][n] = (f32x4){0.f, 0.f, 0.f, 0.f};
    bf16x8 At[4][2], B0[2][2], B1[2][2];
    const size_t khstep = (size_t)K * 2;
    const char* cA = (const char*)g.A + (size_t)cur.pm * tstep + cur.kh * khstep; const char* cB = (const char*)g.Bt + (size_t)cur.pn * tstep + cur.kh * khstep;
    S.a_ready(cur);
    if constexpr (SP2) {
        PG8_STAGE(PG8_SB(0, 0), cB, voffB); PG8_STAGE(PG8_SB(0, 1), cB + hstep, voffB); PG8_STAGE(PG8_SA(0, 0), cA, voffA); PG8_STAGE(PG8_SA(0, 1), cA + hstep, voffA);
        if (wr == 1) PG8_BAR;
        PG8_WAIT_V(2); PG8_BAR;
        PG8_STAGE(PG8_SB(1, 0), cB + kstep, voffB); PG8_STAGE(PG8_SA(1, 0), cA + kstep, voffA); PG8_STAGE(PG8_SB(1, 1), cB + hstep + kstep, voffB);
        PG8_WAIT_V(6); PG8_BAR;
    } else {
        PG8_STAGE(PG8_SB(0, 0), cB, voffB); PG8_STAGE(PG8_SA(0, 0), cA, voffA); PG8_STAGE(PG8_SB(0, 1), cB + hstep, voffB); PG8_STAGE(PG8_SA(0, 1), cA + hstep, voffA);
        if (wr == 1) PG8_BAR;
        PG8_WAIT_V(4); PG8_BAR;
        PG8_STAGE(PG8_SB(1, 0), cB + kstep, voffB); PG8_STAGE(PG8_SA(1, 0), cA + kstep, voffA); PG8_STAGE(PG8_SB(1, 1), cB + hstep + kstep, voffB);
        PG8_WAIT_V(6); PG8_BAR;
    }
    for (;;) {
        const bool has_next = S.next(ui + 1, nxt);
        const char* nA = has_next ? (const char*)g.A + (size_t)nxt.pm * tstep + nxt.kh * khstep : cA; const char* nB = has_next ? (const char*)g.Bt + (size_t)nxt.pn * tstep + nxt.kh * khstep : cB;
        for (int t = 0; t < nt; t += 2) {
            const bool last = (t == nt - 2);
            const char* a1 = cA + (size_t)(t + 1) * kstep;
            const char* a2 = last ? nA : cA + (size_t)(t + 2) * kstep; const char* b2 = last ? nB : cB + (size_t)(t + 2) * kstep;
            const char* a3 = a2 + kstep; const char* b3 = b2 + kstep;
            if (last && has_next) S.a_ready(nxt);
            if constexpr (SP2) {
            PG8_LDB(B0, 0, 0); PG8_LDB(B1, 0, 1); PG8_SCHED; PG8_LDA(At, 0, 0); PG8_STAGE(PG8_SA(1, 1), a1 + hstep, voffA);
            PG8_WAIT_V(8); PG8_WAIT_L(0); PG8_BAR; PG8_MMA(0, 0, At, B0); PG8_MMA(0, 1, At, B1); PG8_BAR; PG8_SCHED;
            PG8_LDA(At, 0, 1); PG8_STAGE(PG8_SB(0, 0), b2, voffB); PG8_STAGE(PG8_SB(0, 1), b2 + hstep, voffB); PG8_STAGE(PG8_SA(0, 0), a2, voffA);
            PG8_WAIT_V(8); PG8_WAIT_L(0); PG8_BAR; PG8_MMA(1, 0, At, B0); PG8_MMA(1, 1, At, B1); PG8_BAR; PG8_SCHED;
            PG8_LDB(B0, 1, 0); PG8_LDB(B1, 1, 1); PG8_SCHED; PG8_LDA(At, 1, 0); PG8_STAGE(PG8_SA(0, 1), a2 + hstep, voffA);
            PG8_WAIT_V(8); PG8_WAIT_L(0); PG8_BAR; PG8_MMA(0, 0, At, B0); PG8_MMA(0, 1, At, B1); PG8_BAR; PG8_SCHED;
            PG8_LDA(At, 1, 1); PG8_STAGE(PG8_SB(1, 0), b3, voffB); PG8_STAGE(PG8_SB(1, 1), b3 + hstep, voffB); PG8_STAGE(PG8_SA(1, 0), a3, voffA);
            PG8_WAIT_V(8); PG8_WAIT_L(0); PG8_BAR; PG8_MMA(1, 0, At, B0); PG8_MMA(1, 1, At, B1); PG8_BAR; PG8_SCHED;
            } else {
            PG8_LDB(B0, 0, 0); PG8_SCHED; PG8_LDA(At, 0, 0); PG8_STAGE(PG8_SA(1, 1), a1 + hstep, voffA);
            PG8_WAIT_L(8); PG8_BAR; PG8_WAIT_L(0); PG8_MMA(0, 0, At, B0); PG8_BAR; PG8_SCHED;
            PG8_LDB(B1, 0, 1); PG8_STAGE(PG8_SB(0, 0), b2, voffB);
            PG8_BAR; PG8_WAIT_L(0); PG8_MMA(0, 1, At, B1); PG8_BAR;
            PG8_LDA(At, 0, 1); PG8_STAGE(PG8_SA(0, 0), a2, voffA);
            PG8_BAR; PG8_WAIT_L(0); PG8_MMA(1, 0, At, B0); PG8_BAR; PG8_SCHED;
            PG8_STAGE(PG8_SB(0, 1), b2 + hstep, voffB);
            PG8_WAIT_V(6); PG8_BAR; PG8_MMA(1, 1, At, B1); PG8_BAR;
            PG8_LDB(B0, 1, 0); PG8_SCHED; PG8_LDA(At, 1, 0); PG8_STAGE(PG8_SA(0, 1), a2 + hstep, voffA);
            PG8_WAIT_L(8); PG8_BAR; PG8_WAIT_L(0); PG8_MMA(0, 0, At, B0); PG8_BAR; PG8_SCHED;
            PG8_LDB(B1, 1, 1); PG8_STAGE(PG8_SB(1, 0), b3, voffB);
            PG8_BAR; PG8_WAIT_L(0); PG8_MMA(0, 1, At, B1); PG8_BAR;
            PG8_LDA(At, 1, 1); PG8_STAGE(PG8_SA(1, 0), a3, voffA);
            PG8_BAR; PG8_WAIT_L(0); PG8_MMA(1, 0, At, B0); PG8_BAR; PG8_SCHED;
            PG8_STAGE(PG8_SB(1, 1), b3 + hstep, voffB);
            PG8_WAIT_V(6); PG8_BAR; PG8_MMA(1, 1, At, B1); PG8_BAR;
            }
        }
        if constexpr (ALIGN_EPI) { if (wr == 0) PG8_BAR; }
        if constexpr (!Epi::AFTER_DRAIN) { E(acc, cur, wr, wc, fr, fq); S.done(cur); }
        if (!has_next) break;
        if (nxt.kh == 0)
#pragma unroll
        for (int a = 0; a < 2; ++a)
#pragma unroll
            for (int b = 0; b < 2; ++b)
#pragma unroll
                for (int m = 0; m < 4; ++m)
#pragma unroll
                    for (int n = 0; n < 2; ++n) acc[a][b][m][n] = (f32x4){0.f, 0.f, 0.f, 0.f};
        cur = nxt; cA = nA; cB = nB; ++ui;
        if constexpr (ALIGN_EPI) { if (wr == 1) PG8_BAR; }
    }
    PG8_WAIT_V(0);
    if constexpr (!ALIGN_EPI) { if (wr == 0) PG8_BAR; }
    PG8_BAR;
    if constexpr (Epi::AFTER_DRAIN) { E.fused(acc, cur, wr, wc, fr, fq, lds, wid, lane); S.done(cur); }
#undef PG8_SA
#undef PG8_SB
#undef PG8_STAGE
#undef PG8_LDA
#undef PG8_LDB
#undef PG8_MMA
#undef PG8_WAIT_V
#undef PG8_WAIT_L
#undef PG8_BAR
#undef PG8_SCHED
}
}

#define LAS __attribute__((address_space(3)))
typedef unsigned short bf16_t;
typedef short bf16x8 __attribute__((ext_vector_type(8)));
typedef float f32x4 __attribute__((ext_vector_type(4)));
typedef float f32x16 __attribute__((ext_vector_type(16)));
typedef unsigned u32x4 __attribute__((ext_vector_type(4)));
typedef unsigned u32x2 __attribute__((ext_vector_type(2)));

constexpr int T = 32768, DM = 1024, SEQ = 4096;
constexpr int NMOD = 6144, NPROJ = 5120, DFF = 2816, NUP = 5632;
constexpr int NTHR = 512;
constexpr size_t MiB = 1u << 20;
constexpr size_t SLAB = 32 * MiB;
constexpr size_t SLAB_EL = (size_t)T * 512;
constexpr size_t WS_BAR = 512 * 1024;
constexpr size_t WS_MOD = 0, WS_LB = 256 * 1024, WS_G = 1 * MiB, WS_RSQ = 2 * MiB, WS_RSKV = 3 * MiB;
constexpr size_t WS_WIN = 4 * MiB, WS_WUQ = 14 * MiB, WS_WUKV = 15 * MiB, WS_WA = 16 * MiB, WS_WB = 17 * MiB, WS_WOUT = 18 * MiB, WS_WUP = 20 * MiB, WS_WDOWN = 31 * MiB;
__host__ __device__ constexpr size_t SL(int i) { return (size_t)i * SLAB; }
constexpr size_t WS_UH = SL(2);
constexpr size_t WS_ACT = SL(2) + 192 * MiB;
constexpr size_t WS_NEED = 512 * MiB;
constexpr int LDS_BYTES = 147456;
constexpr int NPHASE = 17;

__device__ __forceinline__ float bf2f(unsigned short v) { return __uint_as_float((unsigned)v << 16); }
__device__ __forceinline__ float bflo(unsigned w) { return __uint_as_float(w << 16); }
__device__ __forceinline__ float bfhi(unsigned w) { return __uint_as_float(w & 0xffff0000u); }
typedef float f32x2_t __attribute__((ext_vector_type(2))); typedef __bf16 bf16x2_t __attribute__((ext_vector_type(2)));
__device__ __forceinline__ unsigned pk2(float lo, float hi) { f32x2_t v = {lo, hi}; bf16x2_t b = __builtin_convertvector(v, bf16x2_t); return __builtin_bit_cast(unsigned, b); }
__device__ __forceinline__ unsigned short f2bf(float f) { return (unsigned short)(pk2(f, 0.f) & 0xffffu); }
__device__ __forceinline__ float wave_sum(float v) {
#pragma unroll
    for (int o = 1; o < 64; o <<= 1) v += __shfl_xor(v, o);
    return v;
}
__device__ __forceinline__ float sigmoidf_(float x) { return __builtin_amdgcn_rcpf(1.0f + __expf(-x)); }
#define MFMA16(a, b, c) __builtin_amdgcn_mfma_f32_16x16x32_bf16((a), (b), (c), 0, 0, 0)
#define MFMA32(a, b, c) __builtin_amdgcn_mfma_f32_32x32x16_bf16((a), (b), (c), 0, 0, 0)

struct Args { const float* in[23]; float* out; unsigned char* ws; float invf[16]; int ph_lo, ph_hi; };

__device__ __forceinline__ int srccol(int mapid, int nd) {
    if (mapid == 0) return nd;
    if (mapid == 1) { if (nd < 800) return nd; if (nd < 1024) return -1; return nd - 224; }
    if (mapid == 3) return (nd >> 6) * 128 + (nd & 63);
    if (mapid == 4) return (nd >> 6) * 128 + 64 + (nd & 63);
    const int pn = nd >> 8, j = nd & 255; return (j < 128) ? (128 * pn + j) : (DFF + 128 * pn + (j - 128));
}
__device__ __forceinline__ void wt_item(const float* W, int K, int Nsrc, bf16_t* WT, int mapid, int item, int nblk, LAS unsigned short* tile, int ldk = 0, int kofs = 0, const float* kgain = nullptr) {
    if (ldk == 0) ldk = K;
    const int kb = item / nblk, nb = item % nblk, k0 = kb * 64, n0 = nb * 64;
    const int tid = threadIdx.x, n = tid & 63, kq = tid >> 6;
    const int sc = srccol(mapid, n0 + n);
#pragma unroll
    for (int i = 0; i < 8; ++i) { const int k = i * 8 + kq; float v = (sc >= 0) ? W[(size_t)(k0 + k) * Nsrc + sc] : 0.f; if (kgain) v *= kgain[k0 + k]; tile[n * 66 + k] = f2bf(v); }
    __syncthreads();
    { const int nn = tid >> 3, kc = tid & 7; const LAS unsigned* tp = (const LAS unsigned*)(tile + nn * 66 + kc * 8);
      u32x4 w; w[0] = tp[0]; w[1] = tp[1]; w[2] = tp[2]; w[3] = tp[3];
      *(u32x4*)(WT + (size_t)(n0 + nn) * ldk + kofs + k0 + kc * 8) = w; }
    __syncthreads();
}
__device__ __forceinline__ void p0_phase(const Args& a, LAS unsigned char* lds, int bid, int G) {
    unsigned char* ws = a.ws;
    const int tid = threadIdx.x, lane = tid & 63, wid = tid >> 6;
    for (int cgp = bid; cgp < 96; cgp += G) {
        LAS float* red = (LAS float*)lds;
        const float* c = a.in[1]; const float* w = a.in[3]; const int n = cgp * 64 + lane;
        float acc[8];
#pragma unroll
        for (int b = 0; b < 8; ++b) acc[b] = 0.f;
        for (int k = wid * 128; k < wid * 128 + 128; ++k) { const float wv = w[(size_t)k * NMOD + n];
#pragma unroll
            for (int b = 0; b < 8; ++b) acc[b] += c[b * DM + k] * wv; }
#pragma unroll
        for (int b = 0; b < 8; ++b) red[(wid * 8 + b) * 64 + lane] = acc[b];
        __syncthreads();
        { const int b = wid; float s = 0.f;
#pragma unroll
          for (int w8 = 0; w8 < 8; ++w8) s += red[(w8 * 8 + b) * 64 + lane];
          ((float*)(ws + WS_MOD))[b * NMOD + n] = s + a.in[4][n]; }
        __syncthreads();
    }
    for (int i = bid * NTHR + tid; i < T; i += G * NTHR) { ((float*)(ws + WS_RSQ))[i] = 0.f; ((float*)(ws + WS_RSKV))[i] = 0.f; }
    if (bid == (96 % G)) { const float* t = a.in[13]; ((float*)(ws + WS_LB))[tid] = 1.0f / (1.0f + expf(t[tid] - t[512 + tid])); }
    LAS unsigned short* tile = (LAS unsigned short*)lds;
    constexpr int I0 = 16 * 80, I1 = 8 * 12, I2 = 4 * 8, I2b = 4 * 8, I3 = 8 * 16, I4 = 8 * 16, I5 = 16 * 16, I6 = 16 * 88, I7 = 44 * 16;
    constexpr int NIT = I0 + I1 + I2 + I2b + I3 + I4 + I5 + I6 + I7;
    for (int it = bid; it < NIT; it += G) {
        int r = it;
        if (r < I0) { wt_item(a.in[6], 1024, 4896, (bf16_t*)(ws + WS_WIN), 1, r, 80, tile); continue; } r -= I0;
        if (r < I1) { wt_item(a.in[8], 512, 768, (bf16_t*)(ws + WS_WUQ), 0, r, 12, tile, 0, 0, a.in[7]); continue; } r -= I1;
        if (r < I2) { wt_item(a.in[10], 256, 1024, (bf16_t*)(ws + WS_WUKV), 3, r, 8, tile, 512, 0, a.in[9]); continue; } r -= I2;
        if (r < I2b) { wt_item(a.in[10], 256, 1024, (bf16_t*)(ws + WS_WUKV + 512 * 1024), 4, r, 8, tile, 512, 0, a.in[9]); continue; } r -= I2b;
        if (r < I3) { wt_item(a.in[15], 512, 1024, (bf16_t*)(ws + WS_WA), 0, r, 16, tile, 1024, 0); continue; } r -= I3;
        if (r < I4) { wt_item(a.in[16], 512, 1024, (bf16_t*)(ws + WS_WA), 0, r, 16, tile, 1024, 512); continue; } r -= I4;
        if (r < I5) { wt_item(a.in[17], 1024, 1024, (bf16_t*)(ws + WS_WOUT), 0, r, 16, tile); continue; } r -= I5;
        if (r < I6) { wt_item(a.in[19], 1024, NUP, (bf16_t*)(ws + WS_WUP), 2, r, 88, tile); continue; } r -= I6;
        wt_item(a.in[22], DFF, 1024, (bf16_t*)(ws + WS_WDOWN), 0, r, 16, tile);
    }
}

template <bool IN_BF16> __device__ __forceinline__ void adaln_phase(const void* xin_, const float* g, const float* mod, int shift_off, int scale_off, bf16_t* out, int bid, int G) {
    const int lane = threadIdx.x & 63, wid = threadIdx.x >> 6;
    const int gw = bid * 8 + wid, NGW = G * 8;
    for (int m0 = 2 * gw; m0 < T; m0 += 2 * NGW) {
        f32x4 v[2][4]; float s[2] = {0.f, 0.f};
#pragma unroll
        for (int r = 0; r < 2; ++r) {
            if (IN_BF16) { const u32x2* xr = (const u32x2*)((const bf16_t*)xin_ + (size_t)(m0 + r) * DM) + lane;
#pragma unroll
                for (int j = 0; j < 4; ++j) { const u32x2 w = __builtin_nontemporal_load(&xr[64 * j]); v[r][j] = (f32x4){bflo(w[0]), bfhi(w[0]), bflo(w[1]), bfhi(w[1])}; } }
            else { const f32x4* xr = (const f32x4*)((const float*)xin_ + (size_t)(m0 + r) * DM) + lane;
#pragma unroll
                for (int j = 0; j < 4; ++j) v[r][j] = __builtin_nontemporal_load(&xr[64 * j]); } }
        const float* mb = mod + (m0 >> 12) * NMOD;
        f32x4 ga[4], sh[4];
#pragma unroll
        for (int j = 0; j < 4; ++j) { const int col = 4 * lane + 256 * j; const f32x4 gg = *(const f32x4*)(g + col), sc = *(const f32x4*)(mb + scale_off + col); sh[j] = *(const f32x4*)(mb + shift_off + col);
#pragma unroll
            for (int e = 0; e < 4; ++e) ga[j][e] = gg[e] * (1.0f + sc[e]); }
#pragma unroll
        for (int r = 0; r < 2; ++r)
#pragma unroll
            for (int j = 0; j < 4; ++j) s[r] += (v[r][j][0] * v[r][j][0] + v[r][j][1] * v[r][j][1]) + (v[r][j][2] * v[r][j][2] + v[r][j][3] * v[r][j][3]);
#pragma unroll
        for (int o = 1; o < 64; o <<= 1) { s[0] += __shfl_xor(s[0], o); s[1] += __shfl_xor(s[1], o); }
#pragma unroll
        for (int r = 0; r < 2; ++r) { const float rstd = rsqrtf(s[r] * (1.f / DM) + 1e-6f);
            u32x2* o8 = (u32x2*)(out + (size_t)(m0 + r) * DM) + lane;
#pragma unroll
            for (int j = 0; j < 4; ++j) { f32x4 h;
#pragma unroll
                for (int e = 0; e < 4; ++e) h[e] = v[r][j][e] * rstd * ga[j][e] + sh[j][e];
                u32x2 w; w[0] = pk2(h[0], h[1]); w[1] = pk2(h[2], h[3]); o8[64 * j] = w; } }
    }
}

__device__ __forceinline__ void lora_norm_phase(const Args& a, int bid, int G) {
    unsigned char* ws = a.ws;
    const bf16_t* cq = (const bf16_t*)(ws + SL(4)); const bf16_t* ckv = (const bf16_t*)(ws + SL(5));
    float* rsq = (float*)(ws + WS_RSQ); float* rskv = (float*)(ws + WS_RSKV);
    const int lane = threadIdx.x & 63, wid = threadIdx.x >> 6;
    const int gw = bid * 8 + wid, NGW = G * 8;
#pragma unroll 4
    for (int m = gw; m < T; m += NGW) {
        const u32x4 w = *(const u32x4*)(cq + (size_t)m * 512 + 8 * lane);
        u32x4 w2 = {0u, 0u, 0u, 0u};
        if (lane < 32) w2 = *(const u32x4*)(ckv + (size_t)m * 512 + 8 * lane);
        float s = 0.f, s2 = 0.f;
#pragma unroll
        for (int e = 0; e < 4; ++e) { const float v0 = bflo(w[e]), v1 = bfhi(w[e]), u0 = bflo(w2[e]), u1 = bfhi(w2[e]); s += v0 * v0 + v1 * v1; s2 += u0 * u0 + u1 * u1; }
#pragma unroll
        for (int o = 1; o < 64; o <<= 1) { s += __shfl_xor(s, o); s2 += __shfl_xor(s2, o); }
        if (lane == 0) { rsq[m] = rsqrtf(s * (1.f / 512.f) + 1e-6f); rskv[m] = rsqrtf(s2 * (1.f / 256.f) + 1e-6f); }
    }
}

__device__ __forceinline__ void h1_phase(const bf16_t* hq, const bf16_t* hf, const bf16_t* hi, bf16_t* qe_out, bf16_t* intra_out, const float* lb, bf16_t* Ub, float* G, LAS unsigned char* lds, int bid, int Gn) {
    LAS bf16_t* QA = (LAS bf16_t*)lds;
    LAS bf16_t* KD = QA + 4 * 64 * 136;
    LAS bf16_t* KET = KD + 64 * 136;
    LAS bf16_t* VT = KET + 128 * 72;
    LAS bf16_t* AT = VT + 128 * 72;
    LAS float* TOT = (LAS float*)(AT + 64 * 72);
    LAS bf16_t* ST = QA;
    const int tid = threadIdx.x, lane = tid & 63, wid = __builtin_amdgcn_readfirstlane(tid >> 6);
    const int k = tid & 127, I = __builtin_amdgcn_readfirstlane(tid >> 7);
    u32x4 pf[2][3];
#define H1_LOAD(uu) do { const int b_ = (uu) >> 8, h_ = ((uu) >> 6) & 3, c_ = (uu) & 63; _Pragma("unroll") for (int i = 0; i < 2; ++i) { const int id = tid + NTHR * i, row = id >> 4, cc = id & 15; \
        const size_t go = (size_t)(b_ * SEQ + c_ * 64 + row) * 512 + h_ * 128 + cc * 8; pf[i][0] = *(const u32x4*)(hq + go); pf[i][1] = *(const u32x4*)(hf + go); pf[i][2] = *(const u32x4*)(hi + go); } } while (0)
    if (bid < 2048) H1_LOAD(bid);
    for (int u = bid; u < 2048; u += Gn) {
    const int b = u >> 8, h = (u >> 6) & 3, c = u & 63, t0 = b * SEQ + c * 64, cb = h * 128;
#pragma unroll
    for (int i = 0; i < 2; ++i) { const int id = tid + NTHR * i, row = id >> 4, cc = id & 15;
        *(LAS u32x4*)(ST + row * 128 + cc * 8) = pf[i][0]; *(LAS u32x4*)(ST + 8192 + row * 128 + cc * 8) = pf[i][1]; *(LAS u32x4*)(ST + 16384 + row * 128 + cc * 8) = pf[i][2]; }
    __syncthreads();
    if (u + Gn < 2048) H1_LOAD(u + Gn);
    float q[16], kk[16], pc[16]; unsigned short vv[16];
    const float lbk = lb[cb + k]; float run = 1.0f;
#pragma unroll
    for (int i = 0; i < 16; ++i) {
        const float xq = bf2f(ST[(16 * I + i) * 128 + k]), xf = bf2f(ST[8192 + (16 * I + i) * 128 + k]); vv[i] = ST[16384 + (16 * I + i) * 128 + k];
        const float f = lbk + (1.0f - lbk) * sigmoidf_(xf);
        run *= f; pc[i] = run; kk[i] = 1.0f - f; q[i] = xq * sigmoidf_(xq);
    }
    TOT[I * 128 + k] = run;
    for (int j = tid; j < 64 * 72 / 2; j += NTHR) ((LAS unsigned*)AT)[j] = 0u;
    __syncthreads();
    const float tp0 = TOT[k], tp1 = TOT[128 + k], tp2 = TOT[256 + k], tp3 = TOT[384 + k];
    const float ej2 = (I > 2 ? tp2 : 1.f), ej1 = (I > 1 ? tp1 : 1.f) * ej2, ej0 = (I > 0 ? tp0 : 1.f) * ej1;
    const float suf = (I <= 0 ? tp0 : 1.f) * (I <= 1 ? tp1 : 1.f) * (I <= 2 ? tp2 : 1.f) * tp3;
    unsigned kw[8], vw[8];
#pragma unroll
    for (int i = 0; i < 16; ++i) {
        const int s = 16 * I + i;
        const float rp = __builtin_amdgcn_rcpf(pc[i]), qp = q[i] * pc[i];
        KD[s * 136 + k] = f2bf(kk[i] * rp);
        QA[(0 * 64 + s) * 136 + k] = f2bf(qp * ej0);
        if (I >= 1) QA[(1 * 64 + s) * 136 + k] = f2bf(qp * ej1);
        if (I >= 2) QA[(2 * 64 + s) * 136 + k] = f2bf(qp * ej2);
        if (I >= 3) QA[(3 * 64 + s) * 136 + k] = f2bf(qp);
        const float ke = kk[i] * (suf * rp);
        if (i & 1) { kw[i >> 1] |= (unsigned)f2bf(ke) << 16; vw[i >> 1] |= (unsigned)vv[i] << 16; } else { kw[i >> 1] = f2bf(ke); vw[i >> 1] = vv[i]; }
    }
    { LAS u32x4* kp = (LAS u32x4*)(KET + k * 72 + 16 * I); kp[0] = (u32x4){kw[0], kw[1], kw[2], kw[3]}; kp[1] = (u32x4){kw[4], kw[5], kw[6], kw[7]};
      LAS u32x4* vp = (LAS u32x4*)(VT + k * 72 + 16 * I); vp[0] = (u32x4){vw[0], vw[1], vw[2], vw[3]}; vp[1] = (u32x4){vw[4], vw[5], vw[6], vw[7]}; }
    if (I == 0) G[(size_t)u * 128 + k] = (tp0 * tp1) * (tp2 * tp3);
    __syncthreads();
    const int l15 = lane & 15, l4 = lane >> 4;
#pragma unroll
    for (int i = 0; i < 2; ++i) { const int id = tid + NTHR * i, row = id >> 4, cc = id & 15;
        *(u32x4*)(qe_out + (size_t)(t0 + row) * 512 + cb + cc * 8) = *(const LAS u32x4*)(QA + row * 136 + cc * 8); }
    for (int blk = wid; blk < 10; blk += 8) {
        const int Ip = (blk >= 6) ? 3 : (blk >= 3) ? 2 : (blk >= 1) ? 1 : 0, J = blk - Ip * (Ip + 1) / 2;
        f32x4 acc = {0.f, 0.f, 0.f, 0.f};
#pragma unroll
        for (int ks = 0; ks < 4; ++ks) {
            const bf16x8 x = *(const LAS bf16x8*)(QA + (J * 64 + 16 * Ip + l15) * 136 + 32 * ks + 8 * l4);
            const bf16x8 y = *(const LAS bf16x8*)(KD + (16 * J + l15) * 136 + 32 * ks + 8 * l4);
            acc = MFMA16(x, y, acc);
        }
#pragma unroll
        for (int ii = 0; ii < 4; ++ii) { const int tl = 4 * l4 + ii; const float val = (Ip == J && l15 > tl) ? 0.f : acc[ii]; AT[(16 * Ip + tl) * 72 + 16 * J + l15] = f2bf(val); }
    }
    __syncthreads();
    { const int tb = wid & 3, vb0 = (wid >> 2) * 4;
      const bf16x8 x0 = *(const LAS bf16x8*)(AT + (16 * tb + l15) * 72 + 8 * l4), x1 = *(const LAS bf16x8*)(AT + (16 * tb + l15) * 72 + 32 + 8 * l4);
#pragma unroll
      for (int j = 0; j < 4; ++j) { const int vb = vb0 + j;
          const bf16x8 y0 = *(const LAS bf16x8*)(VT + (16 * vb + l15) * 72 + 8 * l4), y1 = *(const LAS bf16x8*)(VT + (16 * vb + l15) * 72 + 32 + 8 * l4);
          f32x4 acc = {0.f, 0.f, 0.f, 0.f}; acc = MFMA16(y0, x0, acc); acc = MFMA16(y1, x1, acc);
          u32x2 w; w[0] = pk2(acc[0], acc[1]); w[1] = pk2(acc[2], acc[3]);
          *(u32x2*)(intra_out + (size_t)(t0 + 16 * tb + l15) * 512 + cb + 16 * vb + 4 * l4) = w; } }
    { const int kb = wid;
      const bf16x8 x0 = *(const LAS bf16x8*)(KET + (16 * kb + l15) * 72 + 8 * l4), x1 = *(const LAS bf16x8*)(KET + (16 * kb + l15) * 72 + 32 + 8 * l4);
#pragma unroll
      for (int vb = 0; vb < 8; ++vb) {
          const bf16x8 y0 = *(const LAS bf16x8*)(VT + (16 * vb + l15) * 72 + 8 * l4), y1 = *(const LAS bf16x8*)(VT + (16 * vb + l15) * 72 + 32 + 8 * l4);
          f32x4 acc = {0.f, 0.f, 0.f, 0.f}; acc = MFMA16(x0, y0, acc); acc = MFMA16(x1, y1, acc);
          u32x2 w; w[0] = pk2(acc[0], acc[1]); w[1] = pk2(acc[2], acc[3]);
          *(u32x2*)(Ub + (size_t)u * 16384 + (16 * vb + l15) * 128 + 16 * kb + 4 * l4) = w; } }
    __syncthreads();
    }
#undef H1_LOAD
}

__device__ __forceinline__ void h2_phase(bf16_t* Ub, const float* __restrict__ G, int bid, int Gn) {
    const int gt = bid * NTHR + threadIdx.x, NT_ = Gn * NTHR;
    for (int e4 = gt; e4 < 131072; e4 += NT_) {
        const int bh = e4 >> 12, e = (e4 & 4095) * 4, k = e & 127;
        bf16_t* p = Ub + (size_t)bh * 64 * 16384 + e; const float* gp = G + (size_t)bh * 64 * 128 + k;
        float s0 = 0.f, s1 = 0.f, s2 = 0.f, s3 = 0.f;
#pragma unroll 1
        for (int c0 = 0; c0 < 64; c0 += 16) {
            u32x2 uv[16]; f32x4 g[16];
#pragma unroll
            for (int j = 0; j < 16; ++j) { uv[j] = *(const u32x2*)(p + (size_t)(c0 + j) * 16384); g[j] = *(const f32x4*)(gp + (c0 + j) * 128); }
#pragma unroll
            for (int j = 0; j < 16; ++j) {
                u32x2 w; w[0] = pk2(s0, s1); w[1] = pk2(s2, s3); *(u32x2*)(p + (size_t)(c0 + j) * 16384) = w;
                s0 = g[j][0] * s0 + bflo(uv[j][0]); s1 = g[j][1] * s1 + bfhi(uv[j][0]); s2 = g[j][2] * s2 + bflo(uv[j][1]); s3 = g[j][3] * s3 + bfhi(uv[j][1]);
            }
        }
    }
}

__device__ __forceinline__ void h3_unit(int j, const bf16_t* qe, const bf16_t* intra, const bf16_t* Ub, const bf16_t* hg, const float* gn, bf16_t* out) {
    const int tid = threadIdx.x, lane = tid & 63, wid = __builtin_amdgcn_readfirstlane(tid >> 6), l15 = lane & 15, l4 = lane >> 4;
    const int b = j >> 6, c = j & 63, t0 = b * SEQ + c * 64;
#pragma unroll 1
    for (int cc = 0; cc < 2; ++cc) {
        const int combo = 2 * wid + cc, head = combo >> 2, tb = combo & 3, u = (b * 4 + head) * 64 + c;
        const size_t rbase = (size_t)(t0 + 16 * tb + l15) * 512 + head * 128;
        bf16x8 x[4];
#pragma unroll
        for (int ks = 0; ks < 4; ++ks) x[ks] = *(const bf16x8*)(qe + rbase + 8 * l4 + 32 * ks);
        u32x2 iv[8], gv[8];
#pragma unroll
        for (int vb = 0; vb < 8; ++vb) { iv[vb] = __builtin_nontemporal_load((const u32x2*)(intra + rbase + 16 * vb + 4 * l4)); gv[vb] = __builtin_nontemporal_load((const u32x2*)(hg + rbase + 16 * vb + 4 * l4)); }
        const bf16_t* ub = Ub + (size_t)u * 16384 + l15 * 128 + 8 * l4;
        f32x4 acc[8];
#pragma unroll
        for (int vb = 0; vb < 8; ++vb) { acc[vb] = (f32x4){0.f, 0.f, 0.f, 0.f};
#pragma unroll
            for (int ks = 0; ks < 4; ++ks) { const bf16x8 y = *(const bf16x8*)(ub + vb * 2048 + 32 * ks); acc[vb] = MFMA16(y, x[ks], acc[vb]); } }
        float ss = 0.f;
#pragma unroll
        for (int vb = 0; vb < 8; ++vb) { acc[vb][0] += bflo(iv[vb][0]); acc[vb][1] += bfhi(iv[vb][0]); acc[vb][2] += bflo(iv[vb][1]); acc[vb][3] += bfhi(iv[vb][1]);
            ss += (acc[vb][0] * acc[vb][0] + acc[vb][1] * acc[vb][1]) + (acc[vb][2] * acc[vb][2] + acc[vb][3] * acc[vb][3]); }
        ss += __shfl_xor(ss, 16); ss += __shfl_xor(ss, 32);
        const float rstd = rsqrtf(ss * (1.f / 128.f) + 1e-6f);
#pragma unroll
        for (int vb = 0; vb < 8; ++vb) { const f32x4 gnv = *(const f32x4*)(gn + 16 * vb + 4 * l4);
            const float g0 = bflo(gv[vb][0]), g1 = bfhi(gv[vb][0]), g2 = bflo(gv[vb][1]), g3 = bfhi(gv[vb][1]);
            u32x2 w; w[0] = pk2(acc[vb][0] * rstd * gnv[0] * (g0 * sigmoidf_(g0)), acc[vb][1] * rstd * gnv[1] * (g1 * sigmoidf_(g1)));
            w[1] = pk2(acc[vb][2] * rstd * gnv[2] * (g2 * sigmoidf_(g2)), acc[vb][3] * rstd * gnv[3] * (g3 * sigmoidf_(g3)));
            *(u32x2*)(out + (size_t)(t0 + 16 * tb + l15) * 1024 + 512 + head * 128 + 16 * vb + 4 * l4) = w; }
    }
}

__device__ __forceinline__ void qk_prep_phase(const Args& a, int bid, int G) {
    unsigned char* ws = a.ws;
    const bf16_t* qraw = (const bf16_t*)a.out; const bf16_t* knope = (const bf16_t*)(ws + SL(2)); const bf16_t* krope = (const bf16_t*)(ws + SL(5)) + 256;
    bf16_t* Q = (bf16_t*)(ws + SL(3)); bf16_t* K = (bf16_t*)((unsigned char*)a.out + 64 * MiB);
    const int* positions = (const int*)a.in[2]; const float* gq = a.in[11]; const float* gk = a.in[12];
    const int lane = threadIdx.x & 63, wid = threadIdx.x >> 6, h = lane >> 3, c = lane & 7, c3 = c & 3;
    const float QS = 0.10206207261596577f * 1.4426950408889634f;
    float gqn[8], gkn[8], gqr[4], gkr[4], invf[4];
#pragma unroll
    for (int j = 0; j < 8; ++j) { gqn[j] = gq[8 * c + j] * QS; gkn[j] = gk[8 * c + j]; }
#pragma unroll
    for (int j = 0; j < 4; ++j) { gqr[j] = gq[64 + 4 * c + j] * QS; gkr[j] = gk[64 + 4 * c + j];
        invf[j] = (c3 == 0) ? a.invf[j] : (c3 == 1) ? a.invf[4 + j] : (c3 == 2) ? a.invf[8 + j] : a.invf[12 + j]; }
    const int gw = bid * 8 + wid, NGW = G * 8;
#pragma unroll 2
    for (int m = gw; m < T; m += NGW) {
        const int b = m >> 12, s = m & 4095;
        const u32x4 qn = __builtin_nontemporal_load((const u32x4*)(qraw + (size_t)m * 768 + h * 96 + 8 * c)); const u32x2 qr = __builtin_nontemporal_load((const u32x2*)(qraw + (size_t)m * 768 + h * 96 + 64 + 4 * c));
        const u32x4 kn = __builtin_nontemporal_load((const u32x4*)(knope + (size_t)m * 512 + h * 64 + 8 * c)); const u32x2 kr = *(const u32x2*)(krope + (size_t)m * 512 + 4 * c);
        const float posf = (float)positions[m];
        float cs[4], sn[4];
#pragma unroll
        for (int j = 0; j < 4; ++j) { const float ang = posf * invf[j]; double rv = (double)ang * 0.15915494309189535; rv -= __builtin_rint(rv);
            const float fr = (float)rv; sn[j] = __builtin_amdgcn_sinf(fr); cs[j] = __builtin_amdgcn_cosf(fr); }
        size_t ob = ((size_t)(b * 8 + h) * SEQ + s) * 96;
        { float v[8], w[4]; float ss = 0.f;
#pragma unroll
          for (int e = 0; e < 4; ++e) { v[2 * e] = bflo(qn[e]); v[2 * e + 1] = bfhi(qn[e]); ss += v[2 * e] * v[2 * e] + v[2 * e + 1] * v[2 * e + 1]; }
          w[0] = bflo(qr[0]); w[1] = bfhi(qr[0]); w[2] = bflo(qr[1]); w[3] = bfhi(qr[1]); ss += (w[0] * w[0] + w[1] * w[1]) + (w[2] * w[2] + w[3] * w[3]);
          ss += __shfl_xor(ss, 1); ss += __shfl_xor(ss, 2); ss += __shfl_xor(ss, 4);
          const float rstd = rsqrtf(ss * (1.f / 96.f) + 1e-6f);
          u32x4 o; o[0] = pk2(v[0] * rstd * gqn[0], v[1] * rstd * gqn[1]); o[1] = pk2(v[2] * rstd * gqn[2], v[3] * rstd * gqn[3]);
          o[2] = pk2(v[4] * rstd * gqn[4], v[5] * rstd * gqn[5]); o[3] = pk2(v[6] * rstd * gqn[6], v[7] * rstd * gqn[7]);
          float rot[4];
#pragma unroll
          for (int j = 0; j < 4; ++j) { const float n1 = w[j] * rstd * gqr[j], pr = __shfl_xor(n1, 4); rot[j] = (c & 4) ? (n1 * cs[j] + pr * sn[j]) : (n1 * cs[j] - pr * sn[j]); }
          u32x2 o2; o2[0] = pk2(rot[0], rot[1]); o2[1] = pk2(rot[2], rot[3]);
          *(u32x4*)(Q + ob + 8 * c) = o; *(u32x2*)(Q + ob + 64 + 4 * c) = o2; }
        { float v[8], w[4]; float ss = 0.f;
#pragma unroll
          for (int e = 0; e < 4; ++e) { v[2 * e] = bflo(kn[e]); v[2 * e + 1] = bfhi(kn[e]); ss += v[2 * e] * v[2 * e] + v[2 * e + 1] * v[2 * e + 1]; }
          w[0] = bflo(kr[0]); w[1] = bfhi(kr[0]); w[2] = bflo(kr[1]); w[3] = bfhi(kr[1]); ss += (w[0] * w[0] + w[1] * w[1]) + (w[2] * w[2] + w[3] * w[3]);
          ss += __shfl_xor(ss, 1); ss += __shfl_xor(ss, 2); ss += __shfl_xor(ss, 4);
          const float rstd = rsqrtf(ss * (1.f / 96.f) + 1e-6f);
          u32x4 o; o[0] = pk2(v[0] * rstd * gkn[0], v[1] * rstd * gkn[1]); o[1] = pk2(v[2] * rstd * gkn[2], v[3] * rstd * gkn[3]);
          o[2] = pk2(v[4] * rstd * gkn[4], v[5] * rstd * gkn[5]); o[3] = pk2(v[6] * rstd * gkn[6], v[7] * rstd * gkn[7]);
          float rot[4];
#pragma unroll
          for (int j = 0; j < 4; ++j) { const float n1 = w[j] * rstd * gkr[j], pr = __shfl_xor(n1, 4); rot[j] = (c & 4) ? (n1 * cs[j] + pr * sn[j]) : (n1 * cs[j] - pr * sn[j]); }
          u32x2 o2; o2[0] = pk2(rot[0], rot[1]); o2[1] = pk2(rot[2], rot[3]);
          *(u32x4*)(K + ob + 8 * c) = o; *(u32x2*)(K + ob + 64 + 4 * c) = o2; }
    }
}

__device__ __forceinline__ int crow(int r, int hi) { return (r & 3) + 8 * (r >> 2) + 4 * hi; }
template <bool FIX> __device__ __forceinline__ void attn_unit(const bf16_t* Q, const bf16_t* K, const bf16_t* Vt, bf16_t* O, int bh, int qb, float mfix, LAS unsigned char* lds) {
    const int tid = threadIdx.x, lane = tid & 63, wid = __builtin_amdgcn_readfirstlane(tid >> 6), r = lane & 31, hh = lane >> 5;
    LAS bf16_t* Kb = (LAS bf16_t*)lds;
    LAS bf16_t* Vb = (LAS bf16_t*)(lds + 2 * 64 * 104 * 2);
    const bf16_t* Qh = Q + (size_t)bh * SEQ * 96; const bf16_t* Kh = K + (size_t)bh * SEQ * 96; const bf16_t* Vh = Vt + (size_t)(bh & 7) * 64 * T + (size_t)(bh >> 3) * SEQ;
    const int q0 = qb * 256, qw = q0 + wid * 32, NTL = 4 * (qb + 1);
    bf16x8 qf[6];
#pragma unroll
    for (int d0 = 0; d0 < 6; ++d0) qf[d0] = *(const bf16x8*)(Qh + (size_t)(qw + r) * 96 + 16 * d0 + 8 * hh);
    f32x16 o0, o1;
#pragma unroll
    for (int i = 0; i < 16; ++i) { o0[i] = 0.f; o1[i] = 0.f; }
    float mrun = -1e30f, lrun = 0.f;
    f32x16 cinit;
#pragma unroll
    for (int i = 0; i < 16; ++i) cinit[i] = FIX ? -mfix : 0.f;
    asm volatile("" : "+v"(cinit));
    const int c2 = 512 + tid, kr1 = tid / 12, kc1 = tid % 12, kr2 = c2 / 12, kc2 = c2 % 12, vr = tid >> 3, vc = tid & 7;
    u32x4 kA, kB = {0u, 0u, 0u, 0u}, vA;
#define ATT_LOADG(t) do { kA = *(const u32x4*)(Kh + (size_t)(t) * 6144 + tid * 8); if (tid < 256) kB = *(const u32x4*)(Kh + (size_t)(t) * 6144 + c2 * 8); \
        vA = *(const u32x4*)(Vh + (size_t)vr * T + 64 * (t) + vc * 8); } while (0)
#define ATT_STORE(buf) do { *(LAS u32x4*)(Kb + (buf) * 6656 + kr1 * 104 + kc1 * 8) = kA; if (tid < 256) *(LAS u32x4*)(Kb + (buf) * 6656 + kr2 * 104 + kc2 * 8) = kB; \
        *(LAS u32x2*)(Vb + (buf) * 4352 + vr * 68 + vc * 8) = (u32x2){vA[0], vA[1]}; *(LAS u32x2*)(Vb + (buf) * 4352 + vr * 68 + vc * 8 + 4) = (u32x2){vA[2], vA[3]}; } while (0)
    ATT_LOADG(0); ATT_STORE(0); __syncthreads();
    for (int t = 0; t < NTL; ++t) {
        const int buf = t & 1;
        if (t + 1 < NTL) ATT_LOADG(t + 1);
        if (64 * t <= qw + 31) {
            f32x16 s0, s1;
            const LAS bf16_t* kp = Kb + buf * 6656 + r * 104 + 8 * hh;
#pragma unroll
            for (int d0 = 0; d0 < 6; ++d0) {
                const bf16x8 a0 = *(const LAS bf16x8*)(kp + 16 * d0), a1 = *(const LAS bf16x8*)(kp + 32 * 104 + 16 * d0);
                if (d0 == 0) { s0 = MFMA32(a0, qf[0], cinit); s1 = MFMA32(a1, qf[0], cinit); }
                else { s0 = MFMA32(a0, qf[d0], s0); s1 = MFMA32(a1, qf[d0], s1); }
            }
            if (64 * t + 63 > qw) {
                const int qrow = qw + r;
#pragma unroll
                for (int i = 0; i < 16; ++i) { const int kv = 64 * t + crow(i, hh); if (kv > qrow) s0[i] = -1e30f; if (kv + 32 > qrow) s1[i] = -1e30f; }
            }
            if constexpr (FIX) {
                f32x2_t l2 = {0.f, 0.f};
#pragma unroll
                for (int i = 0; i < 16; i += 2) { s0[i] = __builtin_amdgcn_exp2f(s0[i]); s0[i + 1] = __builtin_amdgcn_exp2f(s0[i + 1]); s1[i] = __builtin_amdgcn_exp2f(s1[i]); s1[i + 1] = __builtin_amdgcn_exp2f(s1[i + 1]);
                    l2 += (f32x2_t){s0[i], s0[i + 1]}; l2 += (f32x2_t){s1[i], s1[i + 1]}; }
                lrun += l2[0] + l2[1];
            } else {
            float mx = s0[0];
#pragma unroll
            for (int i = 1; i < 16; ++i) mx = fmaxf(mx, s0[i]);
#pragma unroll
            for (int i = 0; i < 16; ++i) mx = fmaxf(mx, s1[i]);
            mx = fmaxf(mx, __shfl_xor(mx, 32));
            const float mnew = fmaxf(mrun, mx), alpha = __builtin_amdgcn_exp2f(mrun - mnew);
            mrun = mnew;
            float ls = 0.f;
#pragma unroll
            for (int i = 0; i < 16; ++i) { s0[i] = __builtin_amdgcn_exp2f(s0[i] - mnew); s1[i] = __builtin_amdgcn_exp2f(s1[i] - mnew); ls += s0[i] + s1[i]; }
            lrun = lrun * alpha + ls;
            if (__any(alpha != 1.0f)) {
#pragma unroll
                for (int i = 0; i < 16; ++i) { const float ai = __shfl(alpha, crow(i, hh)); o0[i] *= ai; o1[i] *= ai; } }
            }
            u32x4 pw[4];
#pragma unroll
            for (int e = 0; e < 4; ++e) { pw[0][e] = pk2(s0[2 * e], s0[2 * e + 1]); pw[1][e] = pk2(s0[8 + 2 * e], s0[8 + 2 * e + 1]); pw[2][e] = pk2(s1[2 * e], s1[2 * e + 1]); pw[3][e] = pk2(s1[8 + 2 * e], s1[8 + 2 * e + 1]); }
            const LAS bf16_t* vp = Vb + buf * 4352 + r * 68 + 4 * hh;
#pragma unroll
            for (int ks = 0; ks < 4; ++ks) {
                const u32x2 va0 = *(const LAS u32x2*)(vp + 16 * ks), va1 = *(const LAS u32x2*)(vp + 16 * ks + 8), vb0 = *(const LAS u32x2*)(vp + 32 * 68 + 16 * ks), vb1 = *(const LAS u32x2*)(vp + 32 * 68 + 16 * ks + 8);
                const bf16x8 v0 = __builtin_bit_cast(bf16x8, (u32x4){va0[0], va0[1], va1[0], va1[1]}), v1 = __builtin_bit_cast(bf16x8, (u32x4){vb0[0], vb0[1], vb1[0], vb1[1]});
                const bf16x8 pf = __builtin_bit_cast(bf16x8, pw[ks]);
                o0 = MFMA32(pf, v0, o0); o1 = MFMA32(pf, v1, o1);
            }
        }
        if (t + 1 < NTL) ATT_STORE(buf ^ 1);
        __syncthreads();
    }
#undef ATT_LOADG
#undef ATT_STORE
    const float ltot = lrun + __shfl_xor(lrun, 32), inv = 1.0f / ltot;
    const int b = bh >> 3, head = bh & 7;
#pragma unroll
    for (int i = 0; i < 16; ++i) { const int qr = crow(i, hh); const float f = __shfl(inv, qr);
        bf16_t* op = O + (size_t)(b * SEQ + qw + qr) * 1024 + head * 64 + r;
        op[0] = f2bf(o0[i] * f); op[32] = f2bf(o1[i] * f); }
}

__device__ __forceinline__ void attn_unit64(const bf16_t* Q, const bf16_t* K, const bf16_t* Vt, bf16_t* O, int bh, int qb8, float mfix, LAS unsigned char* lds) {
    const int tid = threadIdx.x, lane = tid & 63, wid = __builtin_amdgcn_readfirstlane(tid >> 6), r = lane & 31, hh = lane >> 5;
    LAS bf16_t* Kb = (LAS bf16_t*)lds;
    LAS bf16_t* Vb = (LAS bf16_t*)(lds + 2 * 64 * 104 * 2);
    const bf16_t* Qh = Q + (size_t)bh * SEQ * 96; const bf16_t* Kh = K + (size_t)bh * SEQ * 96; const bf16_t* Vh = Vt + (size_t)(bh & 7) * 64 * T + (size_t)(bh >> 3) * SEQ;
    const int q0 = qb8 * 512, qw = q0 + wid * 64, NTL = 8 * (qb8 + 1), tmaxw = 8 * qb8 + wid;
    LAS bf16x8* Qs = (LAS bf16x8*)(lds + 2 * 64 * 104 * 2 + 2 * 64 * 68 * 2) + tid;
#pragma unroll
    for (int d0 = 0; d0 < 6; ++d0) { Qs[512 * d0] = *(const bf16x8*)(Qh + (size_t)(qw + r) * 96 + 16 * d0 + 8 * hh); Qs[512 * (6 + d0)] = *(const bf16x8*)(Qh + (size_t)(qw + 32 + r) * 96 + 16 * d0 + 8 * hh); }
    f32x16 oA0, oA1, oB0, oB1;
#pragma unroll
    for (int i = 0; i < 16; ++i) { oA0[i] = 0.f; oA1[i] = 0.f; oB0[i] = 0.f; oB1[i] = 0.f; }
    float lA = 0.f, lB = 0.f;
    const int c2 = 512 + tid, kr1 = tid / 12, kc1 = tid % 12, kr2 = c2 / 12, kc2 = c2 % 12, vr = tid >> 3, vc = tid & 7;
    u32x4 kA, kB = {0u, 0u, 0u, 0u}, vA;
#define ATT_LOADG(t) do { kA = *(const u32x4*)(Kh + (size_t)(t) * 6144 + tid * 8); if (tid < 256) kB = *(const u32x4*)(Kh + (size_t)(t) * 6144 + c2 * 8); \
        vA = *(const u32x4*)(Vh + (size_t)vr * T + 64 * (t) + vc * 8); } while (0)
#define ATT_STORE(buf) do { *(LAS u32x4*)(Kb + (buf) * 6656 + kr1 * 104 + kc1 * 8) = kA; if (tid < 256) *(LAS u32x4*)(Kb + (buf) * 6656 + kr2 * 104 + kc2 * 8) = kB; \
        *(LAS u32x2*)(Vb + (buf) * 4352 + vr * 68 + vc * 8) = (u32x2){vA[0], vA[1]}; *(LAS u32x2*)(Vb + (buf) * 4352 + vr * 68 + vc * 8 + 4) = (u32x2){vA[2], vA[3]}; } while (0)
    ATT_LOADG(0); ATT_STORE(0); __syncthreads();
    for (int t = 0; t < NTL; ++t) {
        const int buf = t & 1;
        if (t + 1 < NTL) ATT_LOADG(t + 1);
        if (t <= tmaxw) {
            const LAS bf16_t* kp = Kb + buf * 6656 + r * 104 + 8 * hh;
            const LAS bf16_t* vp = Vb + buf * 4352 + r * 68 + 4 * hh;
#pragma unroll
            for (int half = 0; half < 2; ++half) {
                f32x16 sA, sB;
#pragma unroll
                for (int i = 0; i < 16; ++i) { sA[i] = -mfix; sB[i] = -mfix; }
#pragma unroll
                for (int d0 = 0; d0 < 6; ++d0) { const bf16x8 a = *(const LAS bf16x8*)(kp + half * 32 * 104 + 16 * d0); const bf16x8 qa_ = Qs[512 * d0], qb_ = Qs[512 * (6 + d0)]; sA = MFMA32(a, qa_, sA); sB = MFMA32(a, qb_, sB); }
                if (t == tmaxw) {
                    const int rowA = qw + r, rowB = qw + 32 + r;
#pragma unroll
                    for (int i = 0; i < 16; ++i) { const int kv = 64 * t + 32 * half + crow(i, hh); if (kv > rowA) sA[i] = -1e30f; if (kv > rowB) sB[i] = -1e30f; }
                }
                float la = 0.f, lb_ = 0.f;
#pragma unroll
                for (int i = 0; i < 16; ++i) { sA[i] = __builtin_amdgcn_exp2f(sA[i]); sB[i] = __builtin_amdgcn_exp2f(sB[i]); la += sA[i]; lb_ += sB[i]; }
                lA += la; lB += lb_;
                u32x4 pwA[2], pwB[2];
#pragma unroll
                for (int e = 0; e < 4; ++e) { pwA[0][e] = pk2(sA[2 * e], sA[2 * e + 1]); pwA[1][e] = pk2(sA[8 + 2 * e], sA[8 + 2 * e + 1]); pwB[0][e] = pk2(sB[2 * e], sB[2 * e + 1]); pwB[1][e] = pk2(sB[8 + 2 * e], sB[8 + 2 * e + 1]); }
#pragma unroll
                for (int k2 = 0; k2 < 2; ++k2) { const int ks = 2 * half + k2;
                    const u32x2 va0 = *(const LAS u32x2*)(vp + 16 * ks), va1 = *(const LAS u32x2*)(vp + 16 * ks + 8), vb0 = *(const LAS u32x2*)(vp + 32 * 68 + 16 * ks), vb1 = *(const LAS u32x2*)(vp + 32 * 68 + 16 * ks + 8);
                    const bf16x8 v0 = __builtin_bit_cast(bf16x8, (u32x4){va0[0], va0[1], va1[0], va1[1]}), v1 = __builtin_bit_cast(bf16x8, (u32x4){vb0[0], vb0[1], vb1[0], vb1[1]});
                    const bf16x8 pfA = __builtin_bit_cast(bf16x8, pwA[k2]), pfB = __builtin_bit_cast(bf16x8, pwB[k2]);
                    oA0 = MFMA32(v0, pfA, oA0); oA1 = MFMA32(v1, pfA, oA1); oB0 = MFMA32(v0, pfB, oB0); oB1 = MFMA32(v1, pfB, oB1); }
                __builtin_amdgcn_sched_barrier(0);
            }
        }
        if (t + 1 < NTL) ATT_STORE(buf ^ 1);
        __syncthreads();
    }
#undef ATT_LOADG
#undef ATT_STORE
    const float ltA = lA + __shfl_xor(lA, 32), ltB = lB + __shfl_xor(lB, 32), invA = 1.0f / ltA, invB = 1.0f / ltB;
    const int b = bh >> 3, head = bh & 7;
#define ATT_OSTORE(o0_, o1_, inv_, rowp_) do { \
        _Pragma("unroll") for (int blk_ = 0; blk_ < 2; ++blk_) { \
            _Pragma("unroll") for (int p_ = 0; p_ < 2; ++p_) { const int g_ = 2 * p_; \
                unsigned ax, ay, bx, by; \
                if (blk_ == 0) { ax = pk2(o0_[4 * g_] * inv_, o0_[4 * g_ + 1] * inv_); ay = pk2(o0_[4 * g_ + 2] * inv_, o0_[4 * g_ + 3] * inv_); bx = pk2(o0_[4 * g_ + 4] * inv_, o0_[4 * g_ + 5] * inv_); by = pk2(o0_[4 * g_ + 6] * inv_, o0_[4 * g_ + 7] * inv_); } \
                else { ax = pk2(o1_[4 * g_] * inv_, o1_[4 * g_ + 1] * inv_); ay = pk2(o1_[4 * g_ + 2] * inv_, o1_[4 * g_ + 3] * inv_); bx = pk2(o1_[4 * g_ + 4] * inv_, o1_[4 * g_ + 5] * inv_); by = pk2(o1_[4 * g_ + 6] * inv_, o1_[4 * g_ + 7] * inv_); } \
                { auto r_ = __builtin_amdgcn_permlane32_swap(ax, bx, false, false); ax = r_[0]; bx = r_[1]; } \
                { auto r_ = __builtin_amdgcn_permlane32_swap(ay, by, false, false); ay = r_[0]; by = r_[1]; } \
                *(u32x4*)((rowp_) + 32 * blk_ + 16 * p_ + 8 * hh) = (u32x4){ax, ay, bx, by}; } } } while (0)
    { bf16_t* rowA = O + (size_t)(b * SEQ + qw + r) * 1024 + head * 64; ATT_OSTORE(oA0, oA1, invA, rowA); ATT_OSTORE(oB0, oB1, invB, rowA + (size_t)32 * 1024); }
#undef ATT_OSTORE
}

__device__ __forceinline__ void conv_phase(const Args& a, int tile0, int ntile, int bid, int G) {
    const bf16_t* UH = (const bf16_t*)(a.ws + WS_UH); bf16_t* act = (bf16_t*)(a.ws + WS_ACT);
    const float* cw = a.in[20]; const float* cbias = a.in[21];
    const int gt = bid * NTHR + threadIdx.x, NT_ = G * NTHR;
    const int nit = ntile * 4096 * 16;
    for (int it = gt; it < nit; it += NT_) {
        const int jj = it & 15, tblk = (it >> 4) & 4095, pn = it >> 16;
        const int ch0 = 128 * (tile0 + pn) + 8 * jj, t0 = tblk * 8;
        const bf16_t* up = UH + (size_t)pn * T * 256 + 8 * jj;
        u32x4 gr[10], vr[10];
        const bool first = (t0 & 4095) == 0;
#pragma unroll
        for (int i = 0; i < 10; ++i) { const int t = t0 - 2 + i;
            if (i >= 2 || !first) { gr[i] = *(const u32x4*)(up + (size_t)t * 256); vr[i] = *(const u32x4*)(up + (size_t)t * 256 + 128); }
            else { gr[i] = (u32x4){0u, 0u, 0u, 0u}; vr[i] = (u32x4){0u, 0u, 0u, 0u}; } }
        f32x4 wg[3][2], wv[3][2], bg[2], bv[2];
#pragma unroll
        for (int j = 0; j < 3; ++j)
#pragma unroll
            for (int e = 0; e < 2; ++e) { wg[j][e] = *(const f32x4*)(cw + j * NUP + ch0 + 4 * e); wv[j][e] = *(const f32x4*)(cw + j * NUP + DFF + ch0 + 4 * e); }
#pragma unroll
        for (int e = 0; e < 2; ++e) { bg[e] = *(const f32x4*)(cbias + ch0 + 4 * e); bv[e] = *(const f32x4*)(cbias + DFF + ch0 + 4 * e); }
#pragma unroll
        for (int i = 0; i < 8; ++i) {
            u32x4 w;
#pragma unroll
            for (int e = 0; e < 4; ++e) {
                const int q4 = e >> 1, c0 = 2 * (e & 1);
                const float yg0 = bg[q4][c0] + wg[0][q4][c0] * bflo(gr[i][e]) + wg[1][q4][c0] * bflo(gr[i + 1][e]) + wg[2][q4][c0] * bflo(gr[i + 2][e]);
                const float yg1 = bg[q4][c0 + 1] + wg[0][q4][c0 + 1] * bfhi(gr[i][e]) + wg[1][q4][c0 + 1] * bfhi(gr[i + 1][e]) + wg[2][q4][c0 + 1] * bfhi(gr[i + 2][e]);
                const float yv0 = bv[q4][c0] + wv[0][q4][c0] * bflo(vr[i][e]) + wv[1][q4][c0] * bflo(vr[i + 1][e]) + wv[2][q4][c0] * bflo(vr[i + 2][e]);
                const float yv1 = bv[q4][c0 + 1] + wv[0][q4][c0 + 1] * bfhi(vr[i][e]) + wv[1][q4][c0 + 1] * bfhi(vr[i + 1][e]) + wv[2][q4][c0 + 1] * bfhi(vr[i + 2][e]);
                w[e] = pk2(yg0 * sigmoidf_(yg0) * yv0, yg1 * sigmoidf_(yg1) * yv1);
            }
            *(u32x4*)(act + (size_t)(t0 + i) * DFF + ch0) = w;
        }
    }
}

__device__ __forceinline__ void conv_fix_phase(const Args& a, int bid, int G) {
    const bf16_t* edge = (const bf16_t*)(a.ws + WS_UH); bf16_t* act = (bf16_t*)(a.ws + WS_ACT);
    const float* cw = a.in[20]; const float* cbias = a.in[21];
    const int gt = bid * NTHR + threadIdx.x, NT_ = G * NTHR;
    for (int it = gt; it < 512 * 352; it += NT_) {
        const int cg8 = it % 352, st = it / 352, ch0 = cg8 * 8, pn = ch0 >> 7, j = ch0 & 127, gcol = 256 * pn + j;
        u32x4 gr[4], vr[4];
        const bool first = (st & 63) == 0;
#pragma unroll
        for (int i = 0; i < 4; ++i) {
            if (i >= 2) { const bf16_t* p = edge + ((size_t)st * 4 + (i - 2)) * 5632 + gcol; gr[i] = *(const u32x4*)p; vr[i] = *(const u32x4*)(p + 128); }
            else if (!first) { const bf16_t* p = edge + ((size_t)(st - 1) * 4 + 2 + i) * 5632 + gcol; gr[i] = *(const u32x4*)p; vr[i] = *(const u32x4*)(p + 128); }
            else { gr[i] = (u32x4){0u, 0u, 0u, 0u}; vr[i] = (u32x4){0u, 0u, 0u, 0u}; } }
        f32x4 wg[3][2], wv[3][2], bg[2], bv[2];
#pragma unroll
        for (int jx = 0; jx < 3; ++jx)
#pragma unroll
            for (int e = 0; e < 2; ++e) { wg[jx][e] = *(const f32x4*)(cw + jx * NUP + ch0 + 4 * e); wv[jx][e] = *(const f32x4*)(cw + jx * NUP + DFF + ch0 + 4 * e); }
#pragma unroll
        for (int e = 0; e < 2; ++e) { bg[e] = *(const f32x4*)(cbias + ch0 + 4 * e); bv[e] = *(const f32x4*)(cbias + DFF + ch0 + 4 * e); }
#pragma unroll
        for (int i = 0; i < 2; ++i) {
            u32x4 w;
#pragma unroll
            for (int e = 0; e < 4; ++e) {
                const int q4 = e >> 1, c0 = 2 * (e & 1);
                const float yg0 = bg[q4][c0] + wg[0][q4][c0] * bflo(gr[i][e]) + wg[1][q4][c0] * bflo(gr[i + 1][e]) + wg[2][q4][c0] * bflo(gr[i + 2][e]);
                const float yg1 = bg[q4][c0 + 1] + wg[0][q4][c0 + 1] * bfhi(gr[i][e]) + wg[1][q4][c0 + 1] * bfhi(gr[i + 1][e]) + wg[2][q4][c0 + 1] * bfhi(gr[i + 2][e]);
                const float yv0 = bv[q4][c0] + wv[0][q4][c0] * bflo(vr[i][e]) + wv[1][q4][c0] * bflo(vr[i + 1][e]) + wv[2][q4][c0] * bflo(vr[i + 2][e]);
                const float yv1 = bv[q4][c0 + 1] + wv[0][q4][c0 + 1] * bfhi(vr[i][e]) + wv[1][q4][c0 + 1] * bfhi(vr[i + 1][e]) + wv[2][q4][c0 + 1] * bfhi(vr[i + 2][e]);
                w[e] = pk2(yg0 * sigmoidf_(yg0) * yv0, yg1 * sigmoidf_(yg1) * yv1);
            }
            *(u32x4*)(act + (size_t)(st * 64 + i) * DFF + ch0) = w;
        }
    }
}

#define XB_TMO      128
#define XB_XCNT(j)  (256  + 64 * (j))
#define XB_XSUB(j)  (1280 + 64 * (j))
#define XB_XGEN(j)  (2304 + 64 * (j))
#define XB_TOP      3328
#define XB_TOPGEN   3392
#define XCD_BAR_WORDS 3456
#define XB_SPIN_CAP (1u << 18)

__device__ __forceinline__ unsigned xb_ld(unsigned* p)              { return __hip_atomic_load(p, __ATOMIC_RELAXED, __HIP_MEMORY_SCOPE_AGENT); }
__device__ __forceinline__ unsigned xb_add(unsigned* p, unsigned v) { return __hip_atomic_fetch_add(p, v, __ATOMIC_RELAXED, __HIP_MEMORY_SCOPE_AGENT); }
__device__ __forceinline__ unsigned xb_xcc_id() { return (unsigned)__builtin_amdgcn_s_getreg((3 << 11) | 20) & 0xFu; }
#define XB_SPIN(cond, bar) do { unsigned _sp = 0; while (cond) { __builtin_amdgcn_s_sleep(1); \
    if ((++_sp & 255u) == 0u) { if (xb_ld(&(bar)[XB_TMO])) break; if (_sp > XB_SPIN_CAP) { atomicAdd(&(bar)[XB_TMO], 1u); break; } } } } while (0)

struct XcdBarrier {
    unsigned* bar; unsigned x;
    volatile LAS unsigned* st;
};

__device__ __forceinline__ XcdBarrier xcd_barrier_post(unsigned* bar, volatile LAS unsigned* st) {
    XcdBarrier b; b.bar = bar; b.x = xb_xcc_id(); b.st = st;
    if (threadIdx.x == 0) (void)xb_add(&bar[XB_XCNT(b.x)], 1u);
    return b;
}
__device__ __forceinline__ void xcd_barrier_complete(unsigned* bar, unsigned x, unsigned& nloc, unsigned& nx) {
    const unsigned G = gridDim.x * gridDim.y * gridDim.z;
    unsigned sum, cnt, mine, sp = 0u;
    for (;;) {
        sum = 0u; cnt = 0u; mine = 0u;
#pragma unroll
        for (unsigned j = 0; j < 16; ++j) { const unsigned c = xb_ld(&bar[XB_XCNT(j)]); sum += c; cnt += (c > 0u) ? 1u : 0u; mine = (j == x) ? c : mine; }
        if (sum == G) break;
        __builtin_amdgcn_s_sleep(1);
        if ((++sp & 255u) == 0u) { if (xb_ld(&bar[XB_TMO])) break; if (sp > XB_SPIN_CAP) { atomicAdd(&bar[XB_TMO], 1u); break; } }
    }
    nloc = mine > 0u ? mine : 1u; nx = cnt > 0u ? cnt : 1u;
}

__device__ __forceinline__ void xcd_barrier(const XcdBarrier& b) {
    asm volatile("s_waitcnt vmcnt(0)" ::: "memory");
    __syncthreads();
    if (threadIdx.x == 0) {
        unsigned* bar = b.bar;
        __builtin_amdgcn_s_waitcnt(0);
        unsigned nloc = b.st[0], nx = b.st[1];
        if (nloc == 0u) { xcd_barrier_complete(bar, b.x, nloc, nx); b.st[0] = nloc; b.st[1] = nx; }
        const unsigned old = xb_add(&bar[XB_XSUB(b.x)], 1u);
        const unsigned gen = old / nloc;
        if (old + 1u == (gen + 1u) * nloc) {
            __builtin_amdgcn_fence(__ATOMIC_RELEASE, "agent");
            asm volatile("s_waitcnt vmcnt(0)" ::: "memory");
            const unsigned og = xb_add(&bar[XB_TOP], 1u);
            const unsigned tg = og / nx;
            if (og + 1u == (tg + 1u) * nx) xb_add(&bar[XB_TOPGEN], 1u);
            else XB_SPIN(xb_ld(&bar[XB_TOPGEN]) == tg, bar);
            __builtin_amdgcn_fence(__ATOMIC_ACQUIRE, "agent");
            xb_add(&bar[XB_XGEN(b.x)], 1u);
            asm volatile("s_waitcnt vmcnt(0)" ::: "memory");
        } else {
            XB_SPIN(xb_ld(&bar[XB_XGEN(b.x)]) == gen, bar);
            __builtin_amdgcn_fence(__ATOMIC_ACQUIRE, "agent");
            asm volatile("s_waitcnt vmcnt(0)" ::: "memory");
        }
    }
    __syncthreads();
}


__global__ void __launch_bounds__(NTHR) mk_fwd(Args a) {
    extern __shared__ __attribute__((aligned(16))) unsigned char lds_raw[];
    LAS unsigned char* lds = (LAS unsigned char*)lds_raw;
    cg::grid_group grid = cg::this_grid();
    const int bid = blockIdx.x, G = gridDim.x;
    volatile LAS unsigned* xst = (volatile LAS unsigned*)(lds + LDS_BYTES - 64);
    if (threadIdx.x < 16) xst[threadIdx.x] = 0u;
    __syncthreads();
    XcdBarrier xbar = xcd_barrier_post((unsigned*)(a.ws + WS_BAR), xst);
    unsigned char* ws = a.ws;
    const float* mod = (const float*)(ws + WS_MOD);
#define WSB(off) ((bf16_t*)(ws + (off)))
#ifndef MK_PHMASK
#define MK_PHMASK 0x1ffff
#endif
#define PHON(n) (((MK_PHMASK) >> (n)) & 1)
    const int lo = a.ph_lo, hi = a.ph_hi;
#define IN(k) (PHON(k) && lo <= (k) && (k) < hi)
#define SEAM(k) do { if ((k) + 1 < hi) xcd_barrier(xbar); } while (0)
    if (a.ph_lo < 0) grid.sync();
#ifndef MK_DUP
#define MK_DUP 0
#endif
#ifndef MK_XSYNC
#define MK_XSYNC 0
#endif
#define DUPON(n) (((MK_DUP) >> (n)) & 1)
#define PHASE(k, ...) if (IN(k)) { { __VA_ARGS__ } if (DUPON(k)) { __VA_ARGS__ } SEAM(k); }
    for (int xs_ = 0; xs_ < MK_XSYNC; ++xs_) grid.sync();
    PHASE(0,  p0_phase(a, lds, bid, G); )
    PHASE(1,  adaln_phase<false>(a.in[0], a.in[5], mod, 0, 1024, WSB(SL(2)), bid, G); )
    PHASE(2,  pg8::Gemm g{WSB(SL(2)), WSB(WS_WIN), T, NPROJ, 1024}; pg8::StaticOrder S; S.init(T, NPROJ, G, bid);
                 pg8::EpiProj E{WSB(SL(4)), SLAB_EL, (float*)(ws + WS_RSQ), (float*)(ws + WS_RSKV)};
                 pg8::gemm_phase<pg8::EpiProj, pg8::StaticOrder, true, true>(lds, g, S, E); )
    PHASE(3,
                 h1_phase(WSB(SL(6)), WSB(SL(7)), WSB(SL(8)), WSB(SL(6)), WSB(SL(7)), (const float*)(ws + WS_LB), WSB(SL(14)), (float*)(ws + WS_G), lds, bid, G);
                 if (DUPON(21)) h1_phase(WSB(SL(6)), WSB(SL(7)), WSB(SL(8)), (bf16_t*)a.out, (bf16_t*)a.out + SLAB_EL, (const float*)(ws + WS_LB), (bf16_t*)a.out + 2 * SLAB_EL, (float*)(ws + 40 * MiB), lds, bid, G); )
    PHASE(4,  { pg8::Gemm g{WSB(SL(4)), WSB(WS_WUQ), T, 768, 512}; pg8::StaticOrder S; S.init(T, 768, G, bid);
                 pg8::EpiRowScale E{(bf16_t*)a.out, 768, (const float*)(ws + WS_RSQ), 1.f / 512.f};
                 pg8::gemm_phase<pg8::EpiRowScale, pg8::StaticOrder, true, true>(lds, g, S, E); }
               { pg8::Gemm g{WSB(SL(5)), WSB(WS_WUKV), T, 512, 256, 512}; pg8::StaticOrder S; S.init(T, 512, G, bid);
                 pg8::EpiRowScale E{WSB(SL(2)), 512, (const float*)(ws + WS_RSKV), 1.f / 256.f};
                 pg8::gemm_phase<pg8::EpiRowScale, pg8::StaticOrder, true, true>(lds, g, S, E); }
               { pg8::Gemm g{WSB(WS_WUKV + 512 * 1024), WSB(SL(5)), 512, T, 256, 512}; pg8::StaticOrder S; S.init(512, T, G, bid);
                 pg8::EpiColScale E{WSB(SL(8)), T, (const float*)(ws + WS_RSKV), 1.f / 256.f};
                 pg8::gemm_phase<pg8::EpiColScale, pg8::StaticOrder, true, true>(lds, g, S, E); } )
    PHASE(6,  qk_prep_phase(a, bid, G); if (DUPON(18)) qk_prep_phase(a, bid, G);
                 h2_phase(WSB(SL(14)), (const float*)(ws + WS_G), bid, G); )
    PHASE(7,  const bf16_t* Q = WSB(SL(3)); const bf16_t* K = (const bf16_t*)((unsigned char*)a.out + 64 * MiB); const bf16_t* Vt = WSB(SL(8)); bf16_t* O = (bf16_t*)a.out;
                 float mfix; { const int ln = threadIdx.x & 63; float gqm = fmaxf(fabsf(a.in[11][ln]), fabsf(a.in[11][64 + (ln & 31)])), gkm = fmaxf(fabsf(a.in[12][ln]), fabsf(a.in[12][64 + (ln & 31)]));
                     for (int o = 1; o < 64; o <<= 1) { gqm = fmaxf(gqm, __shfl_xor(gqm, o)); gkm = fmaxf(gkm, __shfl_xor(gkm, o)); }
                     mfix = 14.135f * 1.02f * gqm * gkm; }
                 const bool fix = mfix <= 40.f;
                 for (int rep = 0; rep < (DUPON(19) ? 2 : 1); ++rep) {
                 if (fix) { if (G == 256) { const int bh = bid >> 2, s = bid & 3; attn_unit64(Q, K, Vt, O, bh, 7 - s, mfix, lds); attn_unit64(Q, K, Vt, O, bh, s, mfix, lds); }
                            else { for (int j = bid; j < 512; j += G) attn_unit64(Q, K, Vt, O, j >> 3, 7 - (j & 7), mfix, lds); } }
                 else if (G == 256) { const int bh = bid >> 2, s = bid & 3;
                     for (int i = 0; i < 4; ++i) { const int qb = (i == 0) ? (15 - s) : (i == 1) ? (8 + s) : (i == 2) ? (7 - s) : s; attn_unit<false>(Q, K, Vt, O, bh, qb, mfix, lds); } }
                 else { for (int j = bid; j < 1024; j += G) attn_unit<false>(Q, K, Vt, O, j >> 4, 15 - (j & 15), mfix, lds); }
                 }
                 for (int j = bid; j < 512; j += G) h3_unit(j, WSB(SL(6)), WSB(SL(7)), WSB(SL(14)), WSB(SL(9)), a.in[14], (bf16_t*)a.out);
                 if (DUPON(20)) { for (int j = bid; j < 512; j += G) h3_unit(j, WSB(SL(6)), WSB(SL(7)), WSB(SL(14)), WSB(SL(9)), a.in[14], (bf16_t*)a.out); } )
    PHASE(8,  pg8::Gemm g{(const bf16_t*)a.out, WSB(WS_WA), T, 1024, 512, 1024}; pg8::PairOrder S; S.init(T, 1024, G, bid);
                 pg8::EpiBranchPair E{WSB(SL(10)), WSB(SL(12)), WSB(SL(2)), SLAB_EL};
                 pg8::gemm_phase<pg8::EpiBranchPair, pg8::PairOrder, true, true>(lds, g, S, E); )
    PHASE(10,  pg8::Gemm g{WSB(SL(2)), WSB(WS_WOUT), T, 1024, 1024}; pg8::StaticOrder S; S.init(T, 1024, G, bid);
                  pg8::EpiResGate<false, true> E{a.in[0], WSB(SL(14)), mod + 2048};
                  pg8::gemm_phase<pg8::EpiResGate<false, true>, pg8::StaticOrder, true, true>(lds, g, S, E); )
    PHASE(11,  adaln_phase<true>(WSB(SL(14)), a.in[18], mod, 3072, 4096, (bf16_t*)a.out, bid, G); )
    PHASE(12,  pg8::Gemm g{(const bf16_t*)a.out, WSB(WS_WUP), T, NUP, 1024}; pg8::StaticOrder S; S.init(T, NUP, G, bid);
                  pg8::EpiConvAct E{WSB(WS_ACT), WSB(WS_UH), a.in[20], a.in[21]};
                  pg8::gemm_phase<pg8::EpiConvAct, pg8::StaticOrder, true, true>(lds, g, S, E); )
    PHASE(13,  conv_fix_phase(a, bid, G); )
    PHASE(16,  pg8::Gemm g{WSB(WS_ACT), WSB(WS_WDOWN), T, 1024, DFF}; pg8::StaticOrder S; S.init(T, 1024, G, bid);
                  pg8::EpiResGate<true, false> E{WSB(SL(14)), a.out, mod + 5120};
                  pg8::gemm_phase<pg8::EpiResGate<true, false>, pg8::StaticOrder, true, true>(lds, g, S, E); )
#undef IN
#undef SEAM
#undef PHASE
#undef WSB
}

#ifndef MK_MULTI
#define MK_MULTI 0
#endif
extern "C" void kernel_launch(void* const* d_in, const int* in_sizes, int n_in, void* d_out, int out_size, void* d_ws, size_t ws_size, hipStream_t stream) {
    static int grid = 0;
    if (grid == 0) {
        if (n_in != 23 || out_size != T * DM || ws_size < WS_NEED) { fprintf(stderr, "kernel_launch: unexpected shapes (n_in %d out %d ws %zu)\n", n_in, out_size, ws_size); grid = -1; return; }
        int dev = 0, cus = 0, per_cu = 0;
        hipGetDevice(&dev); hipDeviceGetAttribute(&cus, hipDeviceAttributeMultiprocessorCount, dev);
        hipFuncSetAttribute((const void*)mk_fwd, hipFuncAttributeMaxDynamicSharedMemorySize, LDS_BYTES);
        hipOccupancyMaxActiveBlocksPerMultiprocessor(&per_cu, (const void*)mk_fwd, NTHR, LDS_BYTES);
        if (per_cu < 1) { fprintf(stderr, "kernel_launch: occupancy query says %d blocks per CU\n", per_cu); per_cu = 1; }
        (void)hipGetLastError();
        grid = cus * per_cu;
    }
    if (grid < 0) return;
    if (hipMemsetAsync((char*)d_ws + WS_BAR, 0, XCD_BAR_WORDS * 4, stream) != hipSuccess) { fprintf(stderr, "kernel_launch: memset failed\n"); return; }
    Args a{};
    for (int i = 0; i < 23; ++i) a.in[i] = (const float*)d_in[i];
    a.out = (float*)d_out; a.ws = (unsigned char*)d_ws;
    for (int i = 0; i < 16; ++i) a.invf[i] = powf(10000.0f, -(float)(2 * i) / 32.0f);
#if MK_MULTI
    for (int ph = 0; ph < NPHASE; ++ph) { a.ph_lo = ph; a.ph_hi = ph + 1; hipLaunchKernelGGL(mk_fwd, dim3(grid), dim3(NTHR), LDS_BYTES, stream, a); }
#else
    a.ph_lo = 0; a.ph_hi = NPHASE;
    void* args[] = {&a};
    hipError_t e = hipLaunchCooperativeKernel((const void*)mk_fwd, dim3(grid), dim3(NTHR), args, LDS_BYTES, stream);
    if (e != hipSuccess) fprintf(stderr, "cooperative launch failed: %s (grid %d)\n", hipGetErrorString(e), grid);
#endif
}
```
